# Optimizing an MI355X kernel written in HIP

```python
import jax, jax.numpy as jnp
from jax import lax
import numpy as np

D_MODEL = 1024
BATCH = 8
SEQ = 4096
DEPTH = 2

RET_HEADS = 4
RET_DIM = 128
D_RET = RET_HEADS * RET_DIM
MLSTM_HEADS = 4
MLSTM_DIM = 128
D_MLSTM = MLSTM_HEADS * MLSTM_DIM
D_MIX = D_RET + D_MLSTM
D_FF = 2816
CHUNK = 128
CONV_WIDTH = 4
ROPE_BASE = 10000.0
EPS = 1e-6
N_SUBLAYERS = 3
D_IN = 4 * D_RET + 4 * D_MLSTM + 2 * MLSTM_HEADS

kernel_name = "hybrid_retention_mlstm_macaron_adaln"


def rmsnorm(x, g):
    xf = x.astype(jnp.float32)
    xf = xf * lax.rsqrt(jnp.mean(xf * xf, axis=-1, keepdims=True) + EPS)
    return xf.astype(x.dtype) * g


def ada_mod(c, w, b):
    mod = jax.nn.silu(c) @ w + b
    shift, scale, gate = jnp.split(mod, 3, axis=-1)
    return shift[:, None, :], scale[:, None, :], gate[:, None, :]


def swiglu(h, w1, w3, w2):
    return (jax.nn.silu(h @ w1) * (h @ w3)) @ w2


def to_heads(t, n_heads):
    b, s, _ = t.shape
    return t.reshape(b, s, n_heads, -1).transpose(0, 2, 1, 3).astype(jnp.float32)


def head_norm(h, g):
    mu = jnp.mean(h, axis=-1, keepdims=True)
    var = jnp.mean(jnp.square(h - mu), axis=-1, keepdims=True)
    hn = (h - mu) * lax.rsqrt(var + EPS)
    b, nh, s, dh = hn.shape
    return hn.transpose(0, 2, 1, 3).reshape(b, s, nh * dh) * g.astype(jnp.float32)


def rotary(t, positions):
    dh = t.shape[-1]
    inv_freq = ROPE_BASE ** (-jnp.arange(0, dh, 2, dtype=jnp.float32) / dh)
    ang = positions.astype(jnp.float32)[:, None, :, None] * inv_freq
    cos, sin = jnp.cos(ang), jnp.sin(ang)
    t1, t2 = jnp.split(t, 2, axis=-1)
    return jnp.concatenate([t1 * cos - t2 * sin, t1 * sin + t2 * cos], axis=-1)


def causal_depthwise_conv(u, w, b):
    s = u.shape[1]
    up = jnp.pad(u, ((0, 0), (CONV_WIDTH - 1, 0), (0, 0)))
    out = b
    for j in range(CONV_WIDTH):
        out = out + w[j] * up[:, j:j + s, :]
    return out


def retention_chunkwise(q, k, v):
    b, nh, s, dh = q.shape
    nc = s // CHUNK
    k = k * (dh ** -0.5)
    log_gamma = jnp.log(1.0 - 2.0 ** (-5.0 - jnp.arange(nh, dtype=jnp.float32)))
    idx = jnp.arange(CHUNK)
    diff = (idx[:, None] - idx[None, :]).astype(jnp.float32)
    decay = jnp.where(diff >= 0, jnp.exp(log_gamma[:, None, None] * jnp.maximum(diff, 0.0)), 0.0)
    qc = q.reshape(b, nh, nc, CHUNK, dh)
    kc = k.reshape(b, nh, nc, CHUNK, dh)
    vc = v.reshape(b, nh, nc, CHUNK, dh)
    scores = jnp.einsum('bhcld,bhcmd->bhclm', qc, kc) * decay[None, :, None]
    o_intra = jnp.einsum('bhclm,bhcmd->bhcld', scores, vc)
    w_k = jnp.exp(log_gamma[:, None] * (CHUNK - 1 - idx).astype(jnp.float32))
    kv = jnp.einsum('bhcld,bhcle->bhcde', kc * w_k[None, :, None, :, None], vc)
    chunk_decay = jnp.exp(log_gamma * CHUNK)[:, None, None]

    def step(state, kv_c):
        return state * chunk_decay + kv_c, state

    _, prev = lax.scan(step, jnp.zeros((b, nh, dh, dh), jnp.float32), jnp.moveaxis(kv, 2, 0))
    prev = jnp.moveaxis(prev, 0, 2)
    w_q = jnp.exp(log_gamma[:, None] * (idx + 1).astype(jnp.float32))
    o_inter = jnp.einsum('bhcld,bhcde->bhcle', qc * w_q[None, :, None, :, None], prev)
    return (o_intra + o_inter).reshape(b, nh, s, dh)


def mlstm_chunkwise(q, k, v, i_pre, f_pre):
    b, nh, s, dh = q.shape
    nc = s // CHUNK
    q = q * (dh ** -0.5)
    log_f = jax.nn.log_sigmoid(f_pre)
    chunks = lambda t: jnp.moveaxis(t.reshape(b, nh, nc, CHUNK, *t.shape[3:]), 2, 0)
    causal = jnp.tril(jnp.ones((CHUNK, CHUNK), dtype=bool))

    def step(carry, inp):
        C, n, m = carry
        qc, kc, vc, ic, lfc = inp
        bcum = jnp.cumsum(lfc, axis=-1)
        log_d = jnp.where(causal, bcum[..., :, None] - bcum[..., None, :] + ic[..., None, :], -jnp.inf)
        inter_log = bcum + m[..., None]
        m_t = jnp.maximum(jnp.max(log_d, axis=-1), inter_log)
        w_d = jnp.exp(log_d - m_t[..., None])
        w_inter = jnp.exp(inter_log - m_t)
        sc = jnp.einsum('bhld,bhmd->bhlm', qc, kc) * w_d
        num = jnp.einsum('bhlm,bhmd->bhld', sc, vc) + w_inter[..., None] * jnp.einsum('bhld,bhde->bhle', qc, C)
        den = jnp.sum(sc, axis=-1) + w_inter * jnp.einsum('bhld,bhd->bhl', qc, n)
        h = num / jnp.maximum(jnp.abs(den), jnp.exp(-m_t))[..., None]
        b_last = bcum[..., -1]
        g = b_last[..., None] - bcum + ic
        m_new = jnp.maximum(b_last + m, jnp.max(g, axis=-1))
        w_c = jnp.exp(b_last + m - m_new)
        w_g = jnp.exp(g - m_new[..., None])
        C_new = w_c[..., None, None] * C + jnp.einsum('bhld,bhle->bhde', kc * w_g[..., None], vc)
        n_new = w_c[..., None] * n + jnp.einsum('bhl,bhld->bhd', w_g, kc)
        return (C_new, n_new, m_new), h

    init = (jnp.zeros((b, nh, dh, dh), jnp.float32), jnp.zeros((b, nh, dh), jnp.float32),
            jnp.zeros((b, nh), jnp.float32))
    _, hs = lax.scan(step, init, (chunks(q), chunks(k), chunks(v), chunks(i_pre), chunks(log_f)))
    return jnp.moveaxis(hs, 0, 2).reshape(b, nh, s, dh)


def setup_inputs(seed: int = 0) -> dict:
    key = jax.random.key(seed)
    ks = jax.random.split(key, 20)
    f32 = jnp.float32
    nrm = lambda k, shape, fan_in: jax.random.normal(k, shape, f32) * (fan_in ** -0.5)
    x = jax.random.normal(ks[0], (BATCH, SEQ, D_MODEL), f32)
    c = jax.random.normal(ks[1], (BATCH, D_MODEL), f32)
    offsets = jax.random.randint(ks[2], (BATCH, 1), 0, SEQ, dtype=jnp.int32)
    positions = offsets + jnp.arange(SEQ, dtype=jnp.int32)[None, :]
    norm_g = 1.0 + 0.02 * jax.random.normal(ks[3], (DEPTH, N_SUBLAYERS, D_MODEL), f32)
    w_ada = nrm(ks[4], (DEPTH, N_SUBLAYERS, D_MODEL, 3 * D_MODEL), D_MODEL)
    b_ada = 0.02 * jax.random.normal(ks[5], (DEPTH, N_SUBLAYERS, 3 * D_MODEL), f32)
    w_ff1 = nrm(ks[6], (DEPTH, 2, D_MODEL, D_FF), D_MODEL)
    w_ff3 = nrm(ks[7], (DEPTH, 2, D_MODEL, D_FF), D_MODEL)
    w_ff2 = nrm(ks[8], (DEPTH, 2, D_FF, D_MODEL), D_FF)
    w_in = nrm(ks[9], (DEPTH, D_MODEL, D_IN), D_MODEL)
    conv_w = nrm(ks[10], (DEPTH, CONV_WIDTH, 2 * D_MLSTM), CONV_WIDTH)
    conv_b = 0.02 * jax.random.normal(ks[11], (DEPTH, 2 * D_MLSTM), f32)
    b_igate = 0.1 * jax.random.normal(ks[12], (DEPTH, MLSTM_HEADS), f32)
    b_fgate = (jnp.linspace(3.0, 6.0, MLSTM_HEADS, dtype=f32)[None, :]
               + 0.1 * jax.random.normal(ks[13], (DEPTH, MLSTM_HEADS), f32))
    g_ret_norm = 1.0 + 0.02 * jax.random.normal(ks[14], (DEPTH, D_RET), f32)
    g_mlstm_norm = 1.0 + 0.02 * jax.random.normal(ks[15], (DEPTH, D_MLSTM), f32)
    w_out = nrm(ks[16], (DEPTH, D_MIX, D_MODEL), D_MIX)
    g_final = 1.0 + 0.02 * jax.random.normal(ks[17], (D_MODEL,), f32)
    return {"x": x, "c": c, "positions": positions, "norm_g": norm_g, "w_ada": w_ada,
            "b_ada": b_ada, "w_ff1": w_ff1, "w_ff3": w_ff3, "w_ff2": w_ff2, "w_in": w_in,
            "conv_w": conv_w, "conv_b": conv_b, "b_igate": b_igate, "b_fgate": b_fgate,
            "g_ret_norm": g_ret_norm, "g_mlstm_norm": g_mlstm_norm, "w_out": w_out,
            "g_final": g_final}


def reference(x, c, positions, norm_g, w_ada, b_ada, w_ff1, w_ff3, w_ff2, w_in, conv_w, conv_b,
              b_igate, b_fgate, g_ret_norm, g_mlstm_norm, w_out, g_final):
    for l in range(DEPTH):
        shift, scale, gate = ada_mod(c, w_ada[l, 0], b_ada[l, 0])
        h = rmsnorm(x, norm_g[l, 0]) * (1.0 + scale) + shift
        x = x + 0.5 * gate * swiglu(h, w_ff1[l, 0], w_ff3[l, 0], w_ff2[l, 0])

        shift, scale, gate = ada_mod(c, w_ada[l, 1], b_ada[l, 1])
        h = rmsnorm(x, norm_g[l, 1]) * (1.0 + scale) + shift
        z = h @ w_in[l]
        o = 0
        r_q, r_k, r_v, r_g = (z[..., o + j * D_RET:o + (j + 1) * D_RET] for j in range(4))
        o = 4 * D_RET
        m_qk = z[..., o:o + 2 * D_MLSTM]
        m_v = z[..., o + 2 * D_MLSTM:o + 3 * D_MLSTM]
        m_o = z[..., o + 3 * D_MLSTM:o + 4 * D_MLSTM]
        o = o + 4 * D_MLSTM
        m_i = z[..., o:o + MLSTM_HEADS] + b_igate[l]
        m_f = z[..., o + MLSTM_HEADS:o + 2 * MLSTM_HEADS] + b_fgate[l]

        rq = rotary(to_heads(r_q, RET_HEADS), positions)
        rk = rotary(to_heads(r_k, RET_HEADS), positions)
        ret = retention_chunkwise(rq, rk, to_heads(r_v, RET_HEADS))
        y_ret = jax.nn.silu(r_g.astype(jnp.float32)) * head_norm(ret, g_ret_norm[l])

        qk = jax.nn.silu(causal_depthwise_conv(m_qk, conv_w[l], conv_b[l]))
        mq = to_heads(qk[..., :D_MLSTM], MLSTM_HEADS)
        mk = to_heads(qk[..., D_MLSTM:], MLSTM_HEADS)
        i_pre = m_i.astype(jnp.float32).transpose(0, 2, 1)
        f_pre = m_f.astype(jnp.float32).transpose(0, 2, 1)
        mh = mlstm_chunkwise(mq, mk, to_heads(m_v, MLSTM_HEADS), i_pre, f_pre)
        mh = jax.nn.sigmoid(to_heads(m_o, MLSTM_HEADS)) * mh
        y_ml = head_norm(mh, g_mlstm_norm[l])

        y = jnp.concatenate([y_ret, y_ml], axis=-1).astype(x.dtype)
        x = x + gate * (y @ w_out[l])

        shift, scale, gate = ada_mod(c, w_ada[l, 2], b_ada[l, 2])
        h = rmsnorm(x, norm_g[l, 2]) * (1.0 + scale) + shift
        x = x + 0.5 * gate * swiglu(h, w_ff1[l, 1], w_ff3[l, 1], w_ff2[l, 1])
    return rmsnorm(x, g_final)
```

```cpp
#define MK_ONE_LAUNCH 1
#include <hip/hip_runtime.h>
#include <cstdio>
#include <cstdint>
namespace pg8 {
#define PG8_LAS __attribute__((address_space(3)))
typedef unsigned short bf16_t;
typedef short bf16x8 __attribute__((ext_vector_type(8)));
typedef float f32x4 __attribute__((ext_vector_type(4)));
typedef unsigned u32x4 __attribute__((ext_vector_type(4)));
constexpr int BM = 256, BK = 64, HALF = 128, HTB = HALF * BK * 2  , STAGE_BYTES = 8 * HTB, NXCD = 8, WGM = 8;

__host__ __device__ __forceinline__ int lds_byte(int r, int c) { const int st = (r >> 4) * 2 + (c >> 5), rr = r & 15, cc = c & 31, ob = rr * 64 + cc * 2; return st * 1024 + (ob ^ (((ob >> 9) & 1) << 5)); }
__host__ __device__ __forceinline__ void stage_rc(int b, int& R, int& C) { const int st = b / 1024, sb = b % 1024, swz = sb ^ (((sb >> 9) & 1) << 5); R = (st >> 1) * 16 + swz / 64; C = (st & 1) * 32 + (swz % 64) / 2; }
__host__ __device__ __forceinline__ int perm32(int rho) { const int n = rho >> 4, i = rho & 15; return 8 * (i >> 2) + 4 * n + (i & 3); }

struct Unit { int pm, pn; };
struct Gemm { const bf16_t* A; const bf16_t* Bt; int M, N, K; };

struct StaticOrder {
    int nM, nN, nwg, G, c;
    __host__ __device__ void init(int M, int N, int G_, int c_) { nM = M / BM; nN = N / BM; nwg = nM * nN; G = G_; c = c_; }
    __host__ __device__ bool next(int i, Unit& u) const {
        const long L = (long)i * G + c; if (L >= nwg) return false;
        int wgid = (int)L; { const int q = nwg / NXCD, r = nwg % NXCD, xcd = wgid % NXCD, off = wgid / NXCD; wgid = (xcd < r ? xcd * (q + 1) : r * (q + 1) + (xcd - r) * q) + off; }
        const int nig = WGM * nN, gid = wgid / nig, fm = gid * WGM, gsz = (nM - fm) < WGM ? (nM - fm) : WGM;
        u.pm = fm + ((wgid % nig) % gsz); u.pn = (wgid % nig) / gsz; return true;
    }
    __device__ __forceinline__ void a_ready(const Unit&) const {}
    __device__ __forceinline__ void done(const Unit&) const {}
};

__device__ __forceinline__ unsigned cvt_pk_bf16(float lo, float hi) { unsigned r; asm volatile("v_cvt_pk_bf16_f32 %0, %1, %2" : "=v"(r) : "v"(lo), "v"(hi)); return r; }
__device__ __forceinline__ float silu_f(float g) { return g * __builtin_amdgcn_rcpf(1.0f + __expf(-g)); }

struct EpiSwiglu {
    static constexpr bool PERM = true, AFTER_DRAIN = false;
    bf16_t* U; int ldc;
    __device__ __forceinline__ void operator()(const f32x4 (&acc)[2][2][4][2], const Unit& u, int wr, int wc, int fr, int fq) const {
        const int row0 = u.pm * BM + wr * 64 + fr, col0 = u.pn * HALF + wc * 32 + 8 * fq;
#pragma unroll
        for (int ai = 0; ai < 2; ++ai)
#pragma unroll
            for (int m = 0; m < 4; ++m) { bf16_t* rowp = U + (size_t)(row0 + ai * HALF + m * 16) * ldc + col0;
                f32x4 v0, v1;
#pragma unroll
                for (int j = 0; j < 4; ++j) { v0[j] = silu_f(acc[ai][0][m][0][j]) * acc[ai][1][m][0][j]; v1[j] = silu_f(acc[ai][0][m][1][j]) * acc[ai][1][m][1][j]; }
                u32x4 w; w.x = cvt_pk_bf16(v0[0], v0[1]); w.y = cvt_pk_bf16(v0[2], v0[3]); w.z = cvt_pk_bf16(v1[0], v1[1]); w.w = cvt_pk_bf16(v1[2], v1[3]);
                *(u32x4*)rowp = w; }
    }
};
struct EpiZ {
    static constexpr bool PERM = true, AFTER_DRAIN = false;
    bf16_t* O; int ldc;
    __device__ __forceinline__ void operator()(const f32x4 (&acc)[2][2][4][2], const Unit& u, int wr, int wc, int fr, int fq) const {
        const int row0 = u.pm * BM + wr * 64 + fr, col0 = u.pn * BM + wc * 32 + 8 * fq;
#pragma unroll
        for (int ai = 0; ai < 2; ++ai)
#pragma unroll
            for (int m = 0; m < 4; ++m) { bf16_t* rowp = O + (size_t)(row0 + ai * HALF + m * 16) * ldc + col0;
#pragma unroll
                for (int bj = 0; bj < 2; ++bj) { const f32x4 v0 = acc[ai][bj][m][0], v1 = acc[ai][bj][m][1];
                    u32x4 w; w.x = cvt_pk_bf16(v0[0], v0[1]); w.y = cvt_pk_bf16(v0[2], v0[3]); w.z = cvt_pk_bf16(v1[0], v1[1]); w.w = cvt_pk_bf16(v1[2], v1[3]);
                    *(u32x4*)(rowp + bj * HALF) = w; } }
    }
};
struct EpiResid {
    static constexpr bool PERM = false, AFTER_DRAIN = false;
    const float* base; float* out; const float* gate; int gstride; float coef;
    __device__ __forceinline__ void operator()(const f32x4 (&acc)[2][2][4][2], const Unit& u, int wr, int wc, int fr, int fq) const {
        const int row0 = u.pm * BM + wr * 64 + fr, col0 = u.pn * BM + wc * 32 + 4 * fq;
        const float* gp = gate + (size_t)(u.pm >> 4) * gstride + col0;
        f32x4 gv[2][2];
#pragma unroll
        for (int bj = 0; bj < 2; ++bj)
#pragma unroll
            for (int n = 0; n < 2; ++n) gv[bj][n] = *(const f32x4*)(gp + bj * HALF + n * 16) * coef;
#pragma unroll
        for (int ai = 0; ai < 2; ++ai)
#pragma unroll
            for (int m = 0; m < 4; ++m) { const size_t off = (size_t)(row0 + ai * HALF + m * 16) * 1024 + col0;
#pragma unroll
                for (int bj = 0; bj < 2; ++bj)
#pragma unroll
                    for (int n = 0; n < 2; ++n) { const f32x4 bs = *(const f32x4*)(base + off + bj * HALF + n * 16);
                        *(f32x4*)(out + off + bj * HALF + n * 16) = bs + gv[bj][n] * acc[ai][bj][m][n]; } }
    }
};
template <class Epi, class Sched, bool ALIGN_EPI = false, bool SP2 = false>
__device__ __forceinline__ void gemm_phase(PG8_LAS unsigned char* lds, const Gemm g, const Sched& S, const Epi& E) {
    int tid = threadIdx.x; asm volatile("" : "+v"(tid));
    const int wid = __builtin_amdgcn_readfirstlane(tid >> 6), lane = tid & 63, wr = wid >> 2, wc = wid & 3, fr = lane & 15, fq = lane >> 4;
    const int K = g.K, nt = K / BK;
    unsigned voffA[2], voffB[2];
#pragma unroll
    for (int i = 0; i < 2; ++i) { int R, C; stage_rc(tid * 16 + i * 8192, R, C); const int Rb = Epi::PERM ? ((R & ~31) + perm32(R & 31)) : R;
        voffA[i] = (unsigned)(R * K + C) * 2u; voffB[i] = (unsigned)(Rb * K + C) * 2u; }
    const size_t kstep = (size_t)(BK * 2);
    const size_t hstep = (size_t)HALF * K * 2;
    const size_t tstep = 2 * hstep;
    const unsigned ldsw = (unsigned)wid * 1024u;
    const int aoff = lds_byte(wr * 64 + fr, fq * 8), boff = lds_byte(wc * 32 + fr, fq * 8);
#define PG8_SA(b, h) (((b) * 2 + (h)) * HTB)
#define PG8_SB(b, h) ((4 + (b) * 2 + (h)) * HTB)
#define PG8_STAGE(bufoff, gbase, voff) do { _Pragma("unroll") for (int _i = 0; _i < 2; ++_i) \
        __builtin_amdgcn_global_load_lds((const unsigned*)((const char*)(gbase) + (voff)[_i]), (PG8_LAS unsigned*)(lds + (bufoff) + ldsw + _i * 8192), 16, 0, 0); } while (0)
#define PG8_LDA(dst, b, h) do { _Pragma("unroll") for (int m = 0; m < 4; ++m) _Pragma("unroll") for (int k = 0; k < 2; ++k) dst[m][k] = *(const PG8_LAS bf16x8*)(lds + PG8_SA(b, h) + aoff + m * 2048 + k * 1024); } while (0)
#define PG8_LDB(dst, b, h) do { _Pragma("unroll") for (int n = 0; n < 2; ++n) _Pragma("unroll") for (int k = 0; k < 2; ++k) dst[n][k] = *(const PG8_LAS bf16x8*)(lds + PG8_SB(b, h) + boff + n * 2048 + k * 1024); } while (0)
#define PG8_MMA(ai, bj, At, Bt) do { __builtin_amdgcn_s_setprio(1); _Pragma("unroll") for (int m = 0; m < 4; ++m) _Pragma("unroll") for (int n = 0; n < 2; ++n) _Pragma("unroll") for (int k = 0; k < 2; ++k) \
        acc[ai][bj][m][n] = __builtin_amdgcn_mfma_f32_16x16x32_bf16(Bt[n][k], At[m][k], acc[ai][bj][m][n], 0, 0, 0); __builtin_amdgcn_s_setprio(0); } while (0)
#define PG8_WAIT_V(n) asm volatile("s_waitcnt vmcnt(" #n ")" ::: "memory")
#define PG8_WAIT_L(n) asm volatile("s_waitcnt lgkmcnt(" #n ")" ::: "memory")
#define PG8_BAR __builtin_amdgcn_s_barrier()
#define PG8_SCHED __builtin_amdgcn_sched_barrier(0)
    Unit cur, nxt; int ui = 0;
    if (!S.next(0, cur)) return;
    f32x4 acc[2][2][4][2];
#pragma unroll
    for (int a = 0; a < 2; ++a)
#pragma unroll
        for (int b = 0; b < 2; ++b)
#pragma unroll
            for (int m = 0; m < 4; ++m)
#pragma unroll
                for (int n = 0; n < 2; ++n) acc[a][b][m][n] = (f32x4){0.f, 0.f, 0.f, 0.f};
    bf16x8 At[4][2], B0[2][2], B1[2][2];
    const char* cA = (const char*)g.A + (size_t)cur.pm * tstep; const char* cB = (const char*)g.Bt + (size_t)cur.pn * tstep;
    S.a_ready(cur);
    if constexpr (SP2) {
        PG8_STAGE(PG8_SB(0, 0), cB, voffB); PG8_STAGE(PG8_SB(0, 1), cB + hstep, voffB); PG8_STAGE(PG8_SA(0, 0), cA, voffA); PG8_STAGE(PG8_SA(0, 1), cA + hstep, voffA);
        if (wr == 1) PG8_BAR;
        PG8_WAIT_V(2); PG8_BAR;
        PG8_STAGE(PG8_SB(1, 0), cB + kstep, voffB); PG8_STAGE(PG8_SA(1, 0), cA + kstep, voffA); PG8_STAGE(PG8_SB(1, 1), cB + hstep + kstep, voffB);
        PG8_WAIT_V(6); PG8_BAR;
    } else {
        PG8_STAGE(PG8_SB(0, 0), cB, voffB); PG8_STAGE(PG8_SA(0, 0), cA, voffA); PG8_STAGE(PG8_SB(0, 1), cB + hstep, voffB); PG8_STAGE(PG8_SA(0, 1), cA + hstep, voffA);
        if (wr == 1) PG8_BAR;
        PG8_WAIT_V(4); PG8_BAR;
        PG8_STAGE(PG8_SB(1, 0), cB + kstep, voffB); PG8_STAGE(PG8_SA(1, 0), cA + kstep, voffA); PG8_STAGE(PG8_SB(1, 1), cB + hstep + kstep, voffB);
        PG8_WAIT_V(6); PG8_BAR;
    }
    for (;;) {
        const bool has_next = S.next(ui + 1, nxt);
        const char* nA = has_next ? (const char*)g.A + (size_t)nxt.pm * tstep : cA; const char* nB = has_next ? (const char*)g.Bt + (size_t)nxt.pn * tstep : cB;
        for (int t = 0; t < nt; t += 2) {
            const bool last = (t == nt - 2);
            const char* a1 = cA + (size_t)(t + 1) * kstep;
            const char* a2 = last ? nA : cA + (size_t)(t + 2) * kstep; const char* b2 = last ? nB : cB + (size_t)(t + 2) * kstep;
            const char* a3 = a2 + kstep; const char* b3 = b2 + kstep;
            if (last && has_next) S.a_ready(nxt);
            if constexpr (SP2) {
            PG8_LDB(B0, 0, 0); PG8_LDB(B1, 0, 1); PG8_SCHED; PG8_LDA(At, 0, 0); PG8_STAGE(PG8_SA(1, 1), a1 + hstep, voffA);
            PG8_WAIT_V(8); PG8_WAIT_L(0); PG8_BAR; PG8_MMA(0, 0, At, B0); PG8_MMA(0, 1, At, B1); PG8_BAR; PG8_SCHED;
            PG8_LDA(At, 0, 1); PG8_STAGE(PG8_SB(0, 0), b2, voffB); PG8_STAGE(PG8_SB(0, 1), b2 + hstep, voffB); PG8_STAGE(PG8_SA(0, 0), a2, voffA);
            PG8_WAIT_V(8); PG8_WAIT_L(0); PG8_BAR; PG8_MMA(1, 0, At, B0); PG8_MMA(1, 1, At, B1); PG8_BAR; PG8_SCHED;
            PG8_LDB(B0, 1, 0); PG8_LDB(B1, 1, 1); PG8_SCHED; PG8_LDA(At, 1, 0); PG8_STAGE(PG8_SA(0, 1), a2 + hstep, voffA);
            PG8_WAIT_V(8); PG8_WAIT_L(0); PG8_BAR; PG8_MMA(0, 0, At, B0); PG8_MMA(0, 1, At, B1); PG8_BAR; PG8_SCHED;
            PG8_LDA(At, 1, 1); PG8_STAGE(PG8_SB(1, 0), b3, voffB); PG8_STAGE(PG8_SB(1, 1), b3 + hstep, voffB); PG8_STAGE(PG8_SA(1, 0), a3, voffA);
            PG8_WAIT_V(8); PG8_WAIT_L(0); PG8_BAR; PG8_MMA(1, 0, At, B0); PG8_MMA(1, 1, At, B1); PG8_BAR; PG8_SCHED;
            } else {
            PG8_LDB(B0, 0, 0); PG8_SCHED; PG8_LDA(At, 0, 0); PG8_STAGE(PG8_SA(1, 1), a1 + hstep, voffA);
            PG8_WAIT_L(8); PG8_BAR; PG8_WAIT_L(0); PG8_MMA(0, 0, At, B0); PG8_BAR; PG8_SCHED;
            PG8_LDB(B1, 0, 1); PG8_STAGE(PG8_SB(0, 0), b2, voffB);
            PG8_BAR; PG8_WAIT_L(0); PG8_MMA(0, 1, At, B1); PG8_BAR;
            PG8_LDA(At, 0, 1); PG8_STAGE(PG8_SA(0, 0), a2, voffA);
            PG8_BAR; PG8_WAIT_L(0); PG8_MMA(1, 0, At, B0); PG8_BAR; PG8_SCHED;
            PG8_STAGE(PG8_SB(0, 1), b2 + hstep, voffB);
            PG8_WAIT_V(6); PG8_BAR; PG8_MMA(1, 1, At, B1); PG8_BAR;
            PG8_LDB(B0, 1, 0); PG8_SCHED; PG8_LDA(At, 1, 0); PG8_STAGE(PG8_SA(0, 1), a2 + hstep, voffA);
            PG8_WAIT_L(8); PG8_BAR; PG8_WAIT_L(0); PG8_MMA(0, 0, At, B0); PG8_BAR; PG8_SCHED;
            PG8_LDB(B1, 1, 1); PG8_STAGE(PG8_SB(1, 0), b3, voffB);
            PG8_BAR; PG8_WAIT_L(0); PG8_MMA(0, 1, At, B1); PG8_BAR;
            PG8_LDA(At, 1, 1); PG8_STAGE(PG8_SA(1, 0), a3, voffA);
            PG8_BAR; PG8_WAIT_L(0); PG8_MMA(1, 0, At, B0); PG8_BAR; PG8_SCHED;
            PG8_STAGE(PG8_SB(1, 1), b3 + hstep, voffB);
            PG8_WAIT_V(6); PG8_BAR; PG8_MMA(1, 1, At, B1); PG8_BAR;
            }
        }
        if constexpr (ALIGN_EPI) { if (wr == 0) PG8_BAR; }
        if constexpr (!Epi::AFTER_DRAIN) { E(acc, cur, wr, wc, fr, fq); S.done(cur); }
        if (!has_next) break;
#pragma unroll
        for (int a = 0; a < 2; ++a)
#pragma unroll
            for (int b = 0; b < 2; ++b)
#pragma unroll
                for (int m = 0; m < 4; ++m)
#pragma unroll
                    for (int n = 0; n < 2; ++n) acc[a][b][m][n] = (f32x4){0.f, 0.f, 0.f, 0.f};
        cur = nxt; cA = nA; cB = nB; ++ui;
        if constexpr (ALIGN_EPI) { if (wr == 1) PG8_BAR; }
    }
    PG8_WAIT_V(0);
    if constexpr (!ALIGN_EPI) { if (wr == 0) PG8_BAR; }
    PG8_BAR;
    if constexpr (Epi::AFTER_DRAIN) { E.fused(acc, cur, wr, wc, fr, fq, lds, wid, lane); S.done(cur); }
#undef PG8_SA
#undef PG8_SB
#undef PG8_STAGE
#undef PG8_LDA
#undef PG8_LDB
#undef PG8_MMA
#undef PG8_WAIT_V
#undef PG8_WAIT_L
#undef PG8_BAR
#undef PG8_SCHED
}
}

constexpr int NWAVES = 8;
#ifndef MK_ONE_LAUNCH
#define MK_ONE_LAUNCH 1
#endif

constexpr int BATCH = 8, SEQ = 4096, D = 1024, DEPTH = 2, DFF = 2816, NH = 4, DH = 128, CHUNK = 128, NCH = SEQ / CHUNK, DIN = 4104, DZ = 4096;
constexpr int M = BATCH * SEQ;
constexpr float EPS = 1e-6f;
constexpr int NPHASE = 24;

constexpr size_t MiB = 1u << 20;
constexpr size_t WS_CTL = 0, CTL_ZERO_BYTES = 1 * MiB;
constexpr size_t WS_MOD = 1 * MiB;
constexpr size_t WS_GATES = 2 * MiB;
constexpr size_t WS_NPREV = 3 * MiB;
constexpr size_t WS_MPREV = 3 * MiB + 768 * 1024;
constexpr size_t WS_ROPE = 4 * MiB;
constexpr size_t WS_W = 20 * MiB;
constexpr size_t W13_BYTES = (size_t)2 * DFF * D * 2, W2_BYTES = (size_t)D * DFF * 2, WIN_BYTES = (size_t)DZ * D * 2, WOUT_BYTES = (size_t)D * D * 2;
constexpr size_t LW_W13 = 0, LW_W2 = 2 * W13_BYTES, LW_WIN = LW_W2 + 2 * W2_BYTES, LW_WOUT = LW_WIN + WIN_BYTES, LW_BYTES = LW_WOUT + WOUT_BYTES;
constexpr size_t WS_H = 106 * MiB;
constexpr size_t WS_ST = 170 * MiB;
constexpr size_t WS_Z = 234 * MiB;
constexpr size_t WS_END = 490 * MiB;
static_assert(WS_W + DEPTH * LW_BYTES <= WS_H && WS_H + (size_t)M * D * 2 <= WS_ST && WS_ST + (size_t)2 * BATCH * NH * NCH * 16384 * 2 <= WS_Z && WS_Z + (size_t)M * DZ * 2 <= WS_END, "d_ws map");
constexpr int CW_BAR = 4096;

constexpr int RING_BYTES = 131072;
constexpr int SM_OFF = RING_BYTES;
constexpr int MISC_OFF = RING_BYTES + 12288;
constexpr int LDS_BYTES = 147456;
static_assert(MISC_OFF + 128 <= LDS_BYTES, "LDS map");

#define GAS __attribute__((address_space(1)))
#define LAS __attribute__((address_space(3)))
typedef unsigned short bf16;
typedef unsigned v4u __attribute__((ext_vector_type(4)));
typedef float f32x4 __attribute__((ext_vector_type(4)));
typedef GAS unsigned gu32;
#define RLX_AGENT __ATOMIC_RELAXED, __HIP_MEMORY_SCOPE_AGENT
#define LDS_WAIT() asm volatile("s_waitcnt lgkmcnt(0)" ::: "memory")
#define VM_WAIT() asm volatile("s_waitcnt vmcnt(0)" ::: "memory")
__device__ __forceinline__ unsigned f2bf(float f) { unsigned u = __builtin_bit_cast(unsigned, f); return (u + 0x7fffu + ((u >> 16) & 1u)) >> 16; }
__device__ __forceinline__ unsigned pk2(float lo, float hi) { return f2bf(lo) | (f2bf(hi) << 16); }
__device__ __forceinline__ float bf2f(unsigned short v) { return __builtin_bit_cast(float, (unsigned)v << 16); }
__device__ __forceinline__ float bflo(unsigned w) { return __builtin_bit_cast(float, w << 16); }
__device__ __forceinline__ float bfhi(unsigned w) { return __builtin_bit_cast(float, w & 0xffff0000u); }
__device__ __forceinline__ float wave_sum(float v) {
#pragma unroll
    for (int o = 1; o < 64; o <<= 1) v += __shfl_xor(v, o);
    return v;
}
__device__ __forceinline__ float wave_max(float v) {
#pragma unroll
    for (int o = 1; o < 64; o <<= 1) v = fmaxf(v, __shfl_xor(v, o));
    return v;
}
__device__ __forceinline__ float silu_acc(float x) { return x / (1.0f + expf(-x)); }
__device__ __forceinline__ float sigmoid_acc(float x) { return 1.0f / (1.0f + expf(-x)); }
__device__ __forceinline__ float logsigmoid_acc(float x) { return fminf(x, 0.0f) - log1pf(expf(-fabsf(x))); }
#define XB_TMO      128
#define XB_XCNT(j)  (256  + 64 * (j))
#define XB_XSUB(j)  (1280 + 64 * (j))
#define XB_XGEN(j)  (2304 + 64 * (j))
#define XB_TOP      3328
#define XB_TOPGEN   3392
#define XCD_BAR_WORDS 3456
#define XB_SPIN_CAP (1u << 18)

__device__ __forceinline__ unsigned xb_ld(unsigned* p)              { return __hip_atomic_load(p, __ATOMIC_RELAXED, __HIP_MEMORY_SCOPE_AGENT); }
__device__ __forceinline__ unsigned xb_add(unsigned* p, unsigned v) { return __hip_atomic_fetch_add(p, v, __ATOMIC_RELAXED, __HIP_MEMORY_SCOPE_AGENT); }
__device__ __forceinline__ unsigned xb_xcc_id() { return (unsigned)__builtin_amdgcn_s_getreg((3 << 11) | 20) & 0xFu; }
#define XB_SPIN(cond, bar) do { unsigned _sp = 0; while (cond) { __builtin_amdgcn_s_sleep(1); \
    if ((++_sp & 255u) == 0u) { if (xb_ld(&(bar)[XB_TMO])) break; if (_sp > XB_SPIN_CAP) { atomicAdd(&(bar)[XB_TMO], 1u); break; } } } } while (0)

struct XcdBarrier {
    unsigned* bar; unsigned x;
    volatile LAS unsigned* st;
};

__device__ __forceinline__ XcdBarrier xcd_barrier_post(unsigned* bar, volatile LAS unsigned* st) {
    XcdBarrier b; b.bar = bar; b.x = xb_xcc_id(); b.st = st;
    if (threadIdx.x == 0) (void)xb_add(&bar[XB_XCNT(b.x)], 1u);
    return b;
}
__device__ __forceinline__ void xcd_barrier_complete(unsigned* bar, unsigned x, unsigned& nloc, unsigned& nx) {
    const unsigned G = gridDim.x * gridDim.y * gridDim.z;
    unsigned sum, cnt, mine, sp = 0u;
    for (;;) {
        sum = 0u; cnt = 0u; mine = 0u;
#pragma unroll
        for (unsigned j = 0; j < 16; ++j) { const unsigned c = xb_ld(&bar[XB_XCNT(j)]); sum += c; cnt += (c > 0u) ? 1u : 0u; mine = (j == x) ? c : mine; }
        if (sum == G) break;
        __builtin_amdgcn_s_sleep(1);
        if ((++sp & 255u) == 0u) { if (xb_ld(&bar[XB_TMO])) break; if (sp > XB_SPIN_CAP) { atomicAdd(&bar[XB_TMO], 1u); break; } }
    }
    nloc = mine > 0u ? mine : 1u; nx = cnt > 0u ? cnt : 1u;
}

__device__ __forceinline__ void xcd_barrier(const XcdBarrier& b) {
    asm volatile("s_waitcnt vmcnt(0)" ::: "memory");
    __syncthreads();
    if (threadIdx.x == 0) {
        unsigned* bar = b.bar;
        __builtin_amdgcn_s_waitcnt(0);
        unsigned nloc = b.st[0], nx = b.st[1];
        if (nloc == 0u) { xcd_barrier_complete(bar, b.x, nloc, nx); b.st[0] = nloc; b.st[1] = nx; }
        const unsigned old = xb_add(&bar[XB_XSUB(b.x)], 1u);
        const unsigned gen = old / nloc;
        if (old + 1u == (gen + 1u) * nloc) {
            __builtin_amdgcn_fence(__ATOMIC_RELEASE, "agent");
            asm volatile("s_waitcnt vmcnt(0)" ::: "memory");
            const unsigned og = xb_add(&bar[XB_TOP], 1u);
            const unsigned tg = og / nx;
            if (og + 1u == (tg + 1u) * nx) xb_add(&bar[XB_TOPGEN], 1u);
            else XB_SPIN(xb_ld(&bar[XB_TOPGEN]) == tg, bar);
            __builtin_amdgcn_fence(__ATOMIC_ACQUIRE, "agent");
            xb_add(&bar[XB_XGEN(b.x)], 1u);
            asm volatile("s_waitcnt vmcnt(0)" ::: "memory");
        } else {
            XB_SPIN(xb_ld(&bar[XB_XGEN(b.x)]) == gen, bar);
            __builtin_amdgcn_fence(__ATOMIC_ACQUIRE, "agent");
            asm volatile("s_waitcnt vmcnt(0)" ::: "memory");
        }
    }
    __syncthreads();
}

__device__ __forceinline__ void p0_transpose_item(const float* W, int ldw, int K, bf16* WT, int dst_row0, LAS float* scr, int k0, int n0, int lane) {
#pragma unroll 8
    for (int i = 0; i < 32; ++i) { const int kk = 2 * i + (lane >> 5); scr[kk * 33 + (lane & 31)] = W[(size_t)(k0 + kk) * ldw + n0 + (lane & 31)]; }
    LDS_WAIT(); asm volatile("" ::: "memory");
    const int c = lane & 7;
#pragma unroll
    for (int j = 0; j < 4; ++j) { const int n = (lane >> 3) + 8 * j; const LAS float* s = scr + (8 * c) * 33 + n;
        v4u o; o.x = pk2(s[0 * 33], s[1 * 33]); o.y = pk2(s[2 * 33], s[3 * 33]); o.z = pk2(s[4 * 33], s[5 * 33]); o.w = pk2(s[6 * 33], s[7 * 33]);
        *(GAS v4u*)(WT + (size_t)(dst_row0 + n) * K + k0 + 8 * c) = o; }
    LDS_WAIT(); asm volatile("" ::: "memory");
}
__device__ __forceinline__ void sincos_d(double a, double& s, double& c) {
    const double k = __builtin_rint(a * 0.63661977236758134308);
    double t = __builtin_fma(-k, 1.57079632679489655800e+00, a); t = __builtin_fma(-k, 6.12323399573676603587e-17, t);
    const double t2 = t * t;
    double sp = 1.0 / 6227020800.0; sp = sp * t2 - 1.0 / 39916800.0; sp = sp * t2 + 1.0 / 362880.0; sp = sp * t2 - 1.0 / 5040.0; sp = sp * t2 + 1.0 / 120.0; sp = sp * t2 - 1.0 / 6.0; sp = sp * t2 + 1.0;
    const double st = sp * t;
    double cp = -1.0 / 87178291200.0; cp = cp * t2 + 1.0 / 479001600.0; cp = cp * t2 - 1.0 / 3628800.0; cp = cp * t2 + 1.0 / 40320.0; cp = cp * t2 - 1.0 / 720.0; cp = cp * t2 + 1.0 / 24.0; cp = cp * t2 - 0.5; cp = cp * t2 + 1.0;
    const int q = (int)((long long)k & 3ll);
    s = (q == 0) ? st : (q == 1) ? cp : (q == 2) ? -st : -cp;
    c = (q == 0) ? cp : (q == 1) ? -st : (q == 2) ? -cp : st;
}

__device__ __forceinline__ void prologue_phase(LAS unsigned char* lds, const void* const* in, unsigned char* ws, int tid, int lane, int wave, int vcu, int G) {
    const float* cvec = (const float*)in[1]; const int* positions = (const int*)in[2];
    const float* w_ada = (const float*)in[4]; const float* b_ada = (const float*)in[5];
    {
        LAS float* sc = (LAS float*)lds;
        LAS float* part = (LAS float*)(lds + 32768);
        float* mod = (float*)(ws + WS_MOD);
        for (int i = tid; i < BATCH * D; i += NWAVES * 64) sc[i] = silu_acc(cvec[i]);
        __syncthreads();
        for (int u = vcu; u < DEPTH * 3 * 48; u += G) {
            const int ls = u / 48, n0 = (u % 48) * 64;
            const float* W = w_ada + (size_t)ls * D * 3 * D + n0 + lane;
            float acc[8];
#pragma unroll
            for (int b = 0; b < 8; ++b) acc[b] = 0.f;
            const int k0 = wave * 128;
#pragma unroll 8
            for (int k = 0; k < 128; ++k) { const float w = W[(size_t)(k0 + k) * (3 * D)];
#pragma unroll
                for (int b = 0; b < 8; ++b) acc[b] += sc[b * D + k0 + k] * w; }
#pragma unroll
            for (int b = 0; b < 8; ++b) part[(wave * 8 + b) * 64 + lane] = acc[b];
            __syncthreads();
            { const int b = tid >> 6, col = tid & 63; float s = b_ada[(size_t)ls * 3 * D + n0 + col];
#pragma unroll
              for (int w = 0; w < 8; ++w) s += part[(w * 8 + b) * 64 + col];
              mod[((size_t)ls * BATCH + b) * (3 * D) + n0 + col] = s; }
            __syncthreads();
        }
    }
    {
        float2* rope = (float2*)(ws + WS_ROPE);
        const int gtid = vcu * (NWAVES * 64) + tid, nth = G * NWAVES * 64;
        for (int idx = gtid; idx < M * 64; idx += nth) {
            const int row = idx >> 6, i = idx & 63;
            double r = 1.0, p = 0.8659643233600653;
#pragma unroll
            for (int bit = 0; bit < 6; ++bit) { if ((i >> bit) & 1) r *= p; p *= p; }
            const float invf = (float)r; const float ang = (float)positions[row] * invf;
            double s, c; sincos_d((double)ang, s, c);
            rope[idx] = make_float2((float)c, (float)s);
        }
    }
    {
        LAS float* scr = (LAS float*)(lds + wave * 16384);
        const int gw = vcu * NWAVES + wave, NGW = G * NWAVES;
        constexpr int I_13 = (D / 64) * (DFF / 32), I_2 = (DFF / 64) * (D / 32), I_IN = (D / 64) * (DZ / 32), I_OUT = (D / 64) * (D / 32);
        constexpr int PER_LAYER = 4 * I_13 + 2 * I_2 + I_IN + I_OUT;
        const float* w_ff1 = (const float*)in[6]; const float* w_ff3 = (const float*)in[7]; const float* w_ff2 = (const float*)in[8];
        const float* w_in = (const float*)in[9]; const float* w_out = (const float*)in[16];
        for (int it = gw; it < DEPTH * PER_LAYER; it += NGW) {
            const int l = it / PER_LAYER; int r = it % PER_LAYER;
            unsigned char* lw = ws + WS_W + (size_t)l * LW_BYTES;
            if (r < 4 * I_13) {
                const int q = r / I_13, rr = r % I_13, f = q >> 1, t = q & 1, kb = rr / (DFF / 32), nb = rr % (DFF / 32), n0 = nb * 32;
                const float* W = (t ? w_ff3 : w_ff1) + (size_t)(l * 2 + f) * D * DFF;
                p0_transpose_item(W, DFF, D, (bf16*)(lw + LW_W13 + (size_t)f * W13_BYTES), 256 * (n0 >> 7) + 128 * t + (n0 & 127), scr, kb * 64, n0, lane);
                continue; }
            r -= 4 * I_13;
            if (r < 2 * I_2) { const int f = r / I_2, rr = r % I_2, kb = rr / (D / 32), nb = rr % (D / 32);
                p0_transpose_item(w_ff2 + (size_t)(l * 2 + f) * DFF * D, D, DFF, (bf16*)(lw + LW_W2 + (size_t)f * W2_BYTES), nb * 32, scr, kb * 64, nb * 32, lane);
                continue; }
            r -= 2 * I_2;
            if (r < I_IN) { const int kb = r / (DZ / 32), nb = r % (DZ / 32);
                p0_transpose_item(w_in + (size_t)l * D * DIN, DIN, D, (bf16*)(lw + LW_WIN), nb * 32, scr, kb * 64, nb * 32, lane);
                continue; }
            r -= I_IN;
            { const int kb = r / (D / 32), nb = r % (D / 32);
              p0_transpose_item(w_out + (size_t)l * D * D, D, D, (bf16*)(lw + LW_WOUT), nb * 32, scr, kb * 64, nb * 32, lane); }
        }
    }
}

template <bool GATES>
__device__ __forceinline__ void norm_phase(LAS unsigned char* lds, const float* x, const float* g, const float* mod, bf16* hout, const float* w_in_l, const float* b_ig, const float* b_fg, float* gates,
                                           int gw, int NGW, int lane) {
    LAS f32x4* wgl = (LAS f32x4*)lds;
    if (GATES) { __syncthreads();
        for (int i = lane + 64 * (gw % NWAVES); i < D * 2; i += NWAVES * 64) wgl[i] = *(const f32x4*)(w_in_l + (size_t)(i >> 1) * DIN + DZ + 4 * (i & 1));
        __syncthreads(); }
    for (int grp = gw; grp < M / 16; grp += NGW) {
        const int row0 = grp * 16, b = row0 / SEQ;
        f32x4 gm[4], sh[4];
#pragma unroll
        for (int j = 0; j < 4; ++j) { const int col = 4 * lane + 256 * j; const f32x4 gv = *(const f32x4*)(g + col), sc = *(const f32x4*)(mod + (size_t)b * 3 * D + D + col);
            gm[j] = gv * (1.0f + sc); sh[j] = *(const f32x4*)(mod + (size_t)b * 3 * D + col); }
        float bias8 = 0.f;
        if (GATES) { if (lane < 8) bias8 = lane < 4 ? b_ig[lane] : b_fg[lane - 4]; }
        for (int r = 0; r < 16; ++r) {
            const int row = row0 + r;
            const GAS f32x4* xr = (const GAS f32x4*)(x + (size_t)row * D) + lane;
            f32x4 v[4]; float ss = 0.f;
#pragma unroll
            for (int j = 0; j < 4; ++j) { v[j] = xr[64 * j]; ss += (v[j].x * v[j].x + v[j].y * v[j].y) + (v[j].z * v[j].z + v[j].w * v[j].w); }
            const float rstd = 1.0f / sqrtf(wave_sum(ss) * (1.0f / D) + EPS);
            GAS unsigned long long* o8 = (GAS unsigned long long*)(hout + (size_t)row * D) + lane;
#pragma unroll
            for (int j = 0; j < 4; ++j) { v[j] = (v[j] * rstd) * gm[j] + sh[j];
                o8[64 * j] = (unsigned long long)pk2(v[j].x, v[j].y) | ((unsigned long long)pk2(v[j].z, v[j].w) << 32); }
            if (GATES) {
                f32x4 d0 = {0.f, 0.f, 0.f, 0.f}, d1 = {0.f, 0.f, 0.f, 0.f};
#pragma unroll
                for (int j = 0; j < 4; ++j)
#pragma unroll
                    for (int e = 0; e < 4; ++e) { const int k = 4 * lane + 256 * j + e; d0 += wgl[2 * k] * v[j][e]; d1 += wgl[2 * k + 1] * v[j][e]; }
                float mine = 0.f;
#pragma unroll
                for (int q = 0; q < 4; ++q) { const float s0 = wave_sum(d0[q]), s1 = wave_sum(d1[q]); if (lane == q) mine = s0; if (lane == 4 + q) mine = s1; }
                if (lane < 8) gates[(size_t)row * 8 + lane] = mine + bias8;
            }
        }
    }
}
__device__ __forceinline__ void final_norm_phase(float* x, const float* g, int gw, int NGW, int lane) {
    for (int grp = gw; grp < M / 16; grp += NGW) {
        f32x4 gm[4];
#pragma unroll
        for (int j = 0; j < 4; ++j) gm[j] = *(const f32x4*)(g + 4 * lane + 256 * j);
        for (int r = 0; r < 16; ++r) {
            GAS f32x4* xr = (GAS f32x4*)(x + (size_t)(grp * 16 + r) * D) + lane;
            f32x4 v[4]; float ss = 0.f;
#pragma unroll
            for (int j = 0; j < 4; ++j) { v[j] = xr[64 * j]; ss += (v[j].x * v[j].x + v[j].y * v[j].y) + (v[j].z * v[j].z + v[j].w * v[j].w); }
            const float rstd = 1.0f / sqrtf(wave_sum(ss) * (1.0f / D) + EPS);
#pragma unroll
            for (int j = 0; j < 4; ++j) xr[64 * j] = (v[j] * rstd) * gm[j];
        }
    }
}

__device__ __forceinline__ float lg2gamma(int h) { return h == 0 ? -0.04580368961312479f : h == 1 ? -0.02272007650008353f : h == 2 ? -0.011315313227834146f : -0.005646563141142063f; }
constexpr float QK_SCALE = 0.08838834764831845f;
__device__ __forceinline__ float rot_elem(const bf16* zp, const float2* rp, int l, int d) {
    const int i = d & 63; const float t1 = bf2f(zp[(size_t)l * DZ + i]), t2 = bf2f(zp[(size_t)l * DZ + 64 + i]); const float2 cs = rp[(size_t)l * 64 + i];
    return d < 64 ? t1 * cs.x - t2 * cs.y : t1 * cs.y + t2 * cs.x;
}
__device__ __forceinline__ float conv_elem(const bf16* z, int b, int s, int zc, float cw0, float cw1, float cw2, float cw3, float cb) {
    const bf16* p = z + ((size_t)b * SEQ + s) * DZ + zc;
    float a = cb + cw3 * bf2f(p[0]);
    if (s >= 1) a += cw2 * bf2f(p[-(ptrdiff_t)DZ]);
    if (s >= 2) a += cw1 * bf2f(p[-(ptrdiff_t)2 * DZ]);
    if (s >= 3) a += cw0 * bf2f(p[-(ptrdiff_t)3 * DZ]);
    return silu_acc(a);
}
__device__ __forceinline__ void ml_gate_scan(const float* gates, int row0, int h, int lane, float& bc0, float& bc1, float& ic0, float& ic1) {
    const float* gp = gates + (size_t)(row0 + 2 * lane) * 8;
    ic0 = gp[h]; ic1 = gp[8 + h];
    const float lf0 = logsigmoid_acc(gp[4 + h]), lf1 = logsigmoid_acc(gp[12 + h]);
    const float s1 = lf0 + lf1; float v = s1;
#pragma unroll
    for (int off = 1; off < 64; off <<= 1) { const float t = __shfl_up(v, off); if (lane >= off) v += t; }
    const float ex = v - s1; bc0 = ex + lf0; bc1 = ex + s1;
}

__device__ __forceinline__ void ma_simple(LAS unsigned char* lds, const bf16* z, const float2* rope, const float* gates, const float* conv_w, const float* conv_b,
                                          bf16* states, float* nprev, float* mprev, int tid, int lane, int wave, int vcu, int G) {
    LAS float* kf = (LAS float*)lds;
    LAS float* vf = (LAS float*)(lds + 65536);
    LAS float* wl = (LAS float*)(lds + SM_OFF);
    LAS float* scal = wl + 128;
    for (int u = vcu; u < 256; u += G) {
        const int g = u >> 7, b = (u >> 4) & 7, h = (u >> 2) & 3, eq = u & 3;
        const int d = tid >> 2, e8 = (tid & 3) * 8;
        float acc[8]; float nacc = 0.f, mrun = 0.f;
#pragma unroll
        for (int j = 0; j < 8; ++j) acc[j] = 0.f;
        for (int c = 0; c < NCH; ++c) {
            const int row0 = b * SEQ + c * CHUNK;
            { bf16* st = states + ((((size_t)g * BATCH + b) * NH + h) * NCH + c) * 16384 + d * 128 + eq * 32 + e8;
              v4u o; o.x = pk2(acc[0], acc[1]); o.y = pk2(acc[2], acc[3]); o.z = pk2(acc[4], acc[5]); o.w = pk2(acc[6], acc[7]); *(v4u*)st = o; }
            if (g == 1 && eq == 0) { if ((tid & 3) == 0) nprev[(((size_t)b * NH + h) * NCH + c) * 128 + d] = nacc; if (tid == 0) mprev[((size_t)b * NH + h) * NCH + c] = mrun; }
            __syncthreads();
            if (g == 0) {
                const bf16* zp = z + (size_t)row0 * DZ + 512 + 128 * h; const float2* rp = rope + (size_t)row0 * 64;
                for (int idx = tid; idx < 128 * 128; idx += NWAVES * 64) { const int l = idx >> 7, dd = idx & 127; kf[idx] = rot_elem(zp, rp, l, dd) * QK_SCALE; }
                for (int idx = tid; idx < 128 * 32; idx += NWAVES * 64) { const int l = idx >> 5, e = idx & 31; vf[idx] = bf2f(z[(size_t)(row0 + l) * DZ + 1024 + 128 * h + 32 * eq + e]); }
                if (tid < 128) wl[tid] = exp2f((float)(127 - tid) * lg2gamma(h));
                if (tid == 0) scal[0] = exp2f(128.0f * lg2gamma(h));
            } else {
                for (int idx = tid; idx < 128 * 128; idx += NWAVES * 64) { const int l = idx >> 7, dd = idx & 127, ch = 512 + 128 * h + dd;
                    kf[idx] = conv_elem(z, b, c * CHUNK + l, 2048 + ch, conv_w[ch], conv_w[1024 + ch], conv_w[2048 + ch], conv_w[3072 + ch], conv_b[ch]); }
                for (int idx = tid; idx < 128 * 32; idx += NWAVES * 64) { const int l = idx >> 5, e = idx & 31; vf[idx] = bf2f(z[(size_t)(row0 + l) * DZ + 3072 + 128 * h + 32 * eq + e]); }
                if (wave == 0) {
                    float bc0, bc1, ic0, ic1; ml_gate_scan(gates, row0, h, lane, bc0, bc1, ic0, ic1);
                    const float blast = __shfl(bc1, 63);
                    const float g0 = blast - bc0 + ic0, g1 = blast - bc1 + ic1;
                    const float gmax = wave_max(fmaxf(g0, g1));
                    const float mnew = fmaxf(blast + mrun, gmax);
                    wl[2 * lane] = expf(g0 - mnew); wl[2 * lane + 1] = expf(g1 - mnew);
                    if (lane == 0) { scal[0] = expf(blast + mrun - mnew); scal[1] = mnew; }
                }
            }
            __syncthreads();
            const float wc = scal[0];
            if (g == 1) mrun = scal[1];
#pragma unroll
            for (int j = 0; j < 8; ++j) acc[j] *= wc;
            nacc *= wc;
            for (int l = 0; l < 128; ++l) {
                const float kw = kf[l * 128 + d] * wl[l];
                const f32x4 v0 = *(const LAS f32x4*)(vf + l * 32 + e8), v1 = *(const LAS f32x4*)(vf + l * 32 + e8 + 4);
                acc[0] += kw * v0.x; acc[1] += kw * v0.y; acc[2] += kw * v0.z; acc[3] += kw * v0.w;
                acc[4] += kw * v1.x; acc[5] += kw * v1.y; acc[6] += kw * v1.z; acc[7] += kw * v1.w;
                nacc += kw;
            }
        }
        __syncthreads();
    }
}

__device__ __forceinline__ void mb_simple(LAS unsigned char* lds, const bf16* z, const float2* rope, const float* gates, const float* conv_w, const float* conv_b,
                                          const bf16* states, const float* nprev, const float* mprev, const float* g_ret, const float* g_ml, bf16* y,
                                          int tid, int lane, int wave, int vcu, int G) {
    LAS bf16* qb = (LAS bf16*)lds;
    LAS bf16* kb = (LAS bf16*)(lds + 32768);
    LAS float* P = (LAS float*)(lds + 65536);
    LAS float* bcs = (LAS float*)(lds + SM_OFF);
    LAS float* ics = bcs + 128;
    for (int u = vcu; u < 2 * BATCH * NH * NCH; u += G) {
        const int g = u >> 10, b = (u >> 7) & 7, h = (u >> 5) & 3, c = u & 31;
        const int row0 = b * SEQ + c * CHUNK;
        const int l = tid >> 2, r4 = tid & 3;
        __syncthreads();
        if (g == 0) {
            const bf16* zq = z + (size_t)row0 * DZ + 128 * h; const bf16* zk = zq + 512; const float2* rp = rope + (size_t)row0 * 64;
            for (int idx = tid; idx < 128 * 128; idx += NWAVES * 64) { const int ll = idx >> 7, dd = idx & 127;
                qb[idx] = (bf16)f2bf(rot_elem(zq, rp, ll, dd)); kb[idx] = (bf16)f2bf(rot_elem(zk, rp, ll, dd) * QK_SCALE); }
        } else {
            for (int idx = tid; idx < 128 * 128; idx += NWAVES * 64) { const int ll = idx >> 7, dd = idx & 127, chq = 128 * h + dd, chk = 512 + chq;
                qb[idx] = (bf16)f2bf(conv_elem(z, b, c * CHUNK + ll, 2048 + chq, conv_w[chq], conv_w[1024 + chq], conv_w[2048 + chq], conv_w[3072 + chq], conv_b[chq]) * QK_SCALE);
                kb[idx] = (bf16)f2bf(conv_elem(z, b, c * CHUNK + ll, 2048 + chk, conv_w[chk], conv_w[1024 + chk], conv_w[2048 + chk], conv_w[3072 + chk], conv_b[chk])); }
            if (wave == 0) { float bc0, bc1, ic0, ic1; ml_gate_scan(gates, row0, h, lane, bc0, bc1, ic0, ic1);
                bcs[2 * lane] = bc0; bcs[2 * lane + 1] = bc1; ics[2 * lane] = ic0; ics[2 * lane + 1] = ic1; }
        }
        __syncthreads();
        float rowf, mt = 0.f, bl = 0.f;
        if (g == 0) rowf = exp2f((float)(l + 1) * lg2gamma(h));
        else { const float mp = mprev[((size_t)b * NH + h) * NCH + c]; float amax = -INFINITY;
            for (int m = 0; m <= l; ++m) amax = fmaxf(amax, ics[m] - bcs[m]);
            bl = bcs[l]; mt = bl + fmaxf(amax, mp); rowf = expf(bl + mp - mt); }
        float o[32];
#pragma unroll
        for (int e = 0; e < 32; ++e) o[e] = 0.f;
        const bf16* st = states + ((((size_t)g * BATCH + b) * NH + h) * NCH + c) * 16384 + r4 * 32;
#pragma unroll 1
        for (int dp = 0; dp < 64; ++dp) {
            const unsigned qq = *(const LAS unsigned*)(qb + l * 128 + 2 * dp);
            const float q0 = bflo(qq), q1 = bfhi(qq);
            const v4u* p0 = (const v4u*)(st + (size_t)(2 * dp) * 128); const v4u* p1 = (const v4u*)(st + (size_t)(2 * dp + 1) * 128);
#pragma unroll
            for (int i = 0; i < 4; ++i) { const v4u a = p0[i], bb = p1[i];
                o[8 * i + 0] += q0 * bflo(a.x) + q1 * bflo(bb.x); o[8 * i + 1] += q0 * bfhi(a.x) + q1 * bfhi(bb.x);
                o[8 * i + 2] += q0 * bflo(a.y) + q1 * bflo(bb.y); o[8 * i + 3] += q0 * bfhi(a.y) + q1 * bfhi(bb.y);
                o[8 * i + 4] += q0 * bflo(a.z) + q1 * bflo(bb.z); o[8 * i + 5] += q0 * bfhi(a.z) + q1 * bfhi(bb.z);
                o[8 * i + 6] += q0 * bflo(a.w) + q1 * bflo(bb.w); o[8 * i + 7] += q0 * bfhi(a.w) + q1 * bfhi(bb.w); }
        }
#pragma unroll
        for (int e = 0; e < 32; ++e) o[e] *= rowf;
        float psum = 0.f;
#pragma unroll 1
        for (int mm = 0; mm < 32; ++mm) {
            const int m = r4 * 32 + mm; float s = 0.f;
#pragma unroll 4
            for (int i = 0; i < 16; ++i) { const v4u t = *(const LAS v4u*)(kb + m * 128 + 8 * i); const v4u qv = *(const LAS v4u*)(qb + l * 128 + 8 * i);
                s += bflo(qv.x) * bflo(t.x) + bfhi(qv.x) * bfhi(t.x) + bflo(qv.y) * bflo(t.y) + bfhi(qv.y) * bfhi(t.y)
                   + bflo(qv.z) * bflo(t.z) + bfhi(qv.z) * bfhi(t.z) + bflo(qv.w) * bflo(t.w) + bfhi(qv.w) * bfhi(t.w); }
            float w;
            if (m > l) w = 0.f;
            else if (g == 0) w = exp2f((float)(l - m) * lg2gamma(h));
            else w = expf(bl - bcs[m] + ics[m] - mt);
            const float pv = s * w; P[l * 128 + m] = pv; psum += pv;
        }
        float qn = 0.f;
        if (g == 1) { const float* np = nprev + (((size_t)b * NH + h) * NCH + c) * 128;
#pragma unroll 4
            for (int i = 0; i < 64; ++i) { const unsigned qq = *(const LAS unsigned*)(qb + l * 128 + 2 * i); qn += bflo(qq) * np[2 * i] + bfhi(qq) * np[2 * i + 1]; } }
        __syncthreads();
        { const int vcol = (g == 0 ? 1024 : 3072) + 128 * h;
          for (int idx = tid; idx < 128 * 16; idx += NWAVES * 64) { const int m = idx >> 4, ch = idx & 15; *(LAS v4u*)(kb + m * 128 + 8 * ch) = *(const v4u*)(z + (size_t)(row0 + m) * DZ + vcol + 8 * ch); } }
        __syncthreads();
#pragma unroll 1
        for (int m = 0; m < 128; ++m) {
            const float p = P[l * 128 + m];
#pragma unroll
            for (int i = 0; i < 4; ++i) { const v4u a = *(const LAS v4u*)(kb + m * 128 + r4 * 32 + 8 * i);
                o[8 * i + 0] += p * bflo(a.x); o[8 * i + 1] += p * bfhi(a.x); o[8 * i + 2] += p * bflo(a.y); o[8 * i + 3] += p * bfhi(a.y);
                o[8 * i + 4] += p * bflo(a.z); o[8 * i + 5] += p * bfhi(a.z); o[8 * i + 6] += p * bflo(a.w); o[8 * i + 7] += p * bfhi(a.w); }
        }
        const int row = row0 + l;
        if (g == 1) {
            psum += __shfl_xor(psum, 1); psum += __shfl_xor(psum, 2);
            const float den = psum + rowf * qn; const float dd = fmaxf(fabsf(den), expf(-mt)); const float inv = 1.0f / dd;
            const bf16* zo = z + (size_t)row * DZ + 3584 + 128 * h + r4 * 32;
#pragma unroll
            for (int e = 0; e < 32; ++e) o[e] = o[e] * inv * sigmoid_acc(bf2f(zo[e]));
        }
        float s1 = 0.f;
#pragma unroll
        for (int e = 0; e < 32; ++e) s1 += o[e];
        s1 += __shfl_xor(s1, 1); s1 += __shfl_xor(s1, 2);
        const float mu = s1 * (1.0f / 128.0f); float s2 = 0.f;
#pragma unroll
        for (int e = 0; e < 32; ++e) { const float dlt = o[e] - mu; s2 += dlt * dlt; }
        s2 += __shfl_xor(s2, 1); s2 += __shfl_xor(s2, 2);
        const float rs = 1.0f / sqrtf(s2 * (1.0f / 128.0f) + EPS);
        const float* gn = (g == 0 ? g_ret : g_ml) + 128 * h + r4 * 32;
        const bf16* zg = z + (size_t)row * DZ + 1536 + 128 * h + r4 * 32;
        bf16* yo = y + (size_t)row * D + g * 512 + 128 * h + r4 * 32;
#pragma unroll
        for (int i = 0; i < 4; ++i) { float t[8];
#pragma unroll
            for (int j = 0; j < 8; ++j) { const int e = 8 * i + j; float val = (o[e] - mu) * rs * gn[e]; if (g == 0) val *= silu_acc(bf2f(zg[e])); t[j] = val; }
            v4u w; w.x = pk2(t[0], t[1]); w.y = pk2(t[2], t[3]); w.z = pk2(t[4], t[5]); w.w = pk2(t[6], t[7]);
            *(v4u*)(yo + 8 * i) = w; }
    }
}

struct Args { const void* in[18]; float* out; unsigned char* ws; int ph_lo, ph_hi, li, pad; };
__global__ void __launch_bounds__(NWAVES * 64, 2) mk_fwd(Args args) {
    extern __shared__ __attribute__((aligned(16))) unsigned char lds_raw[];
    LAS unsigned char* lds = (LAS unsigned char*)lds_raw;
    volatile LAS unsigned* MISC = (volatile LAS unsigned*)(lds + MISC_OFF);
    const int G = gridDim.x; const int bx = blockIdx.x; const int vcu = (G % 8 == 0) ? (bx % 8) * (G / 8) + bx / 8 : bx;
#define ARGS() ({ unsigned long long _p = (unsigned long long)__builtin_amdgcn_kernarg_segment_ptr(); asm volatile("" : "+s"(_p)); (const __attribute__((address_space(4))) Args*)_p; })
    if (threadIdx.x < 32) MISC[threadIdx.x] = 0u;
    __syncthreads();
    XcdBarrier bar;
    { const auto* A = ARGS(); bar = xcd_barrier_post((unsigned*)(A->ws + WS_CTL) + CW_BAR + A->li * XCD_BAR_WORDS, MISC + 8); }
    const int lo = args.ph_lo, hi = args.ph_hi;
#define IN(k) (lo <= (k) && (k) < hi)
#define SEAM(k) do { if (IN(k) && IN((k) + 1)) xcd_barrier(bar); } while (0)
#define TIDS() int tid = threadIdx.x; asm volatile("" : "+v"(tid)); const int lane = tid & 63, wave = __builtin_amdgcn_readfirstlane(tid >> 6), gw = vcu * NWAVES + wave, NGW = G * NWAVES; (void)gw; (void)NGW; (void)lane

    if (IN(0)) { TIDS(); const auto* A = ARGS(); const void* inp[18];
#pragma unroll
        for (int i = 0; i < 18; ++i) inp[i] = A->in[i];
        prologue_phase(lds, inp, A->ws, tid, lane, wave, vcu, G); SEAM(0); }

    for (int j = 0; j < 2 * DEPTH; ++j) {
        const int l = j >> 1, f = j & 1;
        const int pb = 1 + 11 * l + (f ? 8 : 0);
        const int s = f ? 2 : 0;
        if (IN(pb)) { TIDS(); const auto* A = ARGS(); unsigned char* ws = A->ws;
            const float* xsrc = (j == 0) ? (const float*)A->in[0] : (const float*)A->out;
            norm_phase<false>(lds, xsrc, (const float*)A->in[3] + (size_t)(l * 3 + s) * D, (const float*)(ws + WS_MOD) + (size_t)(l * 3 + s) * BATCH * 3 * D, (bf16*)(ws + WS_H), nullptr, nullptr, nullptr, nullptr, gw, NGW, lane);
            SEAM(pb); }
        if (IN(pb + 1)) { const auto* A = ARGS(); unsigned char* ws = A->ws;
            pg8::Gemm g{(const bf16*)(ws + WS_H), (const bf16*)(ws + WS_W + (size_t)l * LW_BYTES + LW_W13 + (size_t)f * W13_BYTES), M, 2 * DFF, D}; pg8::StaticOrder S; S.init(M, 2 * DFF, G, bx);
            pg8::EpiSwiglu E{(bf16*)(ws + WS_Z), DFF};
            pg8::gemm_phase<pg8::EpiSwiglu, pg8::StaticOrder, true, true>(lds, g, S, E);
            SEAM(pb + 1);
        }
        if (IN(pb + 2)) { const auto* A = ARGS(); unsigned char* ws = A->ws;
            const float* xsrc = (j == 0) ? (const float*)A->in[0] : (const float*)A->out;
            pg8::Gemm g{(const bf16*)(ws + WS_Z), (const bf16*)(ws + WS_W + (size_t)l * LW_BYTES + LW_W2 + (size_t)f * W2_BYTES), M, D, DFF}; pg8::StaticOrder S; S.init(M, D, G, bx);
            pg8::EpiResid E{xsrc, A->out, (const float*)(ws + WS_MOD) + (size_t)(l * 3 + s) * BATCH * 3 * D + 2 * D, 3 * D, 0.5f};
            pg8::gemm_phase<pg8::EpiResid, pg8::StaticOrder, true, true>(lds, g, S, E);
            SEAM(pb + 2);
        }
        if (f == 0) {
            const int mb = 1 + 11 * l + 3;
            if (IN(mb)) { TIDS(); const auto* A = ARGS(); unsigned char* ws = A->ws;
                norm_phase<true>(lds, A->out, (const float*)A->in[3] + (size_t)(l * 3 + 1) * D, (const float*)(ws + WS_MOD) + (size_t)(l * 3 + 1) * BATCH * 3 * D, (bf16*)(ws + WS_H),
                                 (const float*)A->in[9] + (size_t)l * D * DIN, (const float*)A->in[12] + l * NH, (const float*)A->in[13] + l * NH, (float*)(ws + WS_GATES), gw, NGW, lane);
                SEAM(mb); }
            if (IN(mb + 1)) { const auto* A = ARGS(); unsigned char* ws = A->ws;
                pg8::Gemm g{(const bf16*)(ws + WS_H), (const bf16*)(ws + WS_W + (size_t)l * LW_BYTES + LW_WIN), M, DZ, D}; pg8::StaticOrder S; S.init(M, DZ, G, bx);
                pg8::EpiZ E{(bf16*)(ws + WS_Z), DZ};
                pg8::gemm_phase<pg8::EpiZ, pg8::StaticOrder, true, true>(lds, g, S, E);
                SEAM(mb + 1);
            }
            if (IN(mb + 2)) { TIDS(); const auto* A = ARGS(); unsigned char* ws = A->ws;
                ma_simple(lds, (const bf16*)(ws + WS_Z), (const float2*)(ws + WS_ROPE), (const float*)(ws + WS_GATES), (const float*)A->in[10] + (size_t)l * 4 * D, (const float*)A->in[11] + (size_t)l * D,
                          (bf16*)(ws + WS_ST), (float*)(ws + WS_NPREV), (float*)(ws + WS_MPREV), tid, lane, wave, vcu, G);
                SEAM(mb + 2); }
            if (IN(mb + 3)) { TIDS(); const auto* A = ARGS(); unsigned char* ws = A->ws;
                mb_simple(lds, (const bf16*)(ws + WS_Z), (const float2*)(ws + WS_ROPE), (const float*)(ws + WS_GATES), (const float*)A->in[10] + (size_t)l * 4 * D, (const float*)A->in[11] + (size_t)l * D,
                          (const bf16*)(ws + WS_ST), (const float*)(ws + WS_NPREV), (const float*)(ws + WS_MPREV), (const float*)A->in[14] + (size_t)l * 512, (const float*)A->in[15] + (size_t)l * 512, (bf16*)(ws + WS_H),
                          tid, lane, wave, vcu, G);
                SEAM(mb + 3); }
            if (IN(mb + 4)) { const auto* A = ARGS(); unsigned char* ws = A->ws;
                pg8::Gemm g{(const bf16*)(ws + WS_H), (const bf16*)(ws + WS_W + (size_t)l * LW_BYTES + LW_WOUT), M, D, D}; pg8::StaticOrder S; S.init(M, D, G, bx);
                pg8::EpiResid E{A->out, A->out, (const float*)(ws + WS_MOD) + (size_t)(l * 3 + 1) * BATCH * 3 * D + 2 * D, 3 * D, 1.0f};
                pg8::gemm_phase<pg8::EpiResid, pg8::StaticOrder, true, true>(lds, g, S, E);
                SEAM(mb + 4);
            }
        }
    }
    if (IN(NPHASE - 1)) { TIDS(); const auto* A = ARGS(); final_norm_phase(A->out, (const float*)A->in[17], gw, NGW, lane); }
#undef ARGS
#undef TIDS
#undef IN
#undef SEAM
}

extern "C" void kernel_launch(void* const* d_in, const int* in_sizes, int n_in, void* d_out, int out_size, void* d_ws, size_t ws_size, hipStream_t stream) {
    static int grid = 0;
    if (grid == 0) {
        if (n_in != 18 || in_sizes[0] != M * D || out_size != M * D || ws_size < WS_END) { fprintf(stderr, "kernel_launch: unexpected shapes (n_in %d, in0 %d, out %d, ws %zu)\n", n_in, n_in > 0 ? in_sizes[0] : -1, out_size, ws_size); grid = -1; return; }
        int dev = 0, cus = 0, per_cu = 0;
        if (hipGetDevice(&dev) != hipSuccess || hipDeviceGetAttribute(&cus, hipDeviceAttributeMultiprocessorCount, dev) != hipSuccess) { grid = -1; return; }
        if (hipFuncSetAttribute((const void*)mk_fwd, hipFuncAttributeMaxDynamicSharedMemorySize, LDS_BYTES) != hipSuccess) { fprintf(stderr, "kernel_launch: hipFuncSetAttribute failed\n"); grid = -1; return; }
        if (hipOccupancyMaxActiveBlocksPerMultiprocessor(&per_cu, (const void*)mk_fwd, NWAVES * 64, LDS_BYTES) != hipSuccess || per_cu < 1) { fprintf(stderr, "kernel_launch: occupancy query says %d\n", per_cu); }
        (void)hipGetLastError();
        grid = cus;
    }
    if (grid < 0) return;
    if (hipMemsetAsync((char*)d_ws + WS_CTL, 0, CTL_ZERO_BYTES, stream) != hipSuccess) return;
    Args a{};
    for (int i = 0; i < 18; ++i) a.in[i] = d_in[i];
    a.out = (float*)d_out; a.ws = (unsigned char*)d_ws; a.pad = 0;
#if MK_ONE_LAUNCH
    a.ph_lo = 0; a.ph_hi = NPHASE; a.li = 0;
    hipLaunchKernelGGL(mk_fwd, dim3(grid), dim3(NWAVES * 64), LDS_BYTES, stream, a);
#else
    for (int li = 0; li < NPHASE; ++li) { a.ph_lo = li; a.ph_hi = li + 1; a.li = li;
        hipLaunchKernelGGL(mk_fwd, dim3(grid), dim3(NWAVES * 64), LDS_BYTES, stream, a); }
#endif
}
```

```cpp
#define MK_ONE_LAUNCH 1
#define MA_FN ma_fast
#define MB_FN mb_fast
#include <hip/hip_runtime.h>
#include <cstdio>
#include <cstdint>
namespace pg8 {
#define PG8_LAS __attribute__((address_space(3)))
typedef unsigned short bf16_t;
typedef short bf16x8 __attribute__((ext_vector_type(8)));
typedef float f32x4 __attribute__((ext_vector_type(4)));
typedef unsigned u32x4 __attribute__((ext_vector_type(4)));
constexpr int BM = 256, BK = 64, HALF = 128, HTB = HALF * BK * 2  , STAGE_BYTES = 8 * HTB, NXCD = 8, WGM = 8;

__host__ __device__ __forceinline__ int lds_byte(int r, int c) { const int st = (r >> 4) * 2 + (c >> 5), rr = r & 15, cc = c & 31, ob = rr * 64 + cc * 2; return st * 1024 + (ob ^ (((ob >> 9) & 1) << 5)); }
__host__ __device__ __forceinline__ void stage_rc(int b, int& R, int& C) { const int st = b / 1024, sb = b % 1024, swz = sb ^ (((sb >> 9) & 1) << 5); R = (st >> 1) * 16 + swz / 64; C = (st & 1) * 32 + (swz % 64) / 2; }
__host__ __device__ __forceinline__ int perm32(int rho) { const int n = rho >> 4, i = rho & 15; return 8 * (i >> 2) + 4 * n + (i & 3); }

struct Unit { int pm, pn; };
struct Gemm { const bf16_t* A; const bf16_t* Bt; int M, N, K; };

struct StaticOrder {
    int nM, nN, nwg, G, c;
    __host__ __device__ void init(int M, int N, int G_, int c_) { nM = M / BM; nN = N / BM; nwg = nM * nN; G = G_; c = c_; }
    __host__ __device__ bool next(int i, Unit& u) const {
        const long L = (long)i * G + c; if (L >= nwg) return false;
        int wgid = (int)L; { const int q = nwg / NXCD, r = nwg % NXCD, xcd = wgid % NXCD, off = wgid / NXCD; wgid = (xcd < r ? xcd * (q + 1) : r * (q + 1) + (xcd - r) * q) + off; }
        const int nig = WGM * nN, gid = wgid / nig, fm = gid * WGM, gsz = (nM - fm) < WGM ? (nM - fm) : WGM;
        u.pm = fm + ((wgid % nig) % gsz); u.pn = (wgid % nig) / gsz; return true;
    }
    __device__ __forceinline__ void a_ready(const Unit&) const {}
    __device__ __forceinline__ void done(const Unit&) const {}
};

__device__ __forceinline__ unsigned cvt_pk_bf16(float lo, float hi) { unsigned r; asm volatile("v_cvt_pk_bf16_f32 %0, %1, %2" : "=v"(r) : "v"(lo), "v"(hi)); return r; }
__device__ __forceinline__ float silu_f(float g) { return g * __builtin_amdgcn_rcpf(1.0f + __expf(-g)); }

struct EpiSwiglu {
    static constexpr bool PERM = true, AFTER_DRAIN = false;
    bf16_t* U; int ldc;
    __device__ __forceinline__ void operator()(const f32x4 (&acc)[2][2][4][2], const Unit& u, int wr, int wc, int fr, int fq) const {
        const int row0 = u.pm * BM + wr * 64 + fr, col0 = u.pn * HALF + wc * 32 + 8 * fq;
#pragma unroll
        for (int ai = 0; ai < 2; ++ai)
#pragma unroll
            for (int m = 0; m < 4; ++m) { bf16_t* rowp = U + (size_t)(row0 + ai * HALF + m * 16) * ldc + col0;
                f32x4 v0, v1;
#pragma unroll
                for (int j = 0; j < 4; ++j) { v0[j] = silu_f(acc[ai][0][m][0][j]) * acc[ai][1][m][0][j]; v1[j] = silu_f(acc[ai][0][m][1][j]) * acc[ai][1][m][1][j]; }
                u32x4 w; w.x = cvt_pk_bf16(v0[0], v0[1]); w.y = cvt_pk_bf16(v0[2], v0[3]); w.z = cvt_pk_bf16(v1[0], v1[1]); w.w = cvt_pk_bf16(v1[2], v1[3]);
                *(u32x4*)rowp = w; }
    }
};
struct EpiZ {
    static constexpr bool PERM = true, AFTER_DRAIN = false;
    bf16_t* O; int ldc;
    __device__ __forceinline__ void operator()(const f32x4 (&acc)[2][2][4][2], const Unit& u, int wr, int wc, int fr, int fq) const {
        const int row0 = u.pm * BM + wr * 64 + fr, col0 = u.pn * BM + wc * 32 + 8 * fq;
#pragma unroll
        for (int ai = 0; ai < 2; ++ai)
#pragma unroll
            for (int m = 0; m < 4; ++m) { bf16_t* rowp = O + (size_t)(row0 + ai * HALF + m * 16) * ldc + col0;
#pragma unroll
                for (int bj = 0; bj < 2; ++bj) { const f32x4 v0 = acc[ai][bj][m][0], v1 = acc[ai][bj][m][1];
                    u32x4 w; w.x = cvt_pk_bf16(v0[0], v0[1]); w.y = cvt_pk_bf16(v0[2], v0[3]); w.z = cvt_pk_bf16(v1[0], v1[1]); w.w = cvt_pk_bf16(v1[2], v1[3]);
                    *(u32x4*)(rowp + bj * HALF) = w; } }
    }
};
struct EpiResid {
    static constexpr bool PERM = false, AFTER_DRAIN = false;
    const float* base; float* out; const float* gate; int gstride; float coef;
    __device__ __forceinline__ void operator()(const f32x4 (&acc)[2][2][4][2], const Unit& u, int wr, int wc, int fr, int fq) const {
        const int row0 = u.pm * BM + wr * 64 + fr, col0 = u.pn * BM + wc * 32 + 4 * fq;
        const float* gp = gate + (size_t)(u.pm >> 4) * gstride + col0;
        f32x4 gv[2][2];
#pragma unroll
        for (int bj = 0; bj < 2; ++bj)
#pragma unroll
            for (int n = 0; n < 2; ++n) gv[bj][n] = *(const f32x4*)(gp + bj * HALF + n * 16) * coef;
#pragma unroll
        for (int ai = 0; ai < 2; ++ai)
#pragma unroll
            for (int m = 0; m < 4; ++m) { const size_t off = (size_t)(row0 + ai * HALF + m * 16) * 1024 + col0;
#pragma unroll
                for (int bj = 0; bj < 2; ++bj)
#pragma unroll
                    for (int n = 0; n < 2; ++n) { const f32x4 bs = *(const f32x4*)(base + off + bj * HALF + n * 16);
                        *(f32x4*)(out + off + bj * HALF + n * 16) = bs + gv[bj][n] * acc[ai][bj][m][n]; } }
    }
};
template <class Epi, class Sched, bool ALIGN_EPI = false, bool SP2 = false>
__device__ __forceinline__ void gemm_phase(PG8_LAS unsigned char* lds, const Gemm g, const Sched& S, const Epi& E) {
    int tid = threadIdx.x; asm volatile("" : "+v"(tid));
    const int wid = __builtin_amdgcn_readfirstlane(tid >> 6), lane = tid & 63, wr = wid >> 2, wc = wid & 3, fr = lane & 15, fq = lane >> 4;
    const int K = g.K, nt = K / BK;
    unsigned voffA[2], voffB[2];
#pragma unroll
    for (int i = 0; i < 2; ++i) { int R, C; stage_rc(tid * 16 + i * 8192, R, C); const int Rb = Epi::PERM ? ((R & ~31) + perm32(R & 31)) : R;
        voffA[i] = (unsigned)(R * K + C) * 2u; voffB[i] = (unsigned)(Rb * K + C) * 2u; }
    const size_t kstep = (size_t)(BK * 2);
    const size_t hstep = (size_t)HALF * K * 2;
    const size_t tstep = 2 * hstep;
    const unsigned ldsw = (unsigned)wid * 1024u;
    const int aoff = lds_byte(wr * 64 + fr, fq * 8), boff = lds_byte(wc * 32 + fr, fq * 8);
#define PG8_SA(b, h) (((b) * 2 + (h)) * HTB)
#define PG8_SB(b, h) ((4 + (b) * 2 + (h)) * HTB)
#define PG8_STAGE(bufoff, gbase, voff) do { _Pragma("unroll") for (int _i = 0; _i < 2; ++_i) \
        __builtin_amdgcn_global_load_lds((const unsigned*)((const char*)(gbase) + (voff)[_i]), (PG8_LAS unsigned*)(lds + (bufoff) + ldsw + _i * 8192), 16, 0, 0); } while (0)
#define PG8_LDA(dst, b, h) do { _Pragma("unroll") for (int m = 0; m < 4; ++m) _Pragma("unroll") for (int k = 0; k < 2; ++k) dst[m][k] = *(const PG8_LAS bf16x8*)(lds + PG8_SA(b, h) + aoff + m * 2048 + k * 1024); } while (0)
#define PG8_LDB(dst, b, h) do { _Pragma("unroll") for (int n = 0; n < 2; ++n) _Pragma("unroll") for (int k = 0; k < 2; ++k) dst[n][k] = *(const PG8_LAS bf16x8*)(lds + PG8_SB(b, h) + boff + n * 2048 + k * 1024); } while (0)
#define PG8_MMA(ai, bj, At, Bt) do { __builtin_amdgcn_s_setprio(1); _Pragma("unroll") for (int m = 0; m < 4; ++m) _Pragma("unroll") for (int n = 0; n < 2; ++n) _Pragma("unroll") for (int k = 0; k < 2; ++k) \
        acc[ai][bj][m][n] = __builtin_amdgcn_mfma_f32_16x16x32_bf16(Bt[n][k], At[m][k], acc[ai][bj][m][n], 0, 0, 0); __builtin_amdgcn_s_setprio(0); } while (0)
#define PG8_WAIT_V(n) asm volatile("s_waitcnt vmcnt(" #n ")" ::: "memory")
#define PG8_WAIT_L(n) asm volatile("s_waitcnt lgkmcnt(" #n ")" ::: "memory")
#define PG8_BAR __builtin_amdgcn_s_barrier()
#define PG8_SCHED __builtin_amdgcn_sched_barrier(0)
    Unit cur, nxt; int ui = 0;
    if (!S.next(0, cur)) return;
    f32x4 acc[2][2][4][2];
#pragma unroll
    for (int a = 0; a < 2; ++a)
#pragma unroll
        for (int b = 0; b < 2; ++b)
#pragma unroll
            for (int m = 0; m < 4; ++m)
#pragma unroll
                for (int n = 0; n < 2; ++n) acc[a][b][m][n] = (f32x4){0.f, 0.f, 0.f, 0.f};
    bf16x8 At[4][2], B0[2][2], B1[2][2];
    const char* cA = (const char*)g.A + (size_t)cur.pm * tstep; const char* cB = (const char*)g.Bt + (size_t)cur.pn * tstep;
    S.a_ready(cur);
    if constexpr (SP2) {
        PG8_STAGE(PG8_SB(0, 0), cB, voffB); PG8_STAGE(PG8_SB(0, 1), cB + hstep, voffB); PG8_STAGE(PG8_SA(0, 0), cA, voffA); PG8_STAGE(PG8_SA(0, 1), cA + hstep, voffA);
        if (wr == 1) PG8_BAR;
        PG8_WAIT_V(2); PG8_BAR;
        PG8_STAGE(PG8_SB(1, 0), cB + kstep, voffB); PG8_STAGE(PG8_SA(1, 0), cA + kstep, voffA); PG8_STAGE(PG8_SB(1, 1), cB + hstep + kstep, voffB);
        PG8_WAIT_V(6); PG8_BAR;
    } else {
        PG8_STAGE(PG8_SB(0, 0), cB, voffB); PG8_STAGE(PG8_SA(0, 0), cA, voffA); PG8_STAGE(PG8_SB(0, 1), cB + hstep, voffB); PG8_STAGE(PG8_SA(0, 1), cA + hstep, voffA);
        if (wr == 1) PG8_BAR;
        PG8_WAIT_V(4); PG8_BAR;
        PG8_STAGE(PG8_SB(1, 0), cB + kstep, voffB); PG8_STAGE(PG8_SA(1, 0), cA + kstep, voffA); PG8_STAGE(PG8_SB(1, 1), cB + hstep + kstep, voffB);
        PG8_WAIT_V(6); PG8_BAR;
    }
    for (;;) {
        const bool has_next = S.next(ui + 1, nxt);
        const char* nA = has_next ? (const char*)g.A + (size_t)nxt.pm * tstep : cA; const char* nB = has_next ? (const char*)g.Bt + (size_t)nxt.pn * tstep : cB;
        for (int t = 0; t < nt; t += 2) {
            const bool last = (t == nt - 2);
            const char* a1 = cA + (size_t)(t + 1) * kstep;
            const char* a2 = last ? nA : cA + (size_t)(t + 2) * kstep; const char* b2 = last ? nB : cB + (size_t)(t + 2) * kstep;
            const char* a3 = a2 + kstep; const char* b3 = b2 + kstep;
            if (last && has_next) S.a_ready(nxt);
            if constexpr (SP2) {
            PG8_LDB(B0, 0, 0); PG8_LDB(B1, 0, 1); PG8_SCHED; PG8_LDA(At, 0, 0); PG8_STAGE(PG8_SA(1, 1), a1 + hstep, voffA);
            PG8_WAIT_V(8); PG8_WAIT_L(0); PG8_BAR; PG8_MMA(0, 0, At, B0); PG8_MMA(0, 1, At, B1); PG8_BAR; PG8_SCHED;
            PG8_LDA(At, 0, 1); PG8_STAGE(PG8_SB(0, 0), b2, voffB); PG8_STAGE(PG8_SB(0, 1), b2 + hstep, voffB); PG8_STAGE(PG8_SA(0, 0), a2, voffA);
            PG8_WAIT_V(8); PG8_WAIT_L(0); PG8_BAR; PG8_MMA(1, 0, At, B0); PG8_MMA(1, 1, At, B1); PG8_BAR; PG8_SCHED;
            PG8_LDB(B0, 1, 0); PG8_LDB(B1, 1, 1); PG8_SCHED; PG8_LDA(At, 1, 0); PG8_STAGE(PG8_SA(0, 1), a2 + hstep, voffA);
            PG8_WAIT_V(8); PG8_WAIT_L(0); PG8_BAR; PG8_MMA(0, 0, At, B0); PG8_MMA(0, 1, At, B1); PG8_BAR; PG8_SCHED;
            PG8_LDA(At, 1, 1); PG8_STAGE(PG8_SB(1, 0), b3, voffB); PG8_STAGE(PG8_SB(1, 1), b3 + hstep, voffB); PG8_STAGE(PG8_SA(1, 0), a3, voffA);
            PG8_WAIT_V(8); PG8_WAIT_L(0); PG8_BAR; PG8_MMA(1, 0, At, B0); PG8_MMA(1, 1, At, B1); PG8_BAR; PG8_SCHED;
            } else {
            PG8_LDB(B0, 0, 0); PG8_SCHED; PG8_LDA(At, 0, 0); PG8_STAGE(PG8_SA(1, 1), a1 + hstep, voffA);
            PG8_WAIT_L(8); PG8_BAR; PG8_WAIT_L(0); PG8_MMA(0, 0, At, B0); PG8_BAR; PG8_SCHED;
            PG8_LDB(B1, 0, 1); PG8_STAGE(PG8_SB(0, 0), b2, voffB);
            PG8_BAR; PG8_WAIT_L(0); PG8_MMA(0, 1, At, B1); PG8_BAR;
            PG8_LDA(At, 0, 1); PG8_STAGE(PG8_SA(0, 0), a2, voffA);
            PG8_BAR; PG8_WAIT_L(0); PG8_MMA(1, 0, At, B0); PG8_BAR; PG8_SCHED;
            PG8_STAGE(PG8_SB(0, 1), b2 + hstep, voffB);
            PG8_WAIT_V(6); PG8_BAR; PG8_MMA(1, 1, At, B1); PG8_BAR;
            PG8_LDB(B0, 1, 0); PG8_SCHED; PG8_LDA(At, 1, 0); PG8_STAGE(PG8_SA(0, 1), a2 + hstep, voffA);
            PG8_WAIT_L(8); PG8_BAR; PG8_WAIT_L(0); PG8_MMA(0, 0, At, B0); PG8_BAR; PG8_SCHED;
            PG8_LDB(B1, 1, 1); PG8_STAGE(PG8_SB(1, 0), b3, voffB);
            PG8_BAR; PG8_WAIT_L(0); PG8_MMA(0, 1, At, B1); PG8_BAR;
            PG8_LDA(At, 1, 1); PG8_STAGE(PG8_SA(1, 0), a3, voffA);
            PG8_BAR; PG8_WAIT_L(0); PG8_MMA(1, 0, At, B0); PG8_BAR; PG8_SCHED;
            PG8_STAGE(PG8_SB(1, 1), b3 + hstep, voffB);
            PG8_WAIT_V(6); PG8_BAR; PG8_MMA(1, 1, At, B1); PG8_BAR;
            }
        }
        if constexpr (ALIGN_EPI) { if (wr == 0) PG8_BAR; }
        if constexpr (!Epi::AFTER_DRAIN) { E(acc, cur, wr, wc, fr, fq); S.done(cur); }
        if (!has_next) break;
#pragma unroll
        for (int a = 0; a < 2; ++a)
#pragma unroll
            for (int b = 0; b < 2; ++b)
#pragma unroll
                for (int m = 0; m < 4; ++m)
#pragma unroll
                    for (int n = 0; n < 2; ++n) acc[a][b][m][n] = (f32x4){0.f, 0.f, 0.f, 0.f};
        cur = nxt; cA = nA; cB = nB; ++ui;
        if constexpr (ALIGN_EPI) { if (wr == 1) PG8_BAR; }
    }
    PG8_WAIT_V(0);
    if constexpr (!ALIGN_EPI) { if (wr == 0) PG8_BAR; }
    PG8_BAR;
    if constexpr (Epi::AFTER_DRAIN) { E.fused(acc, cur, wr, wc, fr, fq, lds, wid, lane); S.done(cur); }
#undef PG8_SA
#undef PG8_SB
#undef PG8_STAGE
#undef PG8_LDA
#undef PG8_LDB
#undef PG8_MMA
#undef PG8_WAIT_V
#undef PG8_WAIT_L
#undef PG8_BAR
#undef PG8_SCHED
}
}

constexpr int NWAVES = 8;
#ifndef MK_ONE_LAUNCH
#define MK_ONE_LAUNCH 1
#endif

constexpr int BATCH = 8, SEQ = 4096, D = 1024, DEPTH = 2, DFF = 2816, NH = 4, DH = 128, CHUNK = 128, NCH = SEQ / CHUNK, DIN = 4104, DZ = 4096;
constexpr int M = BATCH * SEQ;
constexpr float EPS = 1e-6f;
constexpr int NPHASE = 24;

constexpr size_t MiB = 1u << 20;
constexpr size_t WS_CTL = 0, CTL_ZERO_BYTES = 1 * MiB;
constexpr size_t WS_MOD = 1 * MiB;
constexpr size_t WS_GATES = 2 * MiB;
constexpr size_t WS_NPREV = 3 * MiB;
constexpr size_t WS_MPREV = 3 * MiB + 768 * 1024;
constexpr size_t WS_ROPE = 4 * MiB;
constexpr size_t WS_W = 20 * MiB;
constexpr size_t W13_BYTES = (size_t)2 * DFF * D * 2, W2_BYTES = (size_t)D * DFF * 2, WIN_BYTES = (size_t)DZ * D * 2, WOUT_BYTES = (size_t)D * D * 2;
constexpr size_t LW_W13 = 0, LW_W2 = 2 * W13_BYTES, LW_WIN = LW_W2 + 2 * W2_BYTES, LW_WOUT = LW_WIN + WIN_BYTES, LW_BYTES = LW_WOUT + WOUT_BYTES;
constexpr size_t WS_H = 106 * MiB;
constexpr size_t WS_ST = 170 * MiB;
constexpr size_t WS_Z = 234 * MiB;
constexpr size_t WS_END = 490 * MiB;
static_assert(WS_W + DEPTH * LW_BYTES <= WS_H && WS_H + (size_t)M * D * 2 <= WS_ST && WS_ST + (size_t)2 * BATCH * NH * NCH * 16384 * 2 <= WS_Z && WS_Z + (size_t)M * DZ * 2 <= WS_END, "d_ws map");
constexpr int CW_BAR = 4096;

constexpr int RING_BYTES = 131072;
constexpr int SM_OFF = RING_BYTES;
constexpr int MISC_OFF = 151552;
constexpr int LDS_BYTES = 155648;
static_assert(MISC_OFF + 128 <= LDS_BYTES, "LDS map");

#define GAS __attribute__((address_space(1)))
#define LAS __attribute__((address_space(3)))
typedef unsigned short bf16;
typedef unsigned v4u __attribute__((ext_vector_type(4)));
typedef float f32x4 __attribute__((ext_vector_type(4)));
typedef GAS unsigned gu32;
#define RLX_AGENT __ATOMIC_RELAXED, __HIP_MEMORY_SCOPE_AGENT
#define LDS_WAIT() asm volatile("s_waitcnt lgkmcnt(0)" ::: "memory")
#define VM_WAIT() asm volatile("s_waitcnt vmcnt(0)" ::: "memory")
__device__ __forceinline__ unsigned f2bf(float f) { unsigned u = __builtin_bit_cast(unsigned, f); return (u + 0x7fffu + ((u >> 16) & 1u)) >> 16; }
__device__ __forceinline__ unsigned pk2(float lo, float hi) { return f2bf(lo) | (f2bf(hi) << 16); }
__device__ __forceinline__ float bf2f(unsigned short v) { return __builtin_bit_cast(float, (unsigned)v << 16); }
__device__ __forceinline__ float bflo(unsigned w) { return __builtin_bit_cast(float, w << 16); }
__device__ __forceinline__ float bfhi(unsigned w) { return __builtin_bit_cast(float, w & 0xffff0000u); }
__device__ __forceinline__ float wave_sum(float v) {
#pragma unroll
    for (int o = 1; o < 64; o <<= 1) v += __shfl_xor(v, o);
    return v;
}
__device__ __forceinline__ float wave_max(float v) {
#pragma unroll
    for (int o = 1; o < 64; o <<= 1) v = fmaxf(v, __shfl_xor(v, o));
    return v;
}
__device__ __forceinline__ float silu_acc(float x) { return x / (1.0f + expf(-x)); }
__device__ __forceinline__ float sigmoid_acc(float x) { return 1.0f / (1.0f + expf(-x)); }
__device__ __forceinline__ float logsigmoid_acc(float x) { return fminf(x, 0.0f) - log1pf(expf(-fabsf(x))); }
#define XB_TMO      128
#define XB_XCNT(j)  (256  + 64 * (j))
#define XB_XSUB(j)  (1280 + 64 * (j))
#define XB_XGEN(j)  (2304 + 64 * (j))
#define XB_TOP      3328
#define XB_TOPGEN   3392
#define XCD_BAR_WORDS 3456
#define XB_SPIN_CAP (1u << 18)

__device__ __forceinline__ unsigned xb_ld(unsigned* p)              { return __hip_atomic_load(p, __ATOMIC_RELAXED, __HIP_MEMORY_SCOPE_AGENT); }
__device__ __forceinline__ unsigned xb_add(unsigned* p, unsigned v) { return __hip_atomic_fetch_add(p, v, __ATOMIC_RELAXED, __HIP_MEMORY_SCOPE_AGENT); }
__device__ __forceinline__ unsigned xb_xcc_id() { return (unsigned)__builtin_amdgcn_s_getreg((3 << 11) | 20) & 0xFu; }
#define XB_SPIN(cond, bar) do { unsigned _sp = 0; while (cond) { __builtin_amdgcn_s_sleep(1); \
    if ((++_sp & 255u) == 0u) { if (xb_ld(&(bar)[XB_TMO])) break; if (_sp > XB_SPIN_CAP) { atomicAdd(&(bar)[XB_TMO], 1u); break; } } } } while (0)

struct XcdBarrier {
    unsigned* bar; unsigned x;
    volatile LAS unsigned* st;
};

__device__ __forceinline__ XcdBarrier xcd_barrier_post(unsigned* bar, volatile LAS unsigned* st) {
    XcdBarrier b; b.bar = bar; b.x = xb_xcc_id(); b.st = st;
    if (threadIdx.x == 0) (void)xb_add(&bar[XB_XCNT(b.x)], 1u);
    return b;
}
__device__ __forceinline__ void xcd_barrier_complete(unsigned* bar, unsigned x, unsigned& nloc, unsigned& nx) {
    const unsigned G = gridDim.x * gridDim.y * gridDim.z;
    unsigned sum, cnt, mine, sp = 0u;
    for (;;) {
        sum = 0u; cnt = 0u; mine = 0u;
#pragma unroll
        for (unsigned j = 0; j < 16; ++j) { const unsigned c = xb_ld(&bar[XB_XCNT(j)]); sum += c; cnt += (c > 0u) ? 1u : 0u; mine = (j == x) ? c : mine; }
        if (sum == G) break;
        __builtin_amdgcn_s_sleep(1);
        if ((++sp & 255u) == 0u) { if (xb_ld(&bar[XB_TMO])) break; if (sp > XB_SPIN_CAP) { atomicAdd(&bar[XB_TMO], 1u); break; } }
    }
    nloc = mine > 0u ? mine : 1u; nx = cnt > 0u ? cnt : 1u;
}

__device__ __forceinline__ void xcd_barrier(const XcdBarrier& b) {
    asm volatile("s_waitcnt vmcnt(0)" ::: "memory");
    __syncthreads();
    if (threadIdx.x == 0) {
        unsigned* bar = b.bar;
        __builtin_amdgcn_s_waitcnt(0);
        unsigned nloc = b.st[0], nx = b.st[1];
        if (nloc == 0u) { xcd_barrier_complete(bar, b.x, nloc, nx); b.st[0] = nloc; b.st[1] = nx; }
        const unsigned old = xb_add(&bar[XB_XSUB(b.x)], 1u);
        const unsigned gen = old / nloc;
        if (old + 1u == (gen + 1u) * nloc) {
            __builtin_amdgcn_fence(__ATOMIC_RELEASE, "agent");
            asm volatile("s_waitcnt vmcnt(0)" ::: "memory");
            const unsigned og = xb_add(&bar[XB_TOP], 1u);
            const unsigned tg = og / nx;
            if (og + 1u == (tg + 1u) * nx) xb_add(&bar[XB_TOPGEN], 1u);
            else XB_SPIN(xb_ld(&bar[XB_TOPGEN]) == tg, bar);
            __builtin_amdgcn_fence(__ATOMIC_ACQUIRE, "agent");
            xb_add(&bar[XB_XGEN(b.x)], 1u);
            asm volatile("s_waitcnt vmcnt(0)" ::: "memory");
        } else {
            XB_SPIN(xb_ld(&bar[XB_XGEN(b.x)]) == gen, bar);
            __builtin_amdgcn_fence(__ATOMIC_ACQUIRE, "agent");
            asm volatile("s_waitcnt vmcnt(0)" ::: "memory");
        }
    }
    __syncthreads();
}

__device__ __forceinline__ void p0_transpose_item(const float* W, int ldw, int K, bf16* WT, int dst_row0, LAS float* scr, int k0, int n0, int lane) {
#pragma unroll 8
    for (int i = 0; i < 32; ++i) { const int kk = 2 * i + (lane >> 5); scr[kk * 33 + (lane & 31)] = W[(size_t)(k0 + kk) * ldw + n0 + (lane & 31)]; }
    LDS_WAIT(); asm volatile("" ::: "memory");
    const int c = lane & 7;
#pragma unroll
    for (int j = 0; j < 4; ++j) { const int n = (lane >> 3) + 8 * j; const LAS float* s = scr + (8 * c) * 33 + n;
        v4u o; o.x = pk2(s[0 * 33], s[1 * 33]); o.y = pk2(s[2 * 33], s[3 * 33]); o.z = pk2(s[4 * 33], s[5 * 33]); o.w = pk2(s[6 * 33], s[7 * 33]);
        *(GAS v4u*)(WT + (size_t)(dst_row0 + n) * K + k0 + 8 * c) = o; }
    LDS_WAIT(); asm volatile("" ::: "memory");
}
__device__ __forceinline__ void sincos_d(double a, double& s, double& c) {
    const double k = __builtin_rint(a * 0.63661977236758134308);
    double t = __builtin_fma(-k, 1.57079632679489655800e+00, a); t = __builtin_fma(-k, 6.12323399573676603587e-17, t);
    const double t2 = t * t;
    double sp = 1.0 / 6227020800.0; sp = sp * t2 - 1.0 / 39916800.0; sp = sp * t2 + 1.0 / 362880.0; sp = sp * t2 - 1.0 / 5040.0; sp = sp * t2 + 1.0 / 120.0; sp = sp * t2 - 1.0 / 6.0; sp = sp * t2 + 1.0;
    const double st = sp * t;
    double cp = -1.0 / 87178291200.0; cp = cp * t2 + 1.0 / 479001600.0; cp = cp * t2 - 1.0 / 3628800.0; cp = cp * t2 + 1.0 / 40320.0; cp = cp * t2 - 1.0 / 720.0; cp = cp * t2 + 1.0 / 24.0; cp = cp * t2 - 0.5; cp = cp * t2 + 1.0;
    const int q = (int)((long long)k & 3ll);
    s = (q == 0) ? st : (q == 1) ? cp : (q == 2) ? -st : -cp;
    c = (q == 0) ? cp : (q == 1) ? -st : (q == 2) ? -cp : st;
}

__device__ __forceinline__ void prologue_phase(LAS unsigned char* lds, const void* const* in, unsigned char* ws, int tid, int lane, int wave, int vcu, int G) {
    const float* cvec = (const float*)in[1]; const int* positions = (const int*)in[2];
    const float* w_ada = (const float*)in[4]; const float* b_ada = (const float*)in[5];
    {
        LAS float* sc = (LAS float*)lds;
        LAS float* part = (LAS float*)(lds + 32768);
        float* mod = (float*)(ws + WS_MOD);
        for (int i = tid; i < BATCH * D; i += NWAVES * 64) sc[i] = silu_acc(cvec[i]);
        __syncthreads();
        for (int u = vcu; u < DEPTH * 3 * 48; u += G) {
            const int ls = u / 48, n0 = (u % 48) * 64;
            const float* W = w_ada + (size_t)ls * D * 3 * D + n0 + lane;
            float acc[8];
#pragma unroll
            for (int b = 0; b < 8; ++b) acc[b] = 0.f;
            const int k0 = wave * 128;
#pragma unroll 8
            for (int k = 0; k < 128; ++k) { const float w = W[(size_t)(k0 + k) * (3 * D)];
#pragma unroll
                for (int b = 0; b < 8; ++b) acc[b] += sc[b * D + k0 + k] * w; }
#pragma unroll
            for (int b = 0; b < 8; ++b) part[(wave * 8 + b) * 64 + lane] = acc[b];
            __syncthreads();
            { const int b = tid >> 6, col = tid & 63; float s = b_ada[(size_t)ls * 3 * D + n0 + col];
#pragma unroll
              for (int w = 0; w < 8; ++w) s += part[(w * 8 + b) * 64 + col];
              mod[((size_t)ls * BATCH + b) * (3 * D) + n0 + col] = s; }
            __syncthreads();
        }
    }
    {
        float2* rope = (float2*)(ws + WS_ROPE);
        const int gtid = vcu * (NWAVES * 64) + tid, nth = G * NWAVES * 64;
        for (int idx = gtid; idx < M * 64; idx += nth) {
            const int row = idx >> 6, i = idx & 63;
            double r = 1.0, p = 0.8659643233600653;
#pragma unroll
            for (int bit = 0; bit < 6; ++bit) { if ((i >> bit) & 1) r *= p; p *= p; }
            const float invf = (float)r; const float ang = (float)positions[row] * invf;
            double s, c; sincos_d((double)ang, s, c);
            rope[idx] = make_float2((float)c, (float)s);
        }
    }
    {
        LAS float* scr = (LAS float*)(lds + wave * 16384);
        const int gw = vcu * NWAVES + wave, NGW = G * NWAVES;
        constexpr int I_13 = (D / 64) * (DFF / 32), I_2 = (DFF / 64) * (D / 32), I_IN = (D / 64) * (DZ / 32), I_OUT = (D / 64) * (D / 32);
        constexpr int PER_LAYER = 4 * I_13 + 2 * I_2 + I_IN + I_OUT;
        const float* w_ff1 = (const float*)in[6]; const float* w_ff3 = (const float*)in[7]; const float* w_ff2 = (const float*)in[8];
        const float* w_in = (const float*)in[9]; const float* w_out = (const float*)in[16];
        for (int it = gw; it < DEPTH * PER_LAYER; it += NGW) {
            const int l = it / PER_LAYER; int r = it % PER_LAYER;
            unsigned char* lw = ws + WS_W + (size_t)l * LW_BYTES;
            if (r < 4 * I_13) {
                const int q = r / I_13, rr = r % I_13, f = q >> 1, t = q & 1, kb = rr / (DFF / 32), nb = rr % (DFF / 32), n0 = nb * 32;
                const float* W = (t ? w_ff3 : w_ff1) + (size_t)(l * 2 + f) * D * DFF;
                p0_transpose_item(W, DFF, D, (bf16*)(lw + LW_W13 + (size_t)f * W13_BYTES), 256 * (n0 >> 7) + 128 * t + (n0 & 127), scr, kb * 64, n0, lane);
                continue; }
            r -= 4 * I_13;
            if (r < 2 * I_2) { const int f = r / I_2, rr = r % I_2, kb = rr / (D / 32), nb = rr % (D / 32);
                p0_transpose_item(w_ff2 + (size_t)(l * 2 + f) * DFF * D, D, DFF, (bf16*)(lw + LW_W2 + (size_t)f * W2_BYTES), nb * 32, scr, kb * 64, nb * 32, lane);
                continue; }
            r -= 2 * I_2;
            if (r < I_IN) { const int kb = r / (DZ / 32), nb = r % (DZ / 32);
                p0_transpose_item(w_in + (size_t)l * D * DIN, DIN, D, (bf16*)(lw + LW_WIN), nb * 32, scr, kb * 64, nb * 32, lane);
                continue; }
            r -= I_IN;
            { const int kb = r / (D / 32), nb = r % (D / 32);
              p0_transpose_item(w_out + (size_t)l * D * D, D, D, (bf16*)(lw + LW_WOUT), nb * 32, scr, kb * 64, nb * 32, lane); }
        }
    }
}

template <bool GATES>
__device__ __forceinline__ void norm_phase(LAS unsigned char* lds, const float* x, const float* g, const float* mod, bf16* hout, const float* w_in_l, const float* b_ig, const float* b_fg, float* gates,
                                           int gw, int NGW, int lane) {
    LAS f32x4* wgl = (LAS f32x4*)lds;
    if (GATES) { __syncthreads();
        for (int i = lane + 64 * (gw % NWAVES); i < D * 2; i += NWAVES * 64) wgl[i] = *(const f32x4*)(w_in_l + (size_t)(i >> 1) * DIN + DZ + 4 * (i & 1));
        __syncthreads(); }
    for (int grp = gw; grp < M / 16; grp += NGW) {
        const int row0 = grp * 16, b = row0 / SEQ;
        f32x4 gm[4], sh[4];
#pragma unroll
        for (int j = 0; j < 4; ++j) { const int col = 4 * lane + 256 * j; const f32x4 gv = *(const f32x4*)(g + col), sc = *(const f32x4*)(mod + (size_t)b * 3 * D + D + col);
            gm[j] = gv * (1.0f + sc); sh[j] = *(const f32x4*)(mod + (size_t)b * 3 * D + col); }
        float bias8 = 0.f;
        if (GATES) { if (lane < 8) bias8 = lane < 4 ? b_ig[lane] : b_fg[lane - 4]; }
        for (int r = 0; r < 16; ++r) {
            const int row = row0 + r;
            const GAS f32x4* xr = (const GAS f32x4*)(x + (size_t)row * D) + lane;
            f32x4 v[4]; float ss = 0.f;
#pragma unroll
            for (int j = 0; j < 4; ++j) { v[j] = xr[64 * j]; ss += (v[j].x * v[j].x + v[j].y * v[j].y) + (v[j].z * v[j].z + v[j].w * v[j].w); }
            const float rstd = 1.0f / sqrtf(wave_sum(ss) * (1.0f / D) + EPS);
            GAS unsigned long long* o8 = (GAS unsigned long long*)(hout + (size_t)row * D) + lane;
#pragma unroll
            for (int j = 0; j < 4; ++j) { v[j] = (v[j] * rstd) * gm[j] + sh[j];
                o8[64 * j] = (unsigned long long)pk2(v[j].x, v[j].y) | ((unsigned long long)pk2(v[j].z, v[j].w) << 32); }
            if (GATES) {
                f32x4 d0 = {0.f, 0.f, 0.f, 0.f}, d1 = {0.f, 0.f, 0.f, 0.f};
#pragma unroll
                for (int j = 0; j < 4; ++j)
#pragma unroll
                    for (int e = 0; e < 4; ++e) { const int k = 4 * lane + 256 * j + e; d0 += wgl[2 * k] * v[j][e]; d1 += wgl[2 * k + 1] * v[j][e]; }
                float mine = 0.f;
#pragma unroll
                for (int q = 0; q < 4; ++q) { const float s0 = wave_sum(d0[q]), s1 = wave_sum(d1[q]); if (lane == q) mine = s0; if (lane == 4 + q) mine = s1; }
                if (lane < 8) gates[(size_t)row * 8 + lane] = mine + bias8;
            }
        }
    }
}
__device__ __forceinline__ void final_norm_phase(float* x, const float* g, int gw, int NGW, int lane) {
    for (int grp = gw; grp < M / 16; grp += NGW) {
        f32x4 gm[4];
#pragma unroll
        for (int j = 0; j < 4; ++j) gm[j] = *(const f32x4*)(g + 4 * lane + 256 * j);
        for (int r = 0; r < 16; ++r) {
            GAS f32x4* xr = (GAS f32x4*)(x + (size_t)(grp * 16 + r) * D) + lane;
            f32x4 v[4]; float ss = 0.f;
#pragma unroll
            for (int j = 0; j < 4; ++j) { v[j] = xr[64 * j]; ss += (v[j].x * v[j].x + v[j].y * v[j].y) + (v[j].z * v[j].z + v[j].w * v[j].w); }
            const float rstd = 1.0f / sqrtf(wave_sum(ss) * (1.0f / D) + EPS);
#pragma unroll
            for (int j = 0; j < 4; ++j) xr[64 * j] = (v[j] * rstd) * gm[j];
        }
    }
}

__device__ __forceinline__ float lg2gamma(int h) { return h == 0 ? -0.04580368961312479f : h == 1 ? -0.02272007650008353f : h == 2 ? -0.011315313227834146f : -0.005646563141142063f; }
constexpr float QK_SCALE = 0.08838834764831845f;
__device__ __forceinline__ float rot_elem(const bf16* zp, const float2* rp, int l, int d) {
    const int i = d & 63; const float t1 = bf2f(zp[(size_t)l * DZ + i]), t2 = bf2f(zp[(size_t)l * DZ + 64 + i]); const float2 cs = rp[(size_t)l * 64 + i];
    return d < 64 ? t1 * cs.x - t2 * cs.y : t1 * cs.y + t2 * cs.x;
}
__device__ __forceinline__ float conv_elem(const bf16* z, int b, int s, int zc, float cw0, float cw1, float cw2, float cw3, float cb) {
    const bf16* p = z + ((size_t)b * SEQ + s) * DZ + zc;
    float a = cb + cw3 * bf2f(p[0]);
    if (s >= 1) a += cw2 * bf2f(p[-(ptrdiff_t)DZ]);
    if (s >= 2) a += cw1 * bf2f(p[-(ptrdiff_t)2 * DZ]);
    if (s >= 3) a += cw0 * bf2f(p[-(ptrdiff_t)3 * DZ]);
    return silu_acc(a);
}
__device__ __forceinline__ void ml_gate_scan(const float* gates, int row0, int h, int lane, float& bc0, float& bc1, float& ic0, float& ic1) {
    const float* gp = gates + (size_t)(row0 + 2 * lane) * 8;
    ic0 = gp[h]; ic1 = gp[8 + h];
    const float lf0 = logsigmoid_acc(gp[4 + h]), lf1 = logsigmoid_acc(gp[12 + h]);
    const float s1 = lf0 + lf1; float v = s1;
#pragma unroll
    for (int off = 1; off < 64; off <<= 1) { const float t = __shfl_up(v, off); if (lane >= off) v += t; }
    const float ex = v - s1; bc0 = ex + lf0; bc1 = ex + s1;
}

__device__ __forceinline__ void ma_simple(LAS unsigned char* lds, const bf16* z, const float2* rope, const float* gates, const float* conv_w, const float* conv_b,
                                          bf16* states, float* nprev, float* mprev, int tid, int lane, int wave, int vcu, int G) {
    LAS float* kf = (LAS float*)lds;
    LAS float* vf = (LAS float*)(lds + 65536);
    LAS float* wl = (LAS float*)(lds + SM_OFF);
    LAS float* scal = wl + 128;
    for (int u = vcu; u < 256; u += G) {
        const int g = u >> 7, b = (u >> 4) & 7, h = (u >> 2) & 3, eq = u & 3;
        const int d = tid >> 2, e8 = (tid & 3) * 8;
        float acc[8]; float nacc = 0.f, mrun = 0.f;
#pragma unroll
        for (int j = 0; j < 8; ++j) acc[j] = 0.f;
        for (int c = 0; c < NCH; ++c) {
            const int row0 = b * SEQ + c * CHUNK;
            { bf16* st = states + ((((size_t)g * BATCH + b) * NH + h) * NCH + c) * 16384 + (size_t)(eq * 32 + e8) * 128 + d;
#pragma unroll
              for (int j = 0; j < 8; ++j) st[j * 128] = (bf16)f2bf(acc[j]); }
            if (g == 1 && eq == 0) { if ((tid & 3) == 0) nprev[(((size_t)b * NH + h) * NCH + c) * 128 + d] = nacc; if (tid == 0) mprev[((size_t)b * NH + h) * NCH + c] = mrun; }
            __syncthreads();
            if (g == 0) {
                const bf16* zp = z + (size_t)row0 * DZ + 512 + 128 * h; const float2* rp = rope + (size_t)row0 * 64;
                for (int idx = tid; idx < 128 * 128; idx += NWAVES * 64) { const int l = idx >> 7, dd = idx & 127; kf[idx] = rot_elem(zp, rp, l, dd) * QK_SCALE; }
                for (int idx = tid; idx < 128 * 32; idx += NWAVES * 64) { const int l = idx >> 5, e = idx & 31; vf[idx] = bf2f(z[(size_t)(row0 + l) * DZ + 1024 + 128 * h + 32 * eq + e]); }
                if (tid < 128) wl[tid] = exp2f((float)(127 - tid) * lg2gamma(h));
                if (tid == 0) scal[0] = exp2f(128.0f * lg2gamma(h));
            } else {
                for (int idx = tid; idx < 128 * 128; idx += NWAVES * 64) { const int l = idx >> 7, dd = idx & 127, ch = 512 + 128 * h + dd;
                    kf[idx] = conv_elem(z, b, c * CHUNK + l, 2048 + ch, conv_w[ch], conv_w[1024 + ch], conv_w[2048 + ch], conv_w[3072 + ch], conv_b[ch]); }
                for (int idx = tid; idx < 128 * 32; idx += NWAVES * 64) { const int l = idx >> 5, e = idx & 31; vf[idx] = bf2f(z[(size_t)(row0 + l) * DZ + 3072 + 128 * h + 32 * eq + e]); }
                if (wave == 0) {
                    float bc0, bc1, ic0, ic1; ml_gate_scan(gates, row0, h, lane, bc0, bc1, ic0, ic1);
                    const float blast = __shfl(bc1, 63);
                    const float g0 = blast - bc0 + ic0, g1 = blast - bc1 + ic1;
                    const float gmax = wave_max(fmaxf(g0, g1));
                    const float mnew = fmaxf(blast + mrun, gmax);
                    wl[2 * lane] = expf(g0 - mnew); wl[2 * lane + 1] = expf(g1 - mnew);
                    if (lane == 0) { scal[0] = expf(blast + mrun - mnew); scal[1] = mnew; }
                }
            }
            __syncthreads();
            const float wc = scal[0];
            if (g == 1) mrun = scal[1];
#pragma unroll
            for (int j = 0; j < 8; ++j) acc[j] *= wc;
            nacc *= wc;
            for (int l = 0; l < 128; ++l) {
                const float kw = kf[l * 128 + d] * wl[l];
                const f32x4 v0 = *(const LAS f32x4*)(vf + l * 32 + e8), v1 = *(const LAS f32x4*)(vf + l * 32 + e8 + 4);
                acc[0] += kw * v0.x; acc[1] += kw * v0.y; acc[2] += kw * v0.z; acc[3] += kw * v0.w;
                acc[4] += kw * v1.x; acc[5] += kw * v1.y; acc[6] += kw * v1.z; acc[7] += kw * v1.w;
                nacc += kw;
            }
        }
        __syncthreads();
    }
}

__device__ __forceinline__ void mb_simple(LAS unsigned char* lds, const bf16* z, const float2* rope, const float* gates, const float* conv_w, const float* conv_b,
                                          const bf16* states, const float* nprev, const float* mprev, const float* g_ret, const float* g_ml, bf16* y,
                                          int tid, int lane, int wave, int vcu, int G) {
    LAS bf16* qb = (LAS bf16*)lds;
    LAS bf16* kb = (LAS bf16*)(lds + 32768);
    LAS float* P = (LAS float*)(lds + 65536);
    LAS float* bcs = (LAS float*)(lds + SM_OFF);
    LAS float* ics = bcs + 128;
    for (int u = vcu; u < 2 * BATCH * NH * NCH; u += G) {
        const int g = u >> 10, b = (u >> 7) & 7, h = (u >> 5) & 3, c = u & 31;
        const int row0 = b * SEQ + c * CHUNK;
        const int l = tid >> 2, r4 = tid & 3;
        __syncthreads();
        if (g == 0) {
            const bf16* zq = z + (size_t)row0 * DZ + 128 * h; const bf16* zk = zq + 512; const float2* rp = rope + (size_t)row0 * 64;
            for (int idx = tid; idx < 128 * 128; idx += NWAVES * 64) { const int ll = idx >> 7, dd = idx & 127;
                qb[idx] = (bf16)f2bf(rot_elem(zq, rp, ll, dd)); kb[idx] = (bf16)f2bf(rot_elem(zk, rp, ll, dd) * QK_SCALE); }
        } else {
            for (int idx = tid; idx < 128 * 128; idx += NWAVES * 64) { const int ll = idx >> 7, dd = idx & 127, chq = 128 * h + dd, chk = 512 + chq;
                qb[idx] = (bf16)f2bf(conv_elem(z, b, c * CHUNK + ll, 2048 + chq, conv_w[chq], conv_w[1024 + chq], conv_w[2048 + chq], conv_w[3072 + chq], conv_b[chq]) * QK_SCALE);
                kb[idx] = (bf16)f2bf(conv_elem(z, b, c * CHUNK + ll, 2048 + chk, conv_w[chk], conv_w[1024 + chk], conv_w[2048 + chk], conv_w[3072 + chk], conv_b[chk])); }
            if (wave == 0) { float bc0, bc1, ic0, ic1; ml_gate_scan(gates, row0, h, lane, bc0, bc1, ic0, ic1);
                bcs[2 * lane] = bc0; bcs[2 * lane + 1] = bc1; ics[2 * lane] = ic0; ics[2 * lane + 1] = ic1; }
        }
        __syncthreads();
        float rowf, mt = 0.f, bl = 0.f;
        if (g == 0) rowf = exp2f((float)(l + 1) * lg2gamma(h));
        else { const float mp = mprev[((size_t)b * NH + h) * NCH + c]; float amax = -INFINITY;
            for (int m = 0; m <= l; ++m) amax = fmaxf(amax, ics[m] - bcs[m]);
            bl = bcs[l]; mt = bl + fmaxf(amax, mp); rowf = expf(bl + mp - mt); }
        float o[32];
#pragma unroll
        for (int e = 0; e < 32; ++e) o[e] = 0.f;
        const bf16* st = states + ((((size_t)g * BATCH + b) * NH + h) * NCH + c) * 16384 + (size_t)(r4 * 32) * 128;
#pragma unroll 1
        for (int dp = 0; dp < 64; ++dp) {
            const unsigned qq = *(const LAS unsigned*)(qb + l * 128 + 2 * dp);
            const float q0 = bflo(qq), q1 = bfhi(qq);
#pragma unroll
            for (int e = 0; e < 32; ++e) { const unsigned pv = *(const unsigned*)(st + (size_t)e * 128 + 2 * dp); o[e] += q0 * bflo(pv) + q1 * bfhi(pv); }
        }
#pragma unroll
        for (int e = 0; e < 32; ++e) o[e] *= rowf;
        float psum = 0.f;
#pragma unroll 1
        for (int mm = 0; mm < 32; ++mm) {
            const int m = r4 * 32 + mm; float s = 0.f;
#pragma unroll 4
            for (int i = 0; i < 16; ++i) { const v4u t = *(const LAS v4u*)(kb + m * 128 + 8 * i); const v4u qv = *(const LAS v4u*)(qb + l * 128 + 8 * i);
                s += bflo(qv.x) * bflo(t.x) + bfhi(qv.x) * bfhi(t.x) + bflo(qv.y) * bflo(t.y) + bfhi(qv.y) * bfhi(t.y)
                   + bflo(qv.z) * bflo(t.z) + bfhi(qv.z) * bfhi(t.z) + bflo(qv.w) * bflo(t.w) + bfhi(qv.w) * bfhi(t.w); }
            float w;
            if (m > l) w = 0.f;
            else if (g == 0) w = exp2f((float)(l - m) * lg2gamma(h));
            else w = expf(bl - bcs[m] + ics[m] - mt);
            const float pv = s * w; P[l * 128 + m] = pv; psum += pv;
        }
        float qn = 0.f;
        if (g == 1) { const float* np = nprev + (((size_t)b * NH + h) * NCH + c) * 128;
#pragma unroll 4
            for (int i = 0; i < 64; ++i) { const unsigned qq = *(const LAS unsigned*)(qb + l * 128 + 2 * i); qn += bflo(qq) * np[2 * i] + bfhi(qq) * np[2 * i + 1]; } }
        __syncthreads();
        { const int vcol = (g == 0 ? 1024 : 3072) + 128 * h;
          for (int idx = tid; idx < 128 * 16; idx += NWAVES * 64) { const int m = idx >> 4, ch = idx & 15; *(LAS v4u*)(kb + m * 128 + 8 * ch) = *(const v4u*)(z + (size_t)(row0 + m) * DZ + vcol + 8 * ch); } }
        __syncthreads();
#pragma unroll 1
        for (int m = 0; m < 128; ++m) {
            const float p = P[l * 128 + m];
#pragma unroll
            for (int i = 0; i < 4; ++i) { const v4u a = *(const LAS v4u*)(kb + m * 128 + r4 * 32 + 8 * i);
                o[8 * i + 0] += p * bflo(a.x); o[8 * i + 1] += p * bfhi(a.x); o[8 * i + 2] += p * bflo(a.y); o[8 * i + 3] += p * bfhi(a.y);
                o[8 * i + 4] += p * bflo(a.z); o[8 * i + 5] += p * bfhi(a.z); o[8 * i + 6] += p * bflo(a.w); o[8 * i + 7] += p * bfhi(a.w); }
        }
        const int row = row0 + l;
        if (g == 1) {
            psum += __shfl_xor(psum, 1); psum += __shfl_xor(psum, 2);
            const float den = psum + rowf * qn; const float dd = fmaxf(fabsf(den), expf(-mt)); const float inv = 1.0f / dd;
            const bf16* zo = z + (size_t)row * DZ + 3584 + 128 * h + r4 * 32;
#pragma unroll
            for (int e = 0; e < 32; ++e) o[e] = o[e] * inv * sigmoid_acc(bf2f(zo[e]));
        }
        float s1 = 0.f;
#pragma unroll
        for (int e = 0; e < 32; ++e) s1 += o[e];
        s1 += __shfl_xor(s1, 1); s1 += __shfl_xor(s1, 2);
        const float mu = s1 * (1.0f / 128.0f); float s2 = 0.f;
#pragma unroll
        for (int e = 0; e < 32; ++e) { const float dlt = o[e] - mu; s2 += dlt * dlt; }
        s2 += __shfl_xor(s2, 1); s2 += __shfl_xor(s2, 2);
        const float rs = 1.0f / sqrtf(s2 * (1.0f / 128.0f) + EPS);
        const float* gn = (g == 0 ? g_ret : g_ml) + 128 * h + r4 * 32;
        const bf16* zg = z + (size_t)row * DZ + 1536 + 128 * h + r4 * 32;
        bf16* yo = y + (size_t)row * D + g * 512 + 128 * h + r4 * 32;
#pragma unroll
        for (int i = 0; i < 4; ++i) { float t[8];
#pragma unroll
            for (int j = 0; j < 8; ++j) { const int e = 8 * i + j; float val = (o[e] - mu) * rs * gn[e]; if (g == 0) val *= silu_acc(bf2f(zg[e])); t[j] = val; }
            v4u w; w.x = pk2(t[0], t[1]); w.y = pk2(t[2], t[3]); w.z = pk2(t[4], t[5]); w.w = pk2(t[6], t[7]);
            *(v4u*)(yo + 8 * i) = w; }
    }
}

typedef short bf16x8 __attribute__((ext_vector_type(8)));
typedef short s16x4 __attribute__((ext_vector_type(4)));
__device__ __forceinline__ unsigned cvtpk(float lo, float hi) { unsigned r; asm volatile("v_cvt_pk_bf16_f32 %0, %1, %2" : "=v"(r) : "v"(lo), "v"(hi)); return r; }
template <int OFF> __device__ __forceinline__ s16x4 tr_read(unsigned addr) { s16x4 r; asm volatile("ds_read_b64_tr_b16 %0, %1 offset:%2" : "=&v"(r) : "v"(addr), "i"(OFF) : "memory"); return r; }
#define TR_WAIT() do { asm volatile("s_waitcnt lgkmcnt(0)" ::: "memory"); __builtin_amdgcn_sched_barrier(0); } while (0)
#define PK8(L, H) (bf16x8){L[0], L[1], L[2], L[3], H[0], H[1], H[2], H[3]}
__device__ __forceinline__ float silu_fast(float x) { return x * __builtin_amdgcn_rcpf(1.0f + __expf(-x)); }
__device__ __forceinline__ float sigmoid_fast(float x) { return __builtin_amdgcn_rcpf(1.0f + __expf(-x)); }
constexpr float LOG2E = 1.4426950408889634f;

template <int NPC, int NTHR>
__device__ __forceinline__ void stage_rot(LAS bf16* dst, int ldst, int half_off, const bf16* zp0, const float2* rp0, float scale, const LAS float* rowscale, int tid) {
    for (int it = tid; it < 128 * NPC; it += NTHR) {
        const int l = it / NPC, pc = it % NPC;
        const bf16* zp = zp0 + (size_t)l * DZ + 8 * pc;
        const v4u a = *(const v4u*)zp, b = *(const v4u*)(zp + 64);
        const f32x4* rp = (const f32x4*)(rp0 + (size_t)l * 64 + 8 * pc);
        const f32x4 r0 = rp[0], r1 = rp[1], r2 = rp[2], r3 = rp[3];
        const float sc = rowscale ? scale * rowscale[l] : scale;
        const float t1[8] = {bflo(a.x), bfhi(a.x), bflo(a.y), bfhi(a.y), bflo(a.z), bfhi(a.z), bflo(a.w), bfhi(a.w)};
        const float t2[8] = {bflo(b.x), bfhi(b.x), bflo(b.y), bfhi(b.y), bflo(b.z), bfhi(b.z), bflo(b.w), bfhi(b.w)};
        const float cs[8] = {r0.x, r0.z, r1.x, r1.z, r2.x, r2.z, r3.x, r3.z}, sn[8] = {r0.y, r0.w, r1.y, r1.w, r2.y, r2.w, r3.y, r3.w};
        float o1[8], o2[8];
#pragma unroll
        for (int j = 0; j < 8; ++j) { o1[j] = (t1[j] * cs[j] - t2[j] * sn[j]) * sc; o2[j] = (t1[j] * sn[j] + t2[j] * cs[j]) * sc; }
        v4u w1, w2; w1.x = cvtpk(o1[0], o1[1]); w1.y = cvtpk(o1[2], o1[3]); w1.z = cvtpk(o1[4], o1[5]); w1.w = cvtpk(o1[6], o1[7]);
        w2.x = cvtpk(o2[0], o2[1]); w2.y = cvtpk(o2[2], o2[3]); w2.z = cvtpk(o2[4], o2[5]); w2.w = cvtpk(o2[6], o2[7]);
        *(LAS v4u*)(dst + l * ldst + 8 * pc) = w1; *(LAS v4u*)(dst + l * ldst + half_off + 8 * pc) = w2;
    }
}
template <int NCHK>
__device__ __forceinline__ void stage_conv(LAS bf16* dst, int ldst, const bf16* zp0, int s0, const float* cw, const float* cb, float scale, const LAS float* rowscale, int tid) {
    const int ch = tid % NCHK;
    float w[4][8], bias[8];
#pragma unroll
    for (int j = 0; j < 4; ++j) { const f32x4 a = *(const f32x4*)(cw + j * 1024 + 8 * ch), b = *(const f32x4*)(cw + j * 1024 + 8 * ch + 4);
        w[j][0] = a.x; w[j][1] = a.y; w[j][2] = a.z; w[j][3] = a.w; w[j][4] = b.x; w[j][5] = b.y; w[j][6] = b.z; w[j][7] = b.w; }
    { const f32x4 a = *(const f32x4*)(cb + 8 * ch), b = *(const f32x4*)(cb + 8 * ch + 4); bias[0] = a.x; bias[1] = a.y; bias[2] = a.z; bias[3] = a.w; bias[4] = b.x; bias[5] = b.y; bias[6] = b.z; bias[7] = b.w; }
    for (int it = tid; it < 128 * NCHK; it += NWAVES * 64) {
        const int l = it / NCHK, s = s0 + l;
        const bf16* zp = zp0 + (size_t)l * DZ + 8 * ch;
        const v4u zero = {0u, 0u, 0u, 0u};
        const v4u x3 = *(const v4u*)zp, x2 = s >= 1 ? *(const v4u*)(zp - (ptrdiff_t)DZ) : zero, x1 = s >= 2 ? *(const v4u*)(zp - (ptrdiff_t)2 * DZ) : zero, x0 = s >= 3 ? *(const v4u*)(zp - (ptrdiff_t)3 * DZ) : zero;
        const unsigned u3[4] = {x3.x, x3.y, x3.z, x3.w}, u2[4] = {x2.x, x2.y, x2.z, x2.w}, u1[4] = {x1.x, x1.y, x1.z, x1.w}, u0[4] = {x0.x, x0.y, x0.z, x0.w};
        const float sc = rowscale ? scale * rowscale[l] : scale;
        float o[8];
#pragma unroll
        for (int p = 0; p < 4; ++p) {
            const float a0 = bias[2 * p] + w[0][2 * p] * bflo(u0[p]) + w[1][2 * p] * bflo(u1[p]) + w[2][2 * p] * bflo(u2[p]) + w[3][2 * p] * bflo(u3[p]);
            const float a1 = bias[2 * p + 1] + w[0][2 * p + 1] * bfhi(u0[p]) + w[1][2 * p + 1] * bfhi(u1[p]) + w[2][2 * p + 1] * bfhi(u2[p]) + w[3][2 * p + 1] * bfhi(u3[p]);
            o[2 * p] = silu_fast(a0) * sc; o[2 * p + 1] = silu_fast(a1) * sc; }
        v4u wv; wv.x = cvtpk(o[0], o[1]); wv.y = cvtpk(o[2], o[3]); wv.z = cvtpk(o[4], o[5]); wv.w = cvtpk(o[6], o[7]);
        *(LAS v4u*)(dst + l * ldst + 8 * ch) = wv;
    }
}
template <int NCHK>
__device__ __forceinline__ void stage_copy(LAS bf16* dst, int ldst, const bf16* src, size_t src_ld, int tid) {
    for (int it = tid; it < 128 * NCHK; it += NWAVES * 64) { const int l = it / NCHK, ch = it % NCHK; *(LAS v4u*)(dst + l * ldst + 8 * ch) = *(const v4u*)(src + (size_t)l * src_ld + 8 * ch); }
}

constexpr int CST = 176;
constexpr int MA_TAB = 2 * 128 * CST * 2;
__device__ __forceinline__ void ma_fast(LAS unsigned char* lds, const bf16* z, const float2* rope, const float* gates, const float* conv_w, const float* conv_b,
                                        bf16* states, float* nprev, float* mprev, int tid, int lane, int wave, int vcu, int G) {
    LAS float* gtab = (LAS float*)(lds + MA_TAB);
    LAS float* wl = gtab + 4096;
    LAS float* blt = wl + 128;
    LAS float* gmt = blt + 32;
    LAS float* wct = gmt + 32;
    LAS float* mnt = wct + 32;
    const int fr = lane & 15, hq = lane >> 4;
    for (int u = vcu; u < 256; u += G) {
        const int g = u >> 7, b = (u >> 4) & 7, h = (u >> 2) & 3, dq = u & 3;
        __syncthreads();
        if (g == 0) { if (tid < 128) gtab[tid] = exp2f((float)(127 - tid) * lg2gamma(h)); }
        else {
            for (int cc = wave * 4; cc < wave * 4 + 4; ++cc) {
                float bc0, bc1, ic0, ic1; ml_gate_scan(gates, b * SEQ + cc * CHUNK, h, lane, bc0, bc1, ic0, ic1);
                const float blast = __shfl(bc1, 63);
                const float g0 = blast - bc0 + ic0, g1 = blast - bc1 + ic1;
                gtab[cc * 128 + 2 * lane] = g0; gtab[cc * 128 + 2 * lane + 1] = g1;
                const float gmax = wave_max(fmaxf(g0, g1));
                if (lane == 0) { blt[cc] = blast; gmt[cc] = gmax; }
            }
            __syncthreads();
            if (tid == 0) { float m = 0.f;
                for (int cc = 0; cc < NCH; ++cc) { const float mn = fmaxf(blt[cc] + m, gmt[cc]); wct[cc] = expf(blt[cc] + m - mn); mnt[cc] = mn;
                    if (dq == 0) mprev[((size_t)b * NH + h) * NCH + cc] = m;
                    m = mn; } }
        }
        __syncthreads();
        const float wc_ret = exp2f(128.0f * lg2gamma(h));
        const int td = wave & 1, tp = wave >> 1;
        f32x4 acc0 = {0.f, 0.f, 0.f, 0.f}, acc1 = acc0, nacc = acc0;
        const int kcol = (g == 0) ? 512 + 128 * h + 16 * dq : 2048 + 512 + 128 * h + 32 * dq;
        const int vcol = (g == 0 ? 1024 : 3072) + 128 * h;
        const int dglob = (g == 0) ? (td ? 64 + 16 * dq : 16 * dq) + 4 * hq : 32 * dq + 16 * td + 4 * hq;
        const unsigned tr_base = (unsigned)(4 * hq + (fr >> 2)) * (CST * 2) + (unsigned)(4 * (fr & 3)) * 2;
        bf16x8 ones; { const short o = (fr == 0) ? (short)0x3F80 : (short)0; ones = (bf16x8){o, o, o, o, o, o, o, o}; }
        for (int c = 0; c < NCH; ++c) {
            const int row0 = b * SEQ + c * CHUNK;
            LAS bf16* comb = (LAS bf16*)(lds + (c & 1) * (128 * CST * 2));
            if (g == 0) stage_rot<2, NWAVES * 64>(comb, CST, 16, z + (size_t)row0 * DZ + kcol, rope + (size_t)row0 * 64 + 16 * dq, QK_SCALE, gtab, tid);
            else {
                if (tid < 128) wl[tid] = expf(gtab[c * 128 + tid] - mnt[c]);
                __syncthreads();
                stage_conv<4>(comb, CST, z + (size_t)row0 * DZ + kcol, c * CHUNK, conv_w + 512 + 128 * h + 32 * dq, conv_b + 512 + 128 * h + 32 * dq, 1.0f, wl, tid);
            }
            stage_copy<16>(comb + 32, CST, z + (size_t)row0 * DZ + vcol, DZ, tid);
            { bf16* st = states + ((((size_t)g * BATCH + b) * NH + h) * NCH + c) * 16384 + dglob;
              uint2 o0, o1; o0.x = cvtpk(acc0[0], acc0[1]); o0.y = cvtpk(acc0[2], acc0[3]); o1.x = cvtpk(acc1[0], acc1[1]); o1.y = cvtpk(acc1[2], acc1[3]);
              *(uint2*)(st + (size_t)(32 * tp + fr) * 128) = o0; *(uint2*)(st + (size_t)(32 * tp + 16 + fr) * 128) = o1;
              if (g == 1 && tp == 0 && fr == 0) *(f32x4*)(nprev + (((size_t)b * NH + h) * NCH + c) * 128 + dglob) = nacc; }
            __syncthreads();
            const float wc = (g == 0) ? wc_ret : wct[c];
            acc0 *= wc; acc1 *= wc; nacc *= wc;
            const unsigned cb = (unsigned)(size_t)comb + tr_base;
#define MA_STEP(S_) do { \
                const s16x4 a_lo = tr_read<((32 * (S_)) * CST + 16 * 0) * 2>(cb + td * 32), a_hi = tr_read<((32 * (S_) + 16) * CST) * 2>(cb + td * 32); \
                const s16x4 b0_lo = tr_read<((32 * (S_)) * CST + 32) * 2>(cb + tp * 64), b0_hi = tr_read<((32 * (S_) + 16) * CST + 32) * 2>(cb + tp * 64); \
                const s16x4 b1_lo = tr_read<((32 * (S_)) * CST + 48) * 2>(cb + tp * 64), b1_hi = tr_read<((32 * (S_) + 16) * CST + 48) * 2>(cb + tp * 64); \
                TR_WAIT(); \
                const bf16x8 A = PK8(a_lo, a_hi); \
                acc0 = __builtin_amdgcn_mfma_f32_16x16x32_bf16(A, PK8(b0_lo, b0_hi), acc0, 0, 0, 0); \
                acc1 = __builtin_amdgcn_mfma_f32_16x16x32_bf16(A, PK8(b1_lo, b1_hi), acc1, 0, 0, 0); \
                if (g == 1 && tp == 0) nacc = __builtin_amdgcn_mfma_f32_16x16x32_bf16(A, ones, nacc, 0, 0, 0); } while (0)
            MA_STEP(0); MA_STEP(1); MA_STEP(2); MA_STEP(3);
#undef MA_STEP
        }
    }
}

constexpr int LST = 144;
constexpr int MX_Q = 0, MX_K = 128 * LST * 2, MX_V = 2 * MX_K, MX_S = 3 * MX_K, MX_TAB = 4 * MX_K;
__device__ __forceinline__ void mb_fast(LAS unsigned char* lds, const bf16* z, const float2* rope, const float* gates, const float* conv_w, const float* conv_b,
                                        const bf16* states, const float* nprev, const float* mprev, const float* g_ret, const float* g_ml, bf16* y,
                                        int tid, int lane, int wave, int vcu, int G) {
    LAS bf16* qs = (LAS bf16*)(lds + MX_Q); LAS bf16* ks = (LAS bf16*)(lds + MX_K); LAS bf16* vs = (LAS bf16*)(lds + MX_V); LAS bf16* ss = (LAS bf16*)(lds + MX_S);
    LAS float* bcs = (LAS float*)(lds + MX_TAB);
    LAS float* ams = bcs + 128;
    LAS float* mts = ams + 128;
    LAS float* nps = mts + 128;
    const int fr = lane & 15, hq = lane >> 4, l0 = 16 * wave;
    for (int u = vcu; u < 2 * BATCH * NH * NCH; u += G) {
        const int g = u >> 10, b = (u >> 7) & 7, h = (u >> 5) & 3, c = u & 31;
        const int row0 = b * SEQ + c * CHUNK;
        __syncthreads();
        if (g == 0) {
            stage_rot<8, NWAVES * 64>(qs, LST, 64, z + (size_t)row0 * DZ + 128 * h, rope + (size_t)row0 * 64, 1.0f, nullptr, tid);
            stage_rot<8, NWAVES * 64>(ks, LST, 64, z + (size_t)row0 * DZ + 512 + 128 * h, rope + (size_t)row0 * 64, QK_SCALE, nullptr, tid);
        } else {
            stage_conv<16>(qs, LST, z + (size_t)row0 * DZ + 2048 + 128 * h, c * CHUNK, conv_w + 128 * h, conv_b + 128 * h, QK_SCALE, nullptr, tid);
            stage_conv<16>(ks, LST, z + (size_t)row0 * DZ + 2048 + 512 + 128 * h, c * CHUNK, conv_w + 512 + 128 * h, conv_b + 512 + 128 * h, 1.0f, nullptr, tid);
            if (wave == 0) {
                float bc0, bc1, ic0, ic1; ml_gate_scan(gates, row0, h, lane, bc0, bc1, ic0, ic1);
                const float a0 = ic0 - bc0, a1 = ic1 - bc1; const float c1 = fmaxf(a0, a1); float v = c1;
#pragma unroll
                for (int off = 1; off < 64; off <<= 1) { const float t = __shfl_up(v, off); if (lane >= off) v = fmaxf(v, t); }
                float ex = __shfl_up(v, 1); if (lane == 0) ex = -INFINITY;
                const float mp = mprev[((size_t)b * NH + h) * NCH + c];
                const float mt0 = bc0 + fmaxf(fmaxf(ex, a0), mp), mt1 = bc1 + fmaxf(fmaxf(ex, c1), mp);
                bcs[2 * lane] = bc0; bcs[2 * lane + 1] = bc1; ams[2 * lane] = a0; ams[2 * lane + 1] = a1; mts[2 * lane] = mt0; mts[2 * lane + 1] = mt1;
            }
            if (tid >= 64 && tid < 192) nps[tid - 64] = nprev[(((size_t)b * NH + h) * NCH + c) * 128 + (tid - 64)];
        }
        stage_copy<16>(vs, LST, z + (size_t)row0 * DZ + (g == 0 ? 1024 : 3072) + 128 * h, DZ, tid);
        stage_copy<16>(ss, LST, states + ((((size_t)g * BATCH + b) * NH + h) * NCH + c) * 16384, 128, tid);
        __syncthreads();
        const int l = l0 + fr;
        float rowf, mt = 0.f, bl_mt = 0.f;
        if (g == 0) rowf = exp2f((float)(l + 1) * lg2gamma(h));
        else { const float mp = mprev[((size_t)b * NH + h) * NCH + c]; const float bl = bcs[l]; mt = mts[l]; rowf = __expf(bl + mp - mt); bl_mt = bl - mt; }
        bf16x8 qf[4];
#pragma unroll
        for (int s = 0; s < 4; ++s) qf[s] = *(const LAS bf16x8*)(qs + l * LST + 32 * s + 8 * hq);
        f32x4 acc[8];
#pragma unroll
        for (int te = 0; te < 8; ++te) { acc[te] = (f32x4){0.f, 0.f, 0.f, 0.f};
#pragma unroll
            for (int s = 0; s < 4; ++s) { const bf16x8 a = *(const LAS bf16x8*)(ss + (16 * te + fr) * LST + 32 * s + 8 * hq); acc[te] = __builtin_amdgcn_mfma_f32_16x16x32_bf16(a, qf[s], acc[te], 0, 0, 0); }
            acc[te] *= rowf; }
        float qn = 0.f;
        if (g == 1) {
#pragma unroll
            for (int s = 0; s < 4; ++s) { const f32x4 n0 = *(const LAS f32x4*)(nps + 32 * s + 8 * hq), n1 = *(const LAS f32x4*)(nps + 32 * s + 8 * hq + 4);
                qn += bf2f((unsigned short)qf[s][0]) * n0.x + bf2f((unsigned short)qf[s][1]) * n0.y + bf2f((unsigned short)qf[s][2]) * n0.z + bf2f((unsigned short)qf[s][3]) * n0.w
                    + bf2f((unsigned short)qf[s][4]) * n1.x + bf2f((unsigned short)qf[s][5]) * n1.y + bf2f((unsigned short)qf[s][6]) * n1.z + bf2f((unsigned short)qf[s][7]) * n1.w; }
            qn += __shfl_xor(qn, 16); qn += __shfl_xor(qn, 32);
        }
        unsigned pk[8][2];
        float psum = 0.f;
        const float lg = lg2gamma(h);
#pragma unroll
        for (int t = 0; t < 8; ++t) {
            if (t <= wave) {
                f32x4 p = {0.f, 0.f, 0.f, 0.f};
#pragma unroll
                for (int s = 0; s < 4; ++s) { const bf16x8 a = *(const LAS bf16x8*)(ks + (16 * t + fr) * LST + 32 * s + 8 * hq); p = __builtin_amdgcn_mfma_f32_16x16x32_bf16(a, qf[s], p, 0, 0, 0); }
                const int m0 = 16 * t + 4 * hq;
                f32x4 w;
                if (g == 0) {
#pragma unroll
                    for (int r = 0; r < 4; ++r) w[r] = exp2f((float)(l - m0 - r) * lg);
                } else { const f32x4 am = *(const LAS f32x4*)(ams + m0);
#pragma unroll
                    for (int r = 0; r < 4; ++r) w[r] = exp2f((bl_mt + am[r]) * LOG2E); }
#pragma unroll
                for (int r = 0; r < 4; ++r) { const float pv = (m0 + r <= l) ? p[r] * w[r] : 0.f; p[r] = pv; psum += pv; }
                pk[t][0] = cvtpk(p[0], p[1]); pk[t][1] = cvtpk(p[2], p[3]);
            } else { pk[t][0] = 0u; pk[t][1] = 0u; }
        }
        const unsigned vb = (unsigned)(size_t)vs + (unsigned)(4 * hq + (fr >> 2)) * (LST * 2) + (unsigned)(4 * (fr & 3)) * 2;
#define MB_PV(SP_) do { if (2 * (SP_) <= wave) { \
            const bf16x8 pf = __builtin_bit_cast(bf16x8, (v4u){pk[2 * (SP_)][0], pk[2 * (SP_)][1], pk[2 * (SP_) + 1][0], pk[2 * (SP_) + 1][1]}); \
            s16x4 lo[8], hi[8]; \
            lo[0] = tr_read<((32 * (SP_)) * LST + 0) * 2>(vb);  hi[0] = tr_read<((32 * (SP_) + 16) * LST + 0) * 2>(vb); \
            lo[1] = tr_read<((32 * (SP_)) * LST + 16) * 2>(vb); hi[1] = tr_read<((32 * (SP_) + 16) * LST + 16) * 2>(vb); \
            lo[2] = tr_read<((32 * (SP_)) * LST + 32) * 2>(vb); hi[2] = tr_read<((32 * (SP_) + 16) * LST + 32) * 2>(vb); \
            lo[3] = tr_read<((32 * (SP_)) * LST + 48) * 2>(vb); hi[3] = tr_read<((32 * (SP_) + 16) * LST + 48) * 2>(vb); \
            lo[4] = tr_read<((32 * (SP_)) * LST + 64) * 2>(vb); hi[4] = tr_read<((32 * (SP_) + 16) * LST + 64) * 2>(vb); \
            lo[5] = tr_read<((32 * (SP_)) * LST + 80) * 2>(vb); hi[5] = tr_read<((32 * (SP_) + 16) * LST + 80) * 2>(vb); \
            lo[6] = tr_read<((32 * (SP_)) * LST + 96) * 2>(vb); hi[6] = tr_read<((32 * (SP_) + 16) * LST + 96) * 2>(vb); \
            lo[7] = tr_read<((32 * (SP_)) * LST + 112) * 2>(vb); hi[7] = tr_read<((32 * (SP_) + 16) * LST + 112) * 2>(vb); \
            TR_WAIT(); \
            _Pragma("unroll") for (int te = 0; te < 8; ++te) acc[te] = __builtin_amdgcn_mfma_f32_16x16x32_bf16(PK8(lo[te], hi[te]), pf, acc[te], 0, 0, 0); } } while (0)
        MB_PV(0); MB_PV(1); MB_PV(2); MB_PV(3);
#undef MB_PV
        const int row = row0 + l;
        if (g == 1) {
            psum += __shfl_xor(psum, 16); psum += __shfl_xor(psum, 32);
            const float den = psum + rowf * qn; const float inv = 1.0f / fmaxf(fabsf(den), __expf(-mt));
            const bf16* zo = z + (size_t)row * DZ + 3584 + 128 * h + 4 * hq;
#pragma unroll
            for (int te = 0; te < 8; ++te) { const uint2 gz = *(const uint2*)(zo + 16 * te);
                acc[te][0] *= inv * sigmoid_fast(bflo(gz.x)); acc[te][1] *= inv * sigmoid_fast(bfhi(gz.x)); acc[te][2] *= inv * sigmoid_fast(bflo(gz.y)); acc[te][3] *= inv * sigmoid_fast(bfhi(gz.y)); }
        }
        float s1 = 0.f;
#pragma unroll
        for (int te = 0; te < 8; ++te) s1 += (acc[te][0] + acc[te][1]) + (acc[te][2] + acc[te][3]);
        s1 += __shfl_xor(s1, 16); s1 += __shfl_xor(s1, 32);
        const float mu = s1 * (1.0f / 128.0f); float s2 = 0.f;
#pragma unroll
        for (int te = 0; te < 8; ++te) { const f32x4 dl = acc[te] - mu; s2 += (dl[0] * dl[0] + dl[1] * dl[1]) + (dl[2] * dl[2] + dl[3] * dl[3]); }
        s2 += __shfl_xor(s2, 16); s2 += __shfl_xor(s2, 32);
        const float rs = 1.0f / sqrtf(s2 * (1.0f / 128.0f) + EPS);
        const float* gn = (g == 0 ? g_ret : g_ml) + 128 * h + 4 * hq;
        const bf16* zg = z + (size_t)row * DZ + 1536 + 128 * h + 4 * hq;
        bf16* yo = y + (size_t)row * D + g * 512 + 128 * h + 4 * hq;
#pragma unroll
        for (int te = 0; te < 8; ++te) { const f32x4 gv = *(const f32x4*)(gn + 16 * te); f32x4 o = (acc[te] - mu) * rs * gv;
            if (g == 0) { const uint2 gz = *(const uint2*)(zg + 16 * te); o[0] *= silu_fast(bflo(gz.x)); o[1] *= silu_fast(bfhi(gz.x)); o[2] *= silu_fast(bflo(gz.y)); o[3] *= silu_fast(bfhi(gz.y)); }
            uint2 w; w.x = cvtpk(o[0], o[1]); w.y = cvtpk(o[2], o[3]); *(uint2*)(yo + 16 * te) = w; }
    }
}

struct Args { const void* in[18]; float* out; unsigned char* ws; int ph_lo, ph_hi, li, pad; };
__global__ void __launch_bounds__(NWAVES * 64, 2) mk_fwd(Args args) {
    extern __shared__ __attribute__((aligned(16))) unsigned char lds_raw[];
    LAS unsigned char* lds = (LAS unsigned char*)lds_raw;
    volatile LAS unsigned* MISC = (volatile LAS unsigned*)(lds + MISC_OFF);
    const int G = gridDim.x; const int bx = blockIdx.x; const int vcu = (G % 8 == 0) ? (bx % 8) * (G / 8) + bx / 8 : bx;
#define ARGS() ({ unsigned long long _p = (unsigned long long)__builtin_amdgcn_kernarg_segment_ptr(); asm volatile("" : "+s"(_p)); (const __attribute__((address_space(4))) Args*)_p; })
    if (threadIdx.x < 32) MISC[threadIdx.x] = 0u;
    __syncthreads();
    XcdBarrier bar;
    { const auto* A = ARGS(); bar = xcd_barrier_post((unsigned*)(A->ws + WS_CTL) + CW_BAR + A->li * XCD_BAR_WORDS, MISC + 8); }
    const int lo = args.ph_lo, hi = args.ph_hi;
#define IN(k) (lo <= (k) && (k) < hi)
#define SEAM(k) do { if (IN(k) && IN((k) + 1)) xcd_barrier(bar); } while (0)
#define TIDS() int tid = threadIdx.x; asm volatile("" : "+v"(tid)); const int lane = tid & 63, wave = __builtin_amdgcn_readfirstlane(tid >> 6), gw = vcu * NWAVES + wave, NGW = G * NWAVES; (void)gw; (void)NGW; (void)lane

    if (IN(0)) { TIDS(); const auto* A = ARGS(); const void* inp[18];
#pragma unroll
        for (int i = 0; i < 18; ++i) inp[i] = A->in[i];
        prologue_phase(lds, inp, A->ws, tid, lane, wave, vcu, G); SEAM(0); }

    for (int j = 0; j < 2 * DEPTH; ++j) {
        const int l = j >> 1, f = j & 1;
        const int pb = 1 + 11 * l + (f ? 8 : 0);
        const int s = f ? 2 : 0;
        if (IN(pb)) { TIDS(); const auto* A = ARGS(); unsigned char* ws = A->ws;
            const float* xsrc = (j == 0) ? (const float*)A->in[0] : (const float*)A->out;
            norm_phase<false>(lds, xsrc, (const float*)A->in[3] + (size_t)(l * 3 + s) * D, (const float*)(ws + WS_MOD) + (size_t)(l * 3 + s) * BATCH * 3 * D, (bf16*)(ws + WS_H), nullptr, nullptr, nullptr, nullptr, gw, NGW, lane);
            SEAM(pb); }
        if (IN(pb + 1)) { const auto* A = ARGS(); unsigned char* ws = A->ws;
            pg8::Gemm g{(const bf16*)(ws + WS_H), (const bf16*)(ws + WS_W + (size_t)l * LW_BYTES + LW_W13 + (size_t)f * W13_BYTES), M, 2 * DFF, D}; pg8::StaticOrder S; S.init(M, 2 * DFF, G, bx);
            pg8::EpiSwiglu E{(bf16*)(ws + WS_Z), DFF};
            pg8::gemm_phase<pg8::EpiSwiglu, pg8::StaticOrder, true, true>(lds, g, S, E);
            SEAM(pb + 1);
        }
        if (IN(pb + 2)) { const auto* A = ARGS(); unsigned char* ws = A->ws;
            const float* xsrc = (j == 0) ? (const float*)A->in[0] : (const float*)A->out;
            pg8::Gemm g{(const bf16*)(ws + WS_Z), (const bf16*)(ws + WS_W + (size_t)l * LW_BYTES + LW_W2 + (size_t)f * W2_BYTES), M, D, DFF}; pg8::StaticOrder S; S.init(M, D, G, bx);
            pg8::EpiResid E{xsrc, A->out, (const float*)(ws + WS_MOD) + (size_t)(l * 3 + s) * BATCH * 3 * D + 2 * D, 3 * D, 0.5f};
            pg8::gemm_phase<pg8::EpiResid, pg8::StaticOrder, true, true>(lds, g, S, E);
            SEAM(pb + 2);
        }
        if (f == 0) {
            const int mb = 1 + 11 * l + 3;
            if (IN(mb)) { TIDS(); const auto* A = ARGS(); unsigned char* ws = A->ws;
                norm_phase<true>(lds, A->out, (const float*)A->in[3] + (size_t)(l * 3 + 1) * D, (const float*)(ws + WS_MOD) + (size_t)(l * 3 + 1) * BATCH * 3 * D, (bf16*)(ws + WS_H),
                                 (const float*)A->in[9] + (size_t)l * D * DIN, (const float*)A->in[12] + l * NH, (const float*)A->in[13] + l * NH, (float*)(ws + WS_GATES), gw, NGW, lane);
                SEAM(mb); }
            if (IN(mb + 1)) { const auto* A = ARGS(); unsigned char* ws = A->ws;
                pg8::Gemm g{(const bf16*)(ws + WS_H), (const bf16*)(ws + WS_W + (size_t)l * LW_BYTES + LW_WIN), M, DZ, D}; pg8::StaticOrder S; S.init(M, DZ, G, bx);
                pg8::EpiZ E{(bf16*)(ws + WS_Z), DZ};
                pg8::gemm_phase<pg8::EpiZ, pg8::StaticOrder, true, true>(lds, g, S, E);
                SEAM(mb + 1);
            }
            if (IN(mb + 2)) { TIDS(); const auto* A = ARGS(); unsigned char* ws = A->ws;
                MA_FN(lds, (const bf16*)(ws + WS_Z), (const float2*)(ws + WS_ROPE), (const float*)(ws + WS_GATES), (const float*)A->in[10] + (size_t)l * 4 * D, (const float*)A->in[11] + (size_t)l * D,
                          (bf16*)(ws + WS_ST), (float*)(ws + WS_NPREV), (float*)(ws + WS_MPREV), tid, lane, wave, vcu, G);
                SEAM(mb + 2); }
            if (IN(mb + 3)) { TIDS(); const auto* A = ARGS(); unsigned char* ws = A->ws;
                MB_FN(lds, (const bf16*)(ws + WS_Z), (const float2*)(ws + WS_ROPE), (const float*)(ws + WS_GATES), (const float*)A->in[10] + (size_t)l * 4 * D, (const float*)A->in[11] + (size_t)l * D,
                          (const bf16*)(ws + WS_ST), (const float*)(ws + WS_NPREV), (const float*)(ws + WS_MPREV), (const float*)A->in[14] + (size_t)l * 512, (const float*)A->in[15] + (size_t)l * 512, (bf16*)(ws + WS_H),
                          tid, lane, wave, vcu, G);
                SEAM(mb + 3); }
            if (IN(mb + 4)) { const auto* A = ARGS(); unsigned char* ws = A->ws;
                pg8::Gemm g{(const bf16*)(ws + WS_H), (const bf16*)(ws + WS_W + (size_t)l * LW_BYTES + LW_WOUT), M, D, D}; pg8::StaticOrder S; S.init(M, D, G, bx);
                pg8::EpiResid E{A->out, A->out, (const float*)(ws + WS_MOD) + (size_t)(l * 3 + 1) * BATCH * 3 * D + 2 * D, 3 * D, 1.0f};
                pg8::gemm_phase<pg8::EpiResid, pg8::StaticOrder, true, true>(lds, g, S, E);
                SEAM(mb + 4);
            }
        }
    }
    if (IN(NPHASE - 1)) { TIDS(); const auto* A = ARGS(); final_norm_phase(A->out, (const float*)A->in[17], gw, NGW, lane); }
#undef ARGS
#undef TIDS
#undef IN
#undef SEAM
}

extern "C" void kernel_launch(void* const* d_in, const int* in_sizes, int n_in, void* d_out, int out_size, void* d_ws, size_t ws_size, hipStream_t stream) {
    static int grid = 0;
    if (grid == 0) {
        if (n_in != 18 || in_sizes[0] != M * D || out_size != M * D || ws_size < WS_END) { fprintf(stderr, "kernel_launch: unexpected shapes (n_in %d, in0 %d, out %d, ws %zu)\n", n_in, n_in > 0 ? in_sizes[0] : -1, out_size, ws_size); grid = -1; return; }
        int dev = 0, cus = 0, per_cu = 0;
        if (hipGetDevice(&dev) != hipSuccess || hipDeviceGetAttribute(&cus, hipDeviceAttributeMultiprocessorCount, dev) != hipSuccess) { grid = -1; return; }
        if (hipFuncSetAttribute((const void*)mk_fwd, hipFuncAttributeMaxDynamicSharedMemorySize, LDS_BYTES) != hipSuccess) { fprintf(stderr, "kernel_launch: hipFuncSetAttribute failed\n"); grid = -1; return; }
        if (hipOccupancyMaxActiveBlocksPerMultiprocessor(&per_cu, (const void*)mk_fwd, NWAVES * 64, LDS_BYTES) != hipSuccess || per_cu < 1) { fprintf(stderr, "kernel_launch: occupancy query says %d\n", per_cu); }
        (void)hipGetLastError();
        grid = cus;
    }
    if (grid < 0) return;
    if (hipMemsetAsync((char*)d_ws + WS_CTL, 0, CTL_ZERO_BYTES, stream) != hipSuccess) return;
    Args a{};
    for (int i = 0; i < 18; ++i) a.in[i] = d_in[i];
    a.out = (float*)d_out; a.ws = (unsigned char*)d_ws; a.pad = 0;
#if MK_ONE_LAUNCH
    a.ph_lo = 0; a.ph_hi = NPHASE; a.li = 0;
    hipLaunchKernelGGL(mk_fwd, dim3(grid), dim3(NWAVES * 64), LDS_BYTES, stream, a);
#else
    for (int li = 0; li < NPHASE; ++li) { a.ph_lo = li; a.ph_hi = li + 1; a.li = li;
        hipLaunchKernelGGL(mk_fwd, dim3(grid), dim3(NWAVES * 64), LDS_BYTES, stream, a); }
#endif
}
```

```cpp
#define MK_ONE_LAUNCH 1
#define MA_FN ma_fast
#define MB_FN mb_fast2
#define DUP_MASK 0
#include <hip/hip_runtime.h>
#include <cstdio>
#include <cstdint>

constexpr int NWAVES = 8;
#ifndef MK_ONE_LAUNCH
#define MK_ONE_LAUNCH 1
#endif

constexpr int BATCH = 8, SEQ = 4096, D = 1024, DEPTH = 2, DFF = 2816, NH = 4, DH = 128, CHUNK = 128, NCH = SEQ / CHUNK, DIN = 4104, DZ = 4096;
constexpr int M = BATCH * SEQ;
constexpr float EPS = 1e-6f;
constexpr int NPHASE = 18;

constexpr size_t MiB = 1u << 20;
constexpr size_t WS_CTL = 0, CTL_ZERO_BYTES = 1 * MiB;
constexpr size_t WS_MOD = 1 * MiB;
constexpr size_t WS_GM = 1 * MiB + 640 * 1024;
constexpr size_t WS_RS = 2 * MiB;
constexpr size_t WS_NPREV = 3 * MiB + 512 * 1024;
constexpr size_t WS_MPREV = 5 * MiB;
constexpr size_t WS_GPART = 4 * MiB;
constexpr size_t WS_SW13 = 6 * MiB;
constexpr size_t WS_SWIN = 7 * MiB;
constexpr size_t WS_ROPE = 8 * MiB;
constexpr size_t WS_W = 24 * MiB;
constexpr size_t W13_BYTES = (size_t)2 * DFF * D * 2, W2_BYTES = (size_t)D * DFF * 2, WIN_BYTES = (size_t)DZ * D * 2, WOUT_BYTES = (size_t)D * D * 2;
constexpr size_t LW_W13 = 0, LW_W2 = 2 * W13_BYTES, LW_WIN = LW_W2 + 2 * W2_BYTES, LW_WOUT = LW_WIN + WIN_BYTES, LW_BYTES = LW_WOUT + WOUT_BYTES;
constexpr size_t WS_XB = 110 * MiB;
constexpr size_t OUT_H = 0, OUT_ST = 64 * MiB;
constexpr size_t WS_Z = 174 * MiB;
constexpr size_t WS_H2 = WS_Z + 192 * MiB;
constexpr size_t WS_END = 430 * MiB;
static_assert(WS_W + DEPTH * LW_BYTES <= WS_XB && WS_XB + (size_t)M * D * 2 <= WS_Z && OUT_ST + (size_t)2 * BATCH * NH * NCH * 16384 * 2 <= (size_t)M * D * 4 && WS_Z + (size_t)M * DZ * 2 <= WS_END, "d_ws map");
static_assert((size_t)M * DFF * 2 <= 192 * MiB && WS_H2 + (size_t)M * D * 2 <= WS_END, "u and H2 inside the z region, disjoint");
static_assert(WS_GM + (size_t)DEPTH * 3 * BATCH * D * 4 <= WS_RS && WS_RS + (size_t)DEPTH * 3 * M * 8 <= WS_NPREV && WS_NPREV + (size_t)BATCH * NH * NCH * 128 * 4 <= WS_GPART && WS_GPART + (size_t)M * 8 * 4 <= WS_MPREV && WS_MPREV + 4096 <= WS_SW13 && WS_GPART + (size_t)DEPTH * M * 8 * 4 <= WS_SW13 && WS_SW13 + (size_t)DEPTH * 2 * BATCH * 2 * DFF * 4 <= WS_SWIN && WS_SWIN + (size_t)DEPTH * BATCH * DIN * 4 <= WS_ROPE, "small tables");
constexpr int CW_BAR = 4096;

constexpr int RING_BYTES = 131072;
constexpr int SM_OFF = RING_BYTES;
constexpr int MISC_OFF = 163584;
constexpr int LDS_BYTES = 163840;
static_assert(MISC_OFF + 128 <= LDS_BYTES, "LDS map");

#define GAS __attribute__((address_space(1)))
#define LAS __attribute__((address_space(3)))
typedef unsigned short bf16;
typedef unsigned v4u __attribute__((ext_vector_type(4)));
typedef float f32x4 __attribute__((ext_vector_type(4)));
typedef GAS unsigned gu32;
constexpr float RS_SCALE = 1048576.0f, RS_INV = 1.0f / (1048576.0f * 1024.0f);
#define RLX_AGENT __ATOMIC_RELAXED, __HIP_MEMORY_SCOPE_AGENT
#define LDS_WAIT() asm volatile("s_waitcnt lgkmcnt(0)" ::: "memory")
#define VM_WAIT() asm volatile("s_waitcnt vmcnt(0)" ::: "memory")
__device__ __forceinline__ unsigned f2bf(float f) { unsigned u = __builtin_bit_cast(unsigned, f); return (u + 0x7fffu + ((u >> 16) & 1u)) >> 16; }
__device__ __forceinline__ unsigned pk2(float lo, float hi) { return f2bf(lo) | (f2bf(hi) << 16); }
__device__ __forceinline__ float bf2f(unsigned short v) { return __builtin_bit_cast(float, (unsigned)v << 16); }
__device__ __forceinline__ float bflo(unsigned w) { return __builtin_bit_cast(float, w << 16); }
__device__ __forceinline__ float bfhi(unsigned w) { return __builtin_bit_cast(float, w & 0xffff0000u); }
__device__ __forceinline__ int lane_id() { int l; asm volatile("v_mbcnt_lo_u32_b32 %0, -1, 0\n\tv_mbcnt_hi_u32_b32 %0, -1, %0" : "=v"(l)); return l; }
__device__ __forceinline__ float wave_sum(float v) {
#pragma unroll
    for (int o = 1; o < 64; o <<= 1) v += __shfl_xor(v, o);
    return v;
}
__device__ __forceinline__ float wave_max(float v) {
#pragma unroll
    for (int o = 1; o < 64; o <<= 1) v = fmaxf(v, __shfl_xor(v, o));
    return v;
}
__device__ __forceinline__ float silu_acc(float x) { return x / (1.0f + expf(-x)); }
__device__ __forceinline__ float sigmoid_acc(float x) { return 1.0f / (1.0f + expf(-x)); }
__device__ __forceinline__ float logsigmoid_acc(float x) { return fminf(x, 0.0f) - log1pf(expf(-fabsf(x))); }

struct Args { const void* in[18]; float* out; unsigned char* ws; int ph_lo, ph_hi, li, pad; };
#define ARGS() ({ unsigned long long _p = (unsigned long long)__builtin_amdgcn_kernarg_segment_ptr(); asm volatile("" : "+s"(_p)); (const __attribute__((address_space(4))) Args*)_p; })
#ifndef PG8_WGM
#define PG8_WGM 8
#endif
namespace pg8 {
#define PG8_LAS __attribute__((address_space(3)))
typedef unsigned short bf16_t;
typedef short bf16x8 __attribute__((ext_vector_type(8)));
typedef float f32x4 __attribute__((ext_vector_type(4)));
typedef unsigned u32x4 __attribute__((ext_vector_type(4)));
constexpr int BM = 256, BK = 64, HALF = 128, HTB = HALF * BK * 2  , STAGE_BYTES = 8 * HTB, NXCD = 8, WGM = PG8_WGM;

__host__ __device__ __forceinline__ int lds_byte(int r, int c) { const int st = (r >> 4) * 2 + (c >> 5), rr = r & 15, cc = c & 31, ob = rr * 64 + cc * 2; return st * 1024 + (ob ^ (((ob >> 9) & 1) << 5)); }
__host__ __device__ __forceinline__ void stage_rc(int b, int& R, int& C) { const int st = b / 1024, sb = b % 1024, swz = sb ^ (((sb >> 9) & 1) << 5); R = (st >> 1) * 16 + swz / 64; C = (st & 1) * 32 + (swz % 64) / 2; }
__host__ __device__ __forceinline__ int perm32(int rho) { const int n = rho >> 4, i = rho & 15; return 8 * (i >> 2) + 4 * n + (i & 3); }

struct Unit { int pm, pn; };
struct Gemm { const bf16_t* A; const bf16_t* Bt; int M, N, K; };

struct StaticOrder {
    int nM, nN, nwg, G, c;
    __host__ __device__ void init(int M, int N, int G_, int c_) { nM = M / BM; nN = N / BM; nwg = nM * nN; G = G_; c = c_; }
    __host__ __device__ bool next(int i, Unit& u) const {
        const long L = (long)i * G + c; if (L >= nwg) return false;
        int wgid = (int)L; { const int q = nwg / NXCD, r = nwg % NXCD, xcd = wgid % NXCD, off = wgid / NXCD; wgid = (xcd < r ? xcd * (q + 1) : r * (q + 1) + (xcd - r) * q) + off; }
        const int nig = WGM * nN, gid = wgid / nig, fm = gid * WGM, gsz = (nM - fm) < WGM ? (nM - fm) : WGM;
        u.pm = fm + ((wgid % nig) % gsz); u.pn = (wgid % nig) / gsz; return true;
    }
    __device__ __forceinline__ void a_ready(const Unit&) const {}
    __device__ __forceinline__ void done(const Unit&) const {}
};

constexpr float NEPS = 1e-6f;
#ifndef EPI_WT
#define EPI_WT 0
#endif
__device__ __forceinline__ void st16_wt(void* p, u32x4 v) {
#if EPI_WT
    asm volatile("global_store_dwordx4 %0, %1, off sc1" :: "v"(p), "v"(v) : "memory");
#else
    *(u32x4*)p = v;
#endif
}
__device__ __forceinline__ unsigned cvt_pk_bf16(float lo, float hi) { unsigned r; asm volatile("v_cvt_pk_bf16_f32 %0, %1, %2" : "=v"(r) : "v"(lo), "v"(hi)); return r; }
__device__ __forceinline__ float silu_f(float g) { return g * __builtin_amdgcn_rcpf(1.0f + __expf(-g)); }
__device__ __forceinline__ float rstd_of(unsigned long long ssfix) { return __builtin_amdgcn_rsqf((float)ssfix * RS_INV + NEPS); }

constexpr int EPI_SLOT = 131072, EPI_COL = 2048, EPI_POS = 3072;
__device__ __forceinline__ void dma_1k(const float* g, PG8_LAS unsigned char* dst, int lane) {
    __builtin_amdgcn_global_load_lds((const unsigned*)(g + 4 * lane), (PG8_LAS unsigned*)dst, 16, 0, 0); }
__device__ __forceinline__ void dma_rs(const unsigned long long* g, PG8_LAS unsigned char* dst, int lane) {
    __builtin_amdgcn_global_load_lds((const unsigned*)(g + 2 * lane), (PG8_LAS unsigned*)dst, 16, 0, 0);
    __builtin_amdgcn_global_load_lds((const unsigned*)(g + 128 + 2 * lane), (PG8_LAS unsigned*)(dst + 1024), 16, 0, 0); }

struct EpiSwigluN {
    static constexpr bool PERM = true, AFTER_DRAIN = false; static constexpr int PROBE_ID = 1;
    int l, f;
    __device__ __forceinline__ void prefetch(PG8_LAS unsigned char* lds, const Unit& u, int wid, int lane) const {
        if (wid < 2) { unsigned char* ws = ARGS()->ws;
            if (wid == 0) dma_rs((const unsigned long long*)(ws + WS_RS) + (size_t)(l * 3 + (f ? 2 : 0)) * M + u.pm * BM, lds + EPI_SLOT, lane);
            else dma_1k((const float*)(ws + WS_SW13) + (size_t)(l * 2 + f) * BATCH * 2 * DFF + (size_t)(u.pm >> 4) * 2 * DFF + u.pn * BM, lds + EPI_SLOT + EPI_COL, lane); }
    }
    __device__ __forceinline__ void operator()(const f32x4 (&acc)[2][2][4][2], const Unit& u, int wr, int wc, int fr, int fq, PG8_LAS unsigned char* lds) const {
        asm volatile("" : "+v"(fr), "+v"(fq));
        unsigned char* ws = ARGS()->ws;
        bf16_t* U = (bf16_t*)(ws + WS_Z); constexpr int ldc = DFF;
        const PG8_LAS unsigned long long* rs = (const PG8_LAS unsigned long long*)(lds + EPI_SLOT) + wr * 64 + fr; const PG8_LAS float* sp = (const PG8_LAS float*)(lds + EPI_SLOT + EPI_COL) + wc * 32 + 8 * fq;
        const int row0 = u.pm * BM + wr * 64 + fr, col0 = u.pn * HALF + wc * 32 + 8 * fq;
        const f32x4 sg0 = *(const PG8_LAS f32x4*)sp, sg1 = *(const PG8_LAS f32x4*)(sp + 4), su0 = *(const PG8_LAS f32x4*)(sp + HALF), su1 = *(const PG8_LAS f32x4*)(sp + HALF + 4);
#pragma unroll
        for (int ai = 0; ai < 2; ++ai)
#pragma unroll
            for (int m = 0; m < 4; ++m) { const int row = row0 + ai * HALF + m * 16; const float rstd = rstd_of(rs[ai * HALF + m * 16]);
                bf16_t* rowp = U + (size_t)row * ldc + col0;
                const f32x4 g0 = acc[ai][0][m][0] * rstd + sg0, g1 = acc[ai][0][m][1] * rstd + sg1, u0 = acc[ai][1][m][0] * rstd + su0, u1 = acc[ai][1][m][1] * rstd + su1;
                f32x4 v0, v1;
#pragma unroll
                for (int j = 0; j < 4; ++j) { v0[j] = silu_f(g0[j]) * u0[j]; v1[j] = silu_f(g1[j]) * u1[j]; }
                u32x4 w; w.x = cvt_pk_bf16(v0[0], v0[1]); w.y = cvt_pk_bf16(v0[2], v0[3]); w.z = cvt_pk_bf16(v1[0], v1[1]); w.w = cvt_pk_bf16(v1[2], v1[3]);
                st16_wt(rowp, w); }
    }
};
struct EpiZN {
    static constexpr bool PERM = true, AFTER_DRAIN = false; static constexpr int PROBE_ID = 2;
    int l;
    __device__ __forceinline__ void prefetch(PG8_LAS unsigned char* lds, const Unit& u, int wid, int lane) const {
        if (wid == 2 && u.pn < 4) dma_1k((const float*)ARGS()->in[2] + u.pm * BM, lds + EPI_SLOT + EPI_POS, lane);
        if (wid < 2) { unsigned char* ws = ARGS()->ws;
            if (wid == 0) dma_rs((const unsigned long long*)(ws + WS_RS) + (size_t)(l * 3 + 1) * M + u.pm * BM, lds + EPI_SLOT, lane);
            else { const float* sw = (const float*)(ws + WS_SWIN) + (size_t)l * BATCH * DIN + (size_t)(u.pm >> 4) * DIN;
                if (u.pn >= 4) dma_1k(sw + u.pn * BM, lds + EPI_SLOT + EPI_COL, lane);
                else { const int p = 4 * lane, bj = p >> 7, cc = p & 127; const int src = (u.pn >> 1) * 512 + 128 * (2 * (u.pn & 1) + (cc >> 6)) + 64 * bj + (cc & 63);
                    __builtin_amdgcn_global_load_lds((const unsigned*)(sw + src), (PG8_LAS unsigned*)(lds + EPI_SLOT + EPI_COL), 16, 0, 0); } } }
    }
    __device__ __forceinline__ void operator()(const f32x4 (&acc)[2][2][4][2], const Unit& u, int wr, int wc, int fr, int fq, PG8_LAS unsigned char* lds) const {
        asm volatile("" : "+v"(fr), "+v"(fq));
        unsigned char* ws = ARGS()->ws;
        bf16_t* O = (bf16_t*)(ws + WS_Z);
        const PG8_LAS unsigned long long* rs = (const PG8_LAS unsigned long long*)(lds + EPI_SLOT) + wr * 64 + fr; const PG8_LAS float* sp = (const PG8_LAS float*)(lds + EPI_SLOT + EPI_COL) + wc * 32 + 8 * fq;
        const int row0 = u.pm * BM + wr * 64 + fr;
        f32x4 sv[2][2];
#pragma unroll
        for (int bj = 0; bj < 2; ++bj)
#pragma unroll
            for (int n = 0; n < 2; ++n) sv[bj][n] = *(const PG8_LAS f32x4*)(sp + bj * HALF + 4 * n);
        if (u.pn >= 4) {
#pragma unroll
            for (int ai = 0; ai < 2; ++ai)
#pragma unroll
                for (int m = 0; m < 4; ++m) { const int row = row0 + ai * HALF + m * 16; const float rstd = rstd_of(rs[ai * HALF + m * 16]);
                    bf16_t* rowp = O + ((size_t)(2 * u.pn) * M + row) * 128 + wc * 32 + 8 * fq;
#pragma unroll
                    for (int bj = 0; bj < 2; ++bj) { const f32x4 v0 = acc[ai][bj][m][0] * rstd + sv[bj][0], v1 = acc[ai][bj][m][1] * rstd + sv[bj][1];
                        u32x4 w; w.x = cvt_pk_bf16(v0[0], v0[1]); w.y = cvt_pk_bf16(v0[2], v0[3]); w.z = cvt_pk_bf16(v1[0], v1[1]); w.w = cvt_pk_bf16(v1[2], v1[3]);
                        st16_wt(rowp + (size_t)bj * M * 128, w); } }
        } else {
            const int cc = wc * 32 + 8 * fq, i0 = cc & 63;
            const int slice = 4 * (u.pn >> 1) + 2 * (u.pn & 1) + (cc >> 6);
            const float sc = u.pn >= 2 ? 0.08838834764831845f : 1.0f;
            const float* invf = (const float*)(ws + WS_ROPE) + i0;
            const f32x4 f0 = *(const f32x4*)invf, f1 = *(const f32x4*)(invf + 4);
            const PG8_LAS int* posl = (const PG8_LAS int*)(lds + EPI_SLOT + EPI_POS) + wr * 64 + fr;
#pragma unroll
            for (int ai = 0; ai < 2; ++ai)
#pragma unroll
                for (int m = 0; m < 4; ++m) { const int row = row0 + ai * HALF + m * 16; const float rstd = rstd_of(rs[ai * HALF + m * 16]) * sc;
                    const float posf = (float)posl[ai * HALF + m * 16];
                    f32x4 c0, s0, c1, s1;
#pragma unroll
                    for (int j = 0; j < 4; ++j) {
                        const float a0_ = posf * f0[j], a1_ = posf * f1[j];
                        const float k0_ = __builtin_rintf(a0_ * 0.15915494f), k1_ = __builtin_rintf(a1_ * 0.15915494f);
                        const float r0_ = __builtin_fmaf(a0_, 6.4206383e-09f, __builtin_fmaf(a0_, 0.15915494f, -k0_)), r1_ = __builtin_fmaf(a1_, 6.4206383e-09f, __builtin_fmaf(a1_, 0.15915494f, -k1_));
                        c0[j] = __builtin_amdgcn_cosf(r0_); s0[j] = __builtin_amdgcn_sinf(r0_); c1[j] = __builtin_amdgcn_cosf(r1_); s1[j] = __builtin_amdgcn_sinf(r1_); }
                    const f32x4 a0 = acc[ai][0][m][0] * rstd + sv[0][0] * sc, a1 = acc[ai][0][m][1] * rstd + sv[0][1] * sc, b0 = acc[ai][1][m][0] * rstd + sv[1][0] * sc, b1 = acc[ai][1][m][1] * rstd + sv[1][1] * sc;
                    const f32x4 o10 = a0 * c0 - b0 * s0, o11 = a1 * c1 - b1 * s1, o20 = a0 * s0 + b0 * c0, o21 = a1 * s1 + b1 * c1;
                    bf16_t* rowp = O + ((size_t)slice * M + row) * 128 + i0;
                    u32x4 w; w.x = cvt_pk_bf16(o10[0], o10[1]); w.y = cvt_pk_bf16(o10[2], o10[3]); w.z = cvt_pk_bf16(o11[0], o11[1]); w.w = cvt_pk_bf16(o11[2], o11[3]);
                    st16_wt(rowp, w);
                    w.x = cvt_pk_bf16(o20[0], o20[1]); w.y = cvt_pk_bf16(o20[2], o20[3]); w.z = cvt_pk_bf16(o21[0], o21[1]); w.w = cvt_pk_bf16(o21[2], o21[3]);
                    st16_wt(rowp + 64, w); }
        }
    }
};
struct EpiResidN {
    static constexpr bool PERM = true, AFTER_DRAIN = false; static constexpr int PROBE_ID = 3;
    int l, kind, first;
    __device__ __forceinline__ void prefetch(PG8_LAS unsigned char* lds, const Unit& u, int wid, int lane) const {
        if (wid < 2) { unsigned char* ws = ARGS()->ws; const int nidx = kind == 2 ? (l + 1) * 3 : l * 3 + kind + 1;
            if (wid == 0) dma_1k((const float*)(ws + WS_MOD) + (size_t)(l * 3 + kind) * BATCH * 3 * D + 2 * D + (size_t)(u.pm >> 4) * 3 * D + u.pn * BM, lds + EPI_SLOT, lane);
            else if (!(kind == 2 && l + 1 >= DEPTH)) dma_1k((const float*)(ws + WS_GM) + (size_t)nidx * BATCH * D + (size_t)(u.pm >> 4) * D + u.pn * BM, lds + EPI_SLOT + EPI_COL, lane); }
    }
    static __device__ __forceinline__ void row_out(const f32x4& x0, const f32x4& x1, const f32x4& g0, const f32x4& g1, bf16_t* xp, bf16_t* hp, bool gmn, float& ss) {
        { u32x4 w; w.x = cvt_pk_bf16(x0[0], x0[1]); w.y = cvt_pk_bf16(x0[2], x0[3]); w.z = cvt_pk_bf16(x1[0], x1[1]); w.w = cvt_pk_bf16(x1[2], x1[3]); st16_wt(xp, w); }
        if (gmn) { const f32x4 y0 = x0 * g0, y1 = x1 * g1;
            u32x4 w; w.x = cvt_pk_bf16(y0[0], y0[1]); w.y = cvt_pk_bf16(y0[2], y0[3]); w.z = cvt_pk_bf16(y1[0], y1[1]); w.w = cvt_pk_bf16(y1[2], y1[3]); st16_wt(hp, w);
            ss += (x0[0] * x0[0] + x0[1] * x0[1]) + (x0[2] * x0[2] + x0[3] * x0[3]) + (x1[0] * x1[0] + x1[1] * x1[1]) + (x1[2] * x1[2] + x1[3] * x1[3]); }
    }
    static __device__ __forceinline__ void row_stat(float ss, unsigned long long* rp, bool gmn, int fq) {
        if (gmn) { ss += __shfl_xor(ss, 16); ss += __shfl_xor(ss, 32);
            if (fq == 0) __hip_atomic_fetch_add(rp, (unsigned long long)(ss * RS_SCALE), __ATOMIC_RELAXED, __HIP_MEMORY_SCOPE_AGENT); }
    }
    __device__ __forceinline__ void operator()(const f32x4 (&acc)[2][2][4][2], const Unit& u, int wr, int wc, int fr, int fq, PG8_LAS unsigned char* lds) const {
        asm volatile("" : "+v"(fr), "+v"(fq));
        const auto* A = ARGS(); unsigned char* ws = A->ws;
        bf16_t* xb = (bf16_t*)(ws + WS_XB); const float* xin = (const float*)A->in[0];
        const float coef = kind == 1 ? 1.0f : 0.5f;
        const int nidx = kind == 2 ? (l + 1) * 3 : l * 3 + kind + 1;
        const bool gmn = !(kind == 2 && l + 1 >= DEPTH);
        bf16_t* hn = kind == 1 ? (bf16_t*)(ws + WS_H2) : (bf16_t*)((unsigned char*)A->out + OUT_H); unsigned long long* rsn = (unsigned long long*)(ws + WS_RS) + (size_t)nidx * M;
        const int row0 = u.pm * BM + wr * 64 + fr, col0 = u.pn * BM + wc * 32 + 8 * fq;
        const PG8_LAS float* gp = (const PG8_LAS float*)(lds + EPI_SLOT) + wc * 32 + 8 * fq; const PG8_LAS float* gmp = gp + EPI_COL / 4;
        if (first) {
        f32x4 gv[2][2], gm[2][2];
#pragma unroll
        for (int bj = 0; bj < 2; ++bj)
#pragma unroll
            for (int n = 0; n < 2; ++n) { gv[bj][n] = *(const PG8_LAS f32x4*)(gp + bj * HALF + 4 * n) * coef;
                gm[bj][n] = gmn ? *(const PG8_LAS f32x4*)(gmp + bj * HALF + 4 * n) : (f32x4){0.f, 0.f, 0.f, 0.f}; }
#pragma unroll
            for (int ai = 0; ai < 2; ++ai)
#pragma unroll
                for (int m = 0; m < 4; ++m) { const int row = row0 + ai * HALF + m * 16; const size_t off = (size_t)row * 1024 + col0;
                    f32x4 xa[2][2];
#pragma unroll
                    for (int bj = 0; bj < 2; ++bj) { xa[bj][0] = *(const f32x4*)(xin + off + bj * HALF); xa[bj][1] = *(const f32x4*)(xin + off + bj * HALF + 4); }
                    float ss = 0.f;
#pragma unroll
                    for (int bj = 0; bj < 2; ++bj) { const f32x4 x0 = xa[bj][0] + gv[bj][0] * acc[ai][bj][m][0], x1 = xa[bj][1] + gv[bj][1] * acc[ai][bj][m][1];
                        row_out(x0, x1, gm[bj][0], gm[bj][1], xb + off + bj * HALF, hn + off + bj * HALF, gmn, ss); }
                    row_stat(ss, rsn + row, gmn, fq); }
        } else {
#pragma unroll
            for (int ai = 0; ai < 2; ++ai) {
                u32x4 xw[4][2];
#pragma unroll
                for (int m = 0; m < 4; ++m)
#pragma unroll
                    for (int bj = 0; bj < 2; ++bj) xw[m][bj] = *(const u32x4*)(xb + (size_t)(row0 + ai * HALF + m * 16) * 1024 + col0 + bj * HALF);
#pragma unroll
                for (int m = 0; m < 4; ++m) { const int row = row0 + ai * HALF + m * 16; const size_t off = (size_t)row * 1024 + col0;
                    float ss = 0.f;
#pragma unroll
                    for (int bj = 0; bj < 2; ++bj) { const u32x4 w = xw[m][bj];
                        const f32x4 gv0 = *(const PG8_LAS f32x4*)(gp + bj * HALF) * coef, gv1 = *(const PG8_LAS f32x4*)(gp + bj * HALF + 4) * coef;
                        const f32x4 x0 = (f32x4){__builtin_bit_cast(float, w.x << 16), __builtin_bit_cast(float, w.x & 0xffff0000u), __builtin_bit_cast(float, w.y << 16), __builtin_bit_cast(float, w.y & 0xffff0000u)} + gv0 * acc[ai][bj][m][0];
                        const f32x4 x1 = (f32x4){__builtin_bit_cast(float, w.z << 16), __builtin_bit_cast(float, w.z & 0xffff0000u), __builtin_bit_cast(float, w.w << 16), __builtin_bit_cast(float, w.w & 0xffff0000u)} + gv1 * acc[ai][bj][m][1];
                        const f32x4 g0 = gmn ? *(const PG8_LAS f32x4*)(gmp + bj * HALF) : (f32x4){0.f, 0.f, 0.f, 0.f}, g1 = gmn ? *(const PG8_LAS f32x4*)(gmp + bj * HALF + 4) : (f32x4){0.f, 0.f, 0.f, 0.f};
                        row_out(x0, x1, g0, g1, xb + off + bj * HALF, hn + off + bj * HALF, gmn, ss); }
                    row_stat(ss, rsn + row, gmn, fq);
                    asm volatile("" : "+v"(gp), "+v"(gmp)); }
            }
        }
    }
};

constexpr size_t CTL_RSF = 512 * 1024, CTL_FCNT = 800 * 1024;
struct EpiFinalN {
    static constexpr bool PERM = true, AFTER_DRAIN = false; static constexpr int PROBE_ID = 4;
    int l;
    __device__ __forceinline__ void prefetch(PG8_LAS unsigned char* lds, const Unit& u, int wid, int lane) const {
        if (wid == 0) dma_1k((const float*)(ARGS()->ws + WS_MOD) + (size_t)(l * 3 + 2) * BATCH * 3 * D + 2 * D + (size_t)(u.pm >> 4) * 3 * D + u.pn * BM, lds + EPI_SLOT, lane);
        else if (wid == 1) dma_1k((const float*)ARGS()->in[17] + u.pn * BM, lds + EPI_SLOT + EPI_COL, lane);
    }
    __device__ __forceinline__ void operator()(const f32x4 (&acc_)[2][2][4][2], const Unit& u, int wr, int wc, int fr, int fq, PG8_LAS unsigned char* lds) const {
        asm volatile("" : "+v"(fr), "+v"(fq));
        f32x4 (&X)[2][2][4][2] = const_cast<f32x4 (&)[2][2][4][2]>(acc_);
        const auto* A = ARGS(); unsigned char* ws = A->ws;
        const bf16_t* xb = (const bf16_t*)(ws + WS_XB);
        unsigned long long* rsf = (unsigned long long*)(ws + WS_CTL + CTL_RSF);
        const int row0 = u.pm * BM + wr * 64 + fr, col0 = u.pn * BM + wc * 32 + 8 * fq;
        const PG8_LAS float* gp = (const PG8_LAS float*)(lds + EPI_SLOT) + wc * 32 + 8 * fq; const PG8_LAS float* gfp = gp + EPI_COL / 4;
#pragma unroll
        for (int ai = 0; ai < 2; ++ai) {
            u32x4 xw[4][2];
#pragma unroll
            for (int m = 0; m < 4; ++m)
#pragma unroll
                for (int bj = 0; bj < 2; ++bj) xw[m][bj] = *(const u32x4*)(xb + (size_t)(row0 + ai * HALF + m * 16) * 1024 + col0 + bj * HALF);
#pragma unroll
            for (int m = 0; m < 4; ++m) { const int row = row0 + ai * HALF + m * 16;
                float ss = 0.f;
#pragma unroll
                for (int bj = 0; bj < 2; ++bj) { const u32x4 w = xw[m][bj];
                    const f32x4 gv0 = *(const PG8_LAS f32x4*)(gp + bj * HALF) * 0.5f, gv1 = *(const PG8_LAS f32x4*)(gp + bj * HALF + 4) * 0.5f;
                    const f32x4 x0 = (f32x4){__builtin_bit_cast(float, w.x << 16), __builtin_bit_cast(float, w.x & 0xffff0000u), __builtin_bit_cast(float, w.y << 16), __builtin_bit_cast(float, w.y & 0xffff0000u)} + gv0 * X[ai][bj][m][0];
                    const f32x4 x1 = (f32x4){__builtin_bit_cast(float, w.z << 16), __builtin_bit_cast(float, w.z & 0xffff0000u), __builtin_bit_cast(float, w.w << 16), __builtin_bit_cast(float, w.w & 0xffff0000u)} + gv1 * X[ai][bj][m][1];
                    X[ai][bj][m][0] = x0; X[ai][bj][m][1] = x1;
                    ss += (x0[0] * x0[0] + x0[1] * x0[1]) + (x0[2] * x0[2] + x0[3] * x0[3]) + (x1[0] * x1[0] + x1[1] * x1[1]) + (x1[2] * x1[2] + x1[3] * x1[3]); }
                EpiResidN::row_stat(ss, rsf + row, true, fq);
                asm volatile("" : "+v"(gp)); }
        }
        __builtin_amdgcn_fence(__ATOMIC_RELEASE, "agent");
        __syncthreads();
        if (wr == 0 && wc == 0 && fr == 0 && fq == 0) { unsigned* cnt = (unsigned*)(ws + WS_CTL + CTL_FCNT) + u.pm;
            __hip_atomic_fetch_add(cnt, 1u, __ATOMIC_RELEASE, __HIP_MEMORY_SCOPE_AGENT);
            while (__hip_atomic_load(cnt, __ATOMIC_RELAXED, __HIP_MEMORY_SCOPE_AGENT) < 4u) __builtin_amdgcn_s_sleep(2); }
        __syncthreads();
        __builtin_amdgcn_fence(__ATOMIC_ACQUIRE, "agent");
        float* out = A->out;
#pragma unroll
        for (int ai = 0; ai < 2; ++ai)
#pragma unroll
            for (int m = 0; m < 4; ++m) { const int row = row0 + ai * HALF + m * 16; const size_t off = (size_t)row * 1024 + col0;
                const float rstd = rstd_of(__hip_atomic_load(rsf + row, __ATOMIC_RELAXED, __HIP_MEMORY_SCOPE_AGENT));
#pragma unroll
                for (int bj = 0; bj < 2; ++bj) { const f32x4 g0 = *(const PG8_LAS f32x4*)(gfp + bj * HALF), g1 = *(const PG8_LAS f32x4*)(gfp + bj * HALF + 4);
                    *(f32x4*)(out + off + bj * HALF) = (X[ai][bj][m][0] * rstd) * g0; *(f32x4*)(out + off + bj * HALF + 4) = (X[ai][bj][m][1] * rstd) * g1; }
                asm volatile("" : "+v"(gfp)); }
    }
};
template <class Epi, class Sched, bool ALIGN_EPI = false, bool SP2 = false>
__device__ __forceinline__ void gemm_phase(PG8_LAS unsigned char* lds, const Gemm g, const Sched& S, const Epi& E, int wave_in) {
    int tid = wave_in * 64 + lane_id(); asm volatile("" : "+v"(tid));
    const int wid = __builtin_amdgcn_readfirstlane(tid >> 6), lane = tid & 63, wr = wid >> 2, wc = wid & 3, fr = lane & 15, fq = lane >> 4;
    const int K = g.K, nt = K / BK;
    unsigned voffA[2], voffB[2];
#pragma unroll
    for (int i = 0; i < 2; ++i) { int R, C; stage_rc(tid * 16 + i * 8192, R, C); const int Rb = Epi::PERM ? ((R & ~31) + perm32(R & 31)) : R;
        voffA[i] = (unsigned)(R * K + C) * 2u; voffB[i] = (unsigned)(Rb * K + C) * 2u; }
    const size_t kstep = (size_t)(BK * 2);
    const size_t hstep = (size_t)HALF * K * 2;
    const size_t tstep = 2 * hstep;
    const unsigned ldsw = (unsigned)wid * 1024u;
    const int aoff = lds_byte(wr * 64 + fr, fq * 8), boff = lds_byte(wc * 32 + fr, fq * 8);
#define PG8_SA(b, h) (((b) * 2 + (h)) * HTB)
#define PG8_SB(b, h) ((4 + (b) * 2 + (h)) * HTB)
#define PG8_STAGE(bufoff, gbase, voff) do { _Pragma("unroll") for (int _i = 0; _i < 2; ++_i) \
        __builtin_amdgcn_global_load_lds((const unsigned*)((const char*)(gbase) + (voff)[_i]), (PG8_LAS unsigned*)(lds + (bufoff) + ldsw + _i * 8192), 16, 0, 0); } while (0)
#define PG8_LDA(dst, b, h) do { _Pragma("unroll") for (int m = 0; m < 4; ++m) _Pragma("unroll") for (int k = 0; k < 2; ++k) dst[m][k] = *(const PG8_LAS bf16x8*)(lds + PG8_SA(b, h) + aoff + m * 2048 + k * 1024); } while (0)
#define PG8_LDB(dst, b, h) do { _Pragma("unroll") for (int n = 0; n < 2; ++n) _Pragma("unroll") for (int k = 0; k < 2; ++k) dst[n][k] = *(const PG8_LAS bf16x8*)(lds + PG8_SB(b, h) + boff + n * 2048 + k * 1024); } while (0)
#define PG8_MMA(ai, bj, At, Bt) do { __builtin_amdgcn_s_setprio(1); _Pragma("unroll") for (int m = 0; m < 4; ++m) _Pragma("unroll") for (int n = 0; n < 2; ++n) _Pragma("unroll") for (int k = 0; k < 2; ++k) \
        acc[ai][bj][m][n] = __builtin_amdgcn_mfma_f32_16x16x32_bf16(Bt[n][k], At[m][k], acc[ai][bj][m][n], 0, 0, 0); __builtin_amdgcn_s_setprio(0); } while (0)
#define PG8_WAIT_V(n) asm volatile("s_waitcnt vmcnt(" #n ")" ::: "memory")
#define PG8_WAIT_L(n) asm volatile("s_waitcnt lgkmcnt(" #n ")" ::: "memory")
#define PG8_BAR __builtin_amdgcn_s_barrier()
#define PG8_SCHED __builtin_amdgcn_sched_barrier(0)
    Unit cur, nxt; int ui = 0;
    if (!S.next(0, cur)) return;
    f32x4 acc[2][2][4][2];
#pragma unroll
    for (int a = 0; a < 2; ++a)
#pragma unroll
        for (int b = 0; b < 2; ++b)
#pragma unroll
            for (int m = 0; m < 4; ++m)
#pragma unroll
                for (int n = 0; n < 2; ++n) acc[a][b][m][n] = (f32x4){0.f, 0.f, 0.f, 0.f};
    bf16x8 At[4][2], B0[2][2], B1[2][2];
    const char* cA = (const char*)g.A + (size_t)cur.pm * tstep; const char* cB = (const char*)g.Bt + (size_t)cur.pn * tstep;
    S.a_ready(cur);
    if constexpr (SP2) {
        PG8_STAGE(PG8_SB(0, 0), cB, voffB); PG8_STAGE(PG8_SB(0, 1), cB + hstep, voffB); PG8_STAGE(PG8_SA(0, 0), cA, voffA); PG8_STAGE(PG8_SA(0, 1), cA + hstep, voffA);
        if (wr == 1) PG8_BAR;
        PG8_WAIT_V(2); PG8_BAR;
        PG8_STAGE(PG8_SB(1, 0), cB + kstep, voffB); PG8_STAGE(PG8_SA(1, 0), cA + kstep, voffA); PG8_STAGE(PG8_SB(1, 1), cB + hstep + kstep, voffB);
        PG8_WAIT_V(6); PG8_BAR;
    } else {
        PG8_STAGE(PG8_SB(0, 0), cB, voffB); PG8_STAGE(PG8_SA(0, 0), cA, voffA); PG8_STAGE(PG8_SB(0, 1), cB + hstep, voffB); PG8_STAGE(PG8_SA(0, 1), cA + hstep, voffA);
        if (wr == 1) PG8_BAR;
        PG8_WAIT_V(4); PG8_BAR;
        PG8_STAGE(PG8_SB(1, 0), cB + kstep, voffB); PG8_STAGE(PG8_SA(1, 0), cA + kstep, voffA); PG8_STAGE(PG8_SB(1, 1), cB + hstep + kstep, voffB);
        PG8_WAIT_V(6); PG8_BAR;
    }
    for (;;) {
        const bool has_next = S.next(ui + 1, nxt);
        const char* nA = has_next ? (const char*)g.A + (size_t)nxt.pm * tstep : cA; const char* nB = has_next ? (const char*)g.Bt + (size_t)nxt.pn * tstep : cB;
        for (int t = 0; t < nt; t += 2) {
            const bool last = (t == nt - 2);
            const char* a1 = cA + (size_t)(t + 1) * kstep;
            const char* a2 = last ? nA : cA + (size_t)(t + 2) * kstep; const char* b2 = last ? nB : cB + (size_t)(t + 2) * kstep;
            const char* a3 = a2 + kstep; const char* b3 = b2 + kstep;
            if (last && has_next) S.a_ready(nxt);
            if (last) E.prefetch(lds, cur, wid, lane);
            if constexpr (SP2) {
            PG8_LDB(B0, 0, 0); PG8_LDB(B1, 0, 1); PG8_SCHED; PG8_LDA(At, 0, 0); PG8_STAGE(PG8_SA(1, 1), a1 + hstep, voffA);
            PG8_WAIT_V(8); PG8_WAIT_L(0); PG8_BAR; PG8_MMA(0, 0, At, B0); PG8_MMA(0, 1, At, B1); PG8_BAR; PG8_SCHED;
            PG8_LDA(At, 0, 1); PG8_STAGE(PG8_SB(0, 0), b2, voffB); PG8_STAGE(PG8_SB(0, 1), b2 + hstep, voffB); PG8_STAGE(PG8_SA(0, 0), a2, voffA);
            PG8_WAIT_V(8); PG8_WAIT_L(0); PG8_BAR; PG8_MMA(1, 0, At, B0); PG8_MMA(1, 1, At, B1); PG8_BAR; PG8_SCHED;
            PG8_LDB(B0, 1, 0); PG8_LDB(B1, 1, 1); PG8_SCHED; PG8_LDA(At, 1, 0); PG8_STAGE(PG8_SA(0, 1), a2 + hstep, voffA);
            PG8_WAIT_V(8); PG8_WAIT_L(0); PG8_BAR; PG8_MMA(0, 0, At, B0); PG8_MMA(0, 1, At, B1); PG8_BAR; PG8_SCHED;
            PG8_LDA(At, 1, 1); PG8_STAGE(PG8_SB(1, 0), b3, voffB); PG8_STAGE(PG8_SB(1, 1), b3 + hstep, voffB); PG8_STAGE(PG8_SA(1, 0), a3, voffA);
            PG8_WAIT_V(8); PG8_WAIT_L(0); PG8_BAR; PG8_MMA(1, 0, At, B0); PG8_MMA(1, 1, At, B1); PG8_BAR; PG8_SCHED;
            } else {
            PG8_LDB(B0, 0, 0); PG8_SCHED; PG8_LDA(At, 0, 0); PG8_STAGE(PG8_SA(1, 1), a1 + hstep, voffA);
            PG8_WAIT_L(8); PG8_BAR; PG8_WAIT_L(0); PG8_MMA(0, 0, At, B0); PG8_BAR; PG8_SCHED;
            PG8_LDB(B1, 0, 1); PG8_STAGE(PG8_SB(0, 0), b2, voffB);
            PG8_BAR; PG8_WAIT_L(0); PG8_MMA(0, 1, At, B1); PG8_BAR;
            PG8_LDA(At, 0, 1); PG8_STAGE(PG8_SA(0, 0), a2, voffA);
            PG8_BAR; PG8_WAIT_L(0); PG8_MMA(1, 0, At, B0); PG8_BAR; PG8_SCHED;
            PG8_STAGE(PG8_SB(0, 1), b2 + hstep, voffB);
            PG8_WAIT_V(6); PG8_BAR; PG8_MMA(1, 1, At, B1); PG8_BAR;
            PG8_LDB(B0, 1, 0); PG8_SCHED; PG8_LDA(At, 1, 0); PG8_STAGE(PG8_SA(0, 1), a2 + hstep, voffA);
            PG8_WAIT_L(8); PG8_BAR; PG8_WAIT_L(0); PG8_MMA(0, 0, At, B0); PG8_BAR; PG8_SCHED;
            PG8_LDB(B1, 1, 1); PG8_STAGE(PG8_SB(1, 0), b3, voffB);
            PG8_BAR; PG8_WAIT_L(0); PG8_MMA(0, 1, At, B1); PG8_BAR;
            PG8_LDA(At, 1, 1); PG8_STAGE(PG8_SA(1, 0), a3, voffA);
            PG8_BAR; PG8_WAIT_L(0); PG8_MMA(1, 0, At, B0); PG8_BAR; PG8_SCHED;
            PG8_STAGE(PG8_SB(1, 1), b3 + hstep, voffB);
            PG8_WAIT_V(6); PG8_BAR; PG8_MMA(1, 1, At, B1); PG8_BAR;
            }
        }
        if constexpr (ALIGN_EPI) { if (wr == 0) PG8_BAR; }
        if constexpr (!Epi::AFTER_DRAIN) {
#if defined(EPI_PROBE)
            const unsigned long long ep0_ = (Epi::PROBE_ID == EPI_PROBE) ? __builtin_amdgcn_s_memrealtime() : 0ull;
#endif
            E(acc, cur, wr, wc, fr, fq, lds); S.done(cur);
#if defined(EPI_PROBE)
            if (Epi::PROBE_ID == EPI_PROBE) { asm volatile("s_waitcnt vmcnt(0)" ::: "memory"); const unsigned long long d_ = __builtin_amdgcn_s_memrealtime() - ep0_; const unsigned long long e_ = __builtin_amdgcn_s_memrealtime() + 3ull * d_; while (__builtin_amdgcn_s_memrealtime() < e_) __builtin_amdgcn_s_sleep(2); }
#endif
        }
        if (!has_next) break;
#pragma unroll
        for (int a = 0; a < 2; ++a)
#pragma unroll
            for (int b = 0; b < 2; ++b)
#pragma unroll
                for (int m = 0; m < 4; ++m)
#pragma unroll
                    for (int n = 0; n < 2; ++n) acc[a][b][m][n] = (f32x4){0.f, 0.f, 0.f, 0.f};
        cur = nxt; cA = nA; cB = nB; ++ui;
        if constexpr (ALIGN_EPI) { if (wr == 1) PG8_BAR; }
    }
    PG8_WAIT_V(0);
    if constexpr (!ALIGN_EPI) { if (wr == 0) PG8_BAR; }
    PG8_BAR;
    if constexpr (Epi::AFTER_DRAIN) { E.fused(acc, cur, wr, wc, fr, fq, lds, wid, lane); S.done(cur); }
#undef PG8_SA
#undef PG8_SB
#undef PG8_STAGE
#undef PG8_LDA
#undef PG8_LDB
#undef PG8_MMA
#undef PG8_WAIT_V
#undef PG8_WAIT_L
#undef PG8_BAR
#undef PG8_SCHED
}
}
#define XB_TMO      128
#define XB_XCNT(j)  (256  + 64 * (j))
#define XB_XSUB(j)  (1280 + 64 * (j))
#define XB_XGEN(j)  (2304 + 64 * (j))
#define XB_TOP      3328
#define XB_TOPGEN   3392
#define XCD_BAR_WORDS 3456
#define XB_SPIN_CAP (1u << 18)

__device__ __forceinline__ unsigned xb_ld(unsigned* p)              { return __hip_atomic_load(p, __ATOMIC_RELAXED, __HIP_MEMORY_SCOPE_AGENT); }
__device__ __forceinline__ unsigned xb_add(unsigned* p, unsigned v) { return __hip_atomic_fetch_add(p, v, __ATOMIC_RELAXED, __HIP_MEMORY_SCOPE_AGENT); }
__device__ __forceinline__ unsigned xb_xcc_id() { return (unsigned)__builtin_amdgcn_s_getreg((3 << 11) | 20) & 0xFu; }
#define XB_SPIN(cond, bar) do { unsigned _sp = 0; while (cond) { __builtin_amdgcn_s_sleep(1); \
    if ((++_sp & 255u) == 0u) { if (xb_ld(&(bar)[XB_TMO])) break; if (_sp > XB_SPIN_CAP) { atomicAdd(&(bar)[XB_TMO], 1u); break; } } } } while (0)

struct XcdBarrier {
    unsigned w;
    unsigned* bar; unsigned x;
    volatile LAS unsigned* st;
};

__device__ __forceinline__ XcdBarrier xcd_barrier_post(unsigned* bar, volatile LAS unsigned* st) {
    XcdBarrier b; b.bar = bar; b.x = xb_xcc_id(); b.st = st;
    b.w = (unsigned)__builtin_amdgcn_readfirstlane((int)(threadIdx.x >> 6));
    if (threadIdx.x == 0) (void)xb_add(&bar[XB_XCNT(b.x)], 1u);
    return b;
}
__device__ __forceinline__ void xcd_barrier_complete(unsigned* bar, unsigned x, unsigned& nloc, unsigned& nx) {
    const unsigned G = gridDim.x * gridDim.y * gridDim.z;
    unsigned sum, cnt, mine, sp = 0u;
    for (;;) {
        sum = 0u; cnt = 0u; mine = 0u;
#pragma unroll
        for (unsigned j = 0; j < 16; ++j) { const unsigned c = xb_ld(&bar[XB_XCNT(j)]); sum += c; cnt += (c > 0u) ? 1u : 0u; mine = (j == x) ? c : mine; }
        if (sum == G) break;
        __builtin_amdgcn_s_sleep(1);
        if ((++sp & 255u) == 0u) { if (xb_ld(&bar[XB_TMO])) break; if (sp > XB_SPIN_CAP) { atomicAdd(&bar[XB_TMO], 1u); break; } }
    }
    nloc = mine > 0u ? mine : 1u; nx = cnt > 0u ? cnt : 1u;
}

__device__ __forceinline__ void xcd_barrier(const XcdBarrier& b) {
    asm volatile("s_waitcnt vmcnt(0)" ::: "memory");
    __syncthreads();
    if (b.w == 0u && lane_id() == 0) {
        unsigned* bar = b.bar;
        __builtin_amdgcn_s_waitcnt(0);
        unsigned nloc = b.st[0], nx = b.st[1];
        if (nloc == 0u) { xcd_barrier_complete(bar, b.x, nloc, nx); b.st[0] = nloc; b.st[1] = nx; }
        const unsigned old = xb_add(&bar[XB_XSUB(b.x)], 1u);
        const unsigned gen = old / nloc;
        if (old + 1u == (gen + 1u) * nloc) {
            __builtin_amdgcn_fence(__ATOMIC_RELEASE, "agent");
            asm volatile("s_waitcnt vmcnt(0)" ::: "memory");
            const unsigned og = xb_add(&bar[XB_TOP], 1u);
            const unsigned tg = og / nx;
            if (og + 1u == (tg + 1u) * nx) xb_add(&bar[XB_TOPGEN], 1u);
            else XB_SPIN(xb_ld(&bar[XB_TOPGEN]) == tg, bar);
            __builtin_amdgcn_fence(__ATOMIC_ACQUIRE, "agent");
            xb_add(&bar[XB_XGEN(b.x)], 1u);
            asm volatile("s_waitcnt vmcnt(0)" ::: "memory");
        } else {
            XB_SPIN(xb_ld(&bar[XB_XGEN(b.x)]) == gen, bar);
            __builtin_amdgcn_fence(__ATOMIC_ACQUIRE, "agent");
            asm volatile("s_waitcnt vmcnt(0)" ::: "memory");
        }
    }
    __syncthreads();
}

__device__ __forceinline__ void p0_transpose_item(const float* W, int ldw, int K, bf16* WT, int dst_row0, LAS float* scr, int k0, int n0, int lane) {
#pragma unroll 8
    for (int i = 0; i < 32; ++i) { const int kk = 2 * i + (lane >> 5); scr[kk * 33 + (lane & 31)] = W[(size_t)(k0 + kk) * ldw + n0 + (lane & 31)]; }
    LDS_WAIT(); asm volatile("" ::: "memory");
    const int c = lane & 7;
#pragma unroll
    for (int j = 0; j < 4; ++j) { const int n = (lane >> 3) + 8 * j; const LAS float* s = scr + (8 * c) * 33 + n;
        v4u o; o.x = pk2(s[0 * 33], s[1 * 33]); o.y = pk2(s[2 * 33], s[3 * 33]); o.z = pk2(s[4 * 33], s[5 * 33]); o.w = pk2(s[6 * 33], s[7 * 33]);
        *(GAS v4u*)(WT + (size_t)(dst_row0 + n) * K + k0 + 8 * c) = o; }
    LDS_WAIT(); asm volatile("" ::: "memory");
}
__device__ __forceinline__ void sincos_d(double a, double& s, double& c) {
    const double k = __builtin_rint(a * 0.63661977236758134308);
    double t = __builtin_fma(-k, 1.57079632679489655800e+00, a); t = __builtin_fma(-k, 6.12323399573676603587e-17, t);
    const double t2 = t * t;
    double sp = 1.0 / 6227020800.0; sp = sp * t2 - 1.0 / 39916800.0; sp = sp * t2 + 1.0 / 362880.0; sp = sp * t2 - 1.0 / 5040.0; sp = sp * t2 + 1.0 / 120.0; sp = sp * t2 - 1.0 / 6.0; sp = sp * t2 + 1.0;
    const double st = sp * t;
    double cp = -1.0 / 87178291200.0; cp = cp * t2 + 1.0 / 479001600.0; cp = cp * t2 - 1.0 / 3628800.0; cp = cp * t2 + 1.0 / 40320.0; cp = cp * t2 - 1.0 / 720.0; cp = cp * t2 + 1.0 / 24.0; cp = cp * t2 - 0.5; cp = cp * t2 + 1.0;
    const int q = (int)((long long)k & 3ll);
    s = (q == 0) ? st : (q == 1) ? cp : (q == 2) ? -st : -cp;
    c = (q == 0) ? cp : (q == 1) ? -st : (q == 2) ? -cp : st;
}


__device__ __forceinline__ void vecmat_unit(const LAS float* vs, LAS float* part, const float* W, int ldw, int n0, int ncols, float* outp, int out_bstride, const float* bias, int tid, int lane, int wave) {
    float acc[8];
#pragma unroll
    for (int b = 0; b < 8; ++b) acc[b] = 0.f;
    const int k0 = wave * 128; const bool act = lane < ncols;
    const float* Wp = W + (size_t)k0 * ldw + n0 + (act ? lane : 0);
    for (int kb = 0; kb < 128; kb += 64) {
        float w[64];
#pragma unroll
        for (int j = 0; j < 64; ++j) w[j] = Wp[(size_t)(kb + j) * ldw];
#pragma unroll
        for (int j = 0; j < 64; ++j)
#pragma unroll
            for (int b = 0; b < 8; ++b) acc[b] += vs[b * D + k0 + kb + j] * w[j];
    }
#pragma unroll
    for (int b = 0; b < 8; ++b) part[(wave * 8 + b) * 64 + lane] = acc[b];
    __syncthreads();
    { const int b = tid >> 6, col = tid & 63;
      if (col < ncols) { float s = bias ? bias[col] : 0.f;
#pragma unroll
        for (int w = 0; w < 8; ++w) s += part[(w * 8 + b) * 64 + col];
        outp[(size_t)b * out_bstride + col] = s; } }
    __syncthreads();
}

__device__ __forceinline__ void prologue_a(LAS unsigned char* lds, const void* const* in, unsigned char* ws, int tid, int lane, int wave, int vcu, int G) {
    const float* cvec = (const float*)in[1]; const int* positions = (const int*)in[2];
    const float* w_ada = (const float*)in[4]; const float* b_ada = (const float*)in[5];
    const int gtid = vcu * (NWAVES * 64) + tid, nth = G * NWAVES * 64;
    { f32x4* z0 = (f32x4*)(ws + WS_RS); for (int i = gtid; i < (int)((size_t)DEPTH * 3 * M * 8 / 16); i += nth) z0[i] = (f32x4){0.f, 0.f, 0.f, 0.f};
    }
    {
        LAS float* sc = (LAS float*)lds;
        LAS float* part = (LAS float*)(lds + 32768);
        float* mod = (float*)(ws + WS_MOD);
        for (int i = tid; i < BATCH * D; i += NWAVES * 64) sc[i] = silu_acc(cvec[i]);
        __syncthreads();
        for (int u = vcu; u < DEPTH * 3 * 48; u += G) { const int ls = u / 48, n0 = (u % 48) * 64;
            vecmat_unit(sc, part, w_ada + (size_t)ls * D * 3 * D, 3 * D, n0, 64, mod + (size_t)ls * BATCH * 3 * D + n0, 3 * D, b_ada + (size_t)ls * 3 * D + n0, tid, lane, wave); }
    }
    if (gtid < 64) {
        double r = 1.0, p = 0.8659643233600653;
#pragma unroll
        for (int bit = 0; bit < 6; ++bit) { if ((gtid >> bit) & 1) r *= p; p *= p; }
        ((float*)(ws + WS_ROPE))[gtid] = (float)r;
    }
    {
        LAS float* scr = (LAS float*)(lds + wave * 16384);
        const int gw = vcu * NWAVES + wave, NGW = G * NWAVES;
        constexpr int I_13 = (D / 64) * (DFF / 32), I_2 = (DFF / 64) * (D / 32), I_IN = (D / 64) * (DZ / 32), I_OUT = (D / 64) * (D / 32);
        constexpr int PER_LAYER = 4 * I_13 + 2 * I_2 + I_IN + I_OUT, NITEMS = DEPTH * PER_LAYER;
#define TR_DECODE(IT_, SRC_, LDW_, WT_, KK_, DROW_, K0_) do { \
            const int l_ = (IT_) / PER_LAYER; int r_ = (IT_) % PER_LAYER; unsigned char* lw_ = ws + WS_W + (size_t)l_ * LW_BYTES; \
            if (r_ < 4 * I_13) { const int q_ = r_ / I_13, rr_ = r_ % I_13, f_ = q_ >> 1, t_ = q_ & 1, kb_ = rr_ / (DFF / 32), n0_ = (rr_ % (DFF / 32)) * 32; \
                SRC_ = (t_ ? (const float*)in[7] : (const float*)in[6]) + (size_t)(l_ * 2 + f_) * D * DFF + (size_t)(kb_ * 64) * DFF + n0_; LDW_ = DFF; WT_ = (bf16*)(lw_ + LW_W13 + (size_t)f_ * W13_BYTES); KK_ = D; \
                DROW_ = 256 * (n0_ >> 7) + 128 * t_ + (n0_ & 127); K0_ = kb_ * 64; } \
            else if ((r_ -= 4 * I_13) < 2 * I_2) { const int f_ = r_ / I_2, rr_ = r_ % I_2, kb_ = rr_ / (D / 32), n0_ = (rr_ % (D / 32)) * 32; \
                SRC_ = (const float*)in[8] + (size_t)(l_ * 2 + f_) * DFF * D + (size_t)(kb_ * 64) * D + n0_; LDW_ = D; WT_ = (bf16*)(lw_ + LW_W2 + (size_t)f_ * W2_BYTES); KK_ = DFF; DROW_ = n0_; K0_ = kb_ * 64; } \
            else if ((r_ -= 2 * I_2) < I_IN) { const int kb_ = r_ / (DZ / 32), n0_ = (r_ % (DZ / 32)) * 32; int dr_ = n0_; \
                if (n0_ < 1024) { const int grp_ = n0_ >> 9, head_ = (n0_ >> 7) & 3, half_ = (n0_ >> 6) & 1; dr_ = 256 * (2 * grp_ + (head_ >> 1)) + 128 * half_ + 64 * (head_ & 1) + (n0_ & 63); }     \
                SRC_ = (const float*)in[9] + (size_t)l_ * D * DIN + (size_t)(kb_ * 64) * DIN + n0_; LDW_ = DIN; WT_ = (bf16*)(lw_ + LW_WIN); KK_ = D; DROW_ = dr_; K0_ = kb_ * 64; } \
            else { r_ -= I_IN; const int kb_ = r_ / (D / 32), n0_ = (r_ % (D / 32)) * 32; \
                SRC_ = (const float*)in[16] + (size_t)l_ * D * D + (size_t)(kb_ * 64) * D + n0_; LDW_ = D; WT_ = (bf16*)(lw_ + LW_WOUT); KK_ = D; DROW_ = n0_; K0_ = kb_ * 64; } } while (0)
#define TR_LOAD(V_, SRC_, LDW_) do { _Pragma("unroll") for (int i_ = 0; i_ < 32; ++i_) V_[i_] = SRC_[(size_t)(2 * i_ + (lane >> 5)) * LDW_ + (lane & 31)]; } while (0)
#define TR_STORE(V_, WT_, KK_, DROW_, K0_) do { \
            _Pragma("unroll") for (int i_ = 0; i_ < 32; ++i_) scr[(2 * i_ + (lane >> 5)) * 33 + (lane & 31)] = V_[i_]; \
            LDS_WAIT(); asm volatile("" ::: "memory"); \
            { const int c_ = lane & 7; \
              _Pragma("unroll") for (int j_ = 0; j_ < 4; ++j_) { const int n_ = (lane >> 3) + 8 * j_; const LAS float* s_ = scr + (8 * c_) * 33 + n_; \
                v4u o_; o_.x = pk2(s_[0 * 33], s_[1 * 33]); o_.y = pk2(s_[2 * 33], s_[3 * 33]); o_.z = pk2(s_[4 * 33], s_[5 * 33]); o_.w = pk2(s_[6 * 33], s_[7 * 33]); \
                *(GAS v4u*)(WT_ + (size_t)(DROW_ + n_) * KK_ + K0_ + 8 * c_) = o_; } } \
            LDS_WAIT(); asm volatile("" ::: "memory"); } while (0)
        const float* sa = nullptr; const float* sb = nullptr; bf16* wa = nullptr; bf16* wb = nullptr; int la = 0, lb = 0, ka = 0, kb2 = 0, da = 0, db = 0, k0a = 0, k0b = 0;
        float va[32], vb[32];
        int it = gw;
        if (it < NITEMS) { TR_DECODE(it, sa, la, wa, ka, da, k0a); TR_LOAD(va, sa, la); }
        while (it < NITEMS) {
            const int it2 = it + NGW;
            if (it2 < NITEMS) { TR_DECODE(it2, sb, lb, wb, kb2, db, k0b); TR_LOAD(vb, sb, lb); }
            TR_STORE(va, wa, ka, da, k0a);
            if (it2 >= NITEMS) break;
            const int it3 = it2 + NGW;
            if (it3 < NITEMS) { TR_DECODE(it3, sa, la, wa, ka, da, k0a); TR_LOAD(va, sa, la); }
            TR_STORE(vb, wb, kb2, db, k0b);
            it = it3;
        }
#undef TR_DECODE
#undef TR_LOAD
#undef TR_STORE
    }
}
__device__ __forceinline__ void prologue_b(LAS unsigned char* lds, const void* const* in, unsigned char* ws, unsigned char* outb, int tid, int lane, int wave, int vcu, int G) {
    const float* x = (const float*)in[0]; const float* norm_g = (const float*)in[3];
    const float* mod = (const float*)(ws + WS_MOD);
    const int gtid = vcu * (NWAVES * 64) + tid, nth = G * NWAVES * 64;
    { float* gmt = (float*)(ws + WS_GM);
      for (int i = gtid; i < DEPTH * 3 * BATCH * D; i += nth) { const int c = i & (D - 1), b = (i >> 10) & 7, ls = i >> 13; gmt[i] = norm_g[ls * D + c] * (1.0f + mod[((size_t)ls * BATCH + b) * 3 * D + D + c]); } }
    {
        LAS float* vs = (LAS float*)lds;
        LAS float* part = (LAS float*)(lds + 32768);
        const float* w_ff1 = (const float*)in[6]; const float* w_ff3 = (const float*)in[7]; const float* w_in = (const float*)in[9];
        constexpr int U13 = DEPTH * 2 * 2 * (DFF / 64), UIN = DEPTH * 65;
        for (int u = vcu; u < U13 + UIN; u += G) {
            int l, s;
            if (u < U13) { l = u / (4 * (DFF / 64)); s = ((u / (2 * (DFF / 64))) & 1) ? 2 : 0; } else { l = (u - U13) / 65; s = 1; }
            __syncthreads();
            for (int i = tid; i < BATCH * D; i += NWAVES * 64) vs[i] = mod[((size_t)(l * 3 + s) * BATCH + (i >> 10)) * 3 * D + (i & (D - 1))];
            __syncthreads();
            if (u < U13) { const int f = (u / (2 * (DFF / 64))) & 1, t = (u / (DFF / 64)) & 1, nb = u % (DFF / 64), n0 = nb * 64;
                const float* W = (t ? w_ff3 : w_ff1) + (size_t)(l * 2 + f) * D * DFF;
                vecmat_unit(vs, part, W, DFF, n0, 64, (float*)(ws + WS_SW13) + (size_t)(l * 2 + f) * BATCH * 2 * DFF + 256 * (n0 >> 7) + 128 * t + (n0 & 127), 2 * DFF, nullptr, tid, lane, wave);
            } else { const int nb = (u - U13) % 65, n0 = nb * 64;
                vecmat_unit(vs, part, w_in + (size_t)l * D * DIN, DIN, n0, nb == 64 ? 8 : 64, (float*)(ws + WS_SWIN) + (size_t)l * BATCH * DIN + n0, DIN, nullptr, tid, lane, wave); }
        }
    }
    {
        const int gw = vcu * NWAVES + wave, NGW = G * NWAVES;
        bf16* hout = (bf16*)(outb + OUT_H); unsigned long long* rs = (unsigned long long*)(ws + WS_RS);
        for (int grp = gw; grp < M / 16; grp += NGW) {
            const int row0 = grp * 16, b = row0 / SEQ;
            f32x4 gm[4];
#pragma unroll
            for (int j = 0; j < 4; ++j) { const int col = 4 * lane + 256 * j; gm[j] = *(const f32x4*)(norm_g + col) * (1.0f + *(const f32x4*)(mod + (size_t)b * 3 * D + D + col)); }
            for (int r = 0; r < 16; r += 2) {
                const int row = row0 + r;
                const GAS f32x4* xr = (const GAS f32x4*)(x + (size_t)row * D) + lane;
                f32x4 v[4], v2[4]; float ss = 0.f, ss2 = 0.f;
#pragma unroll
                for (int j = 0; j < 4; ++j) { v[j] = xr[64 * j]; v2[j] = xr[64 * j + D / 4]; }
#pragma unroll
                for (int j = 0; j < 4; ++j) { ss += (v[j].x * v[j].x + v[j].y * v[j].y) + (v[j].z * v[j].z + v[j].w * v[j].w); ss2 += (v2[j].x * v2[j].x + v2[j].y * v2[j].y) + (v2[j].z * v2[j].z + v2[j].w * v2[j].w); }
                ss = wave_sum(ss); ss2 = wave_sum(ss2);
                if (lane == 0) { rs[row] = (unsigned long long)(ss * RS_SCALE); rs[row + 1] = (unsigned long long)(ss2 * RS_SCALE); }
                GAS unsigned long long* o8 = (GAS unsigned long long*)(hout + (size_t)row * D) + lane;
#pragma unroll
                for (int j = 0; j < 4; ++j) { const f32x4 t = v[j] * gm[j], t2 = v2[j] * gm[j];
                    o8[64 * j] = (unsigned long long)pk2(t.x, t.y) | ((unsigned long long)pk2(t.z, t.w) << 32);
                    o8[64 * j + D / 4] = (unsigned long long)pk2(t2.x, t2.y) | ((unsigned long long)pk2(t2.z, t2.w) << 32); }
            }
        }
    }
}

__device__ __forceinline__ void final_norm_phase(const bf16* xb, float* out, const float* g, int gw, int NGW, int lane) {
    for (int grp = gw; grp < M / 16; grp += NGW) {
        f32x4 gm[4];
#pragma unroll
        for (int j = 0; j < 4; ++j) gm[j] = *(const f32x4*)(g + 4 * lane + 256 * j);
        for (int r = 0; r < 16; r += 2) {
            const size_t row = (size_t)(grp * 16 + r);
            typedef unsigned v2u __attribute__((ext_vector_type(2)));
            const GAS v2u* xr = (const GAS v2u*)(xb + row * D) + lane;
            v2u w[4], w2[4];
#pragma unroll
            for (int j = 0; j < 4; ++j) { w[j] = xr[64 * j]; w2[j] = xr[64 * j + D / 4]; }
            f32x4 v[4], v2[4]; float ss = 0.f, ss2 = 0.f;
#pragma unroll
            for (int j = 0; j < 4; ++j) { v[j] = (f32x4){bflo(w[j].x), bfhi(w[j].x), bflo(w[j].y), bfhi(w[j].y)}; v2[j] = (f32x4){bflo(w2[j].x), bfhi(w2[j].x), bflo(w2[j].y), bfhi(w2[j].y)};
                ss += (v[j].x * v[j].x + v[j].y * v[j].y) + (v[j].z * v[j].z + v[j].w * v[j].w); ss2 += (v2[j].x * v2[j].x + v2[j].y * v2[j].y) + (v2[j].z * v2[j].z + v2[j].w * v2[j].w); }
            const float rstd = 1.0f / sqrtf(wave_sum(ss) * (1.0f / D) + EPS), rstd2 = 1.0f / sqrtf(wave_sum(ss2) * (1.0f / D) + EPS);
            GAS f32x4* orow = (GAS f32x4*)(out + row * D) + lane;
#pragma unroll
            for (int j = 0; j < 4; ++j) { orow[64 * j] = (v[j] * rstd) * gm[j]; orow[64 * j + D / 4] = (v2[j] * rstd2) * gm[j]; }
        }
    }
}
__device__ __forceinline__ float lg2gamma(int h) { return h == 0 ? -0.04580368961312479f : h == 1 ? -0.02272007650008353f : h == 2 ? -0.011315313227834146f : -0.005646563141142063f; }
constexpr float QK_SCALE = 0.08838834764831845f;
__device__ __forceinline__ void ml_gate_scan(const float* gates, int row0, int h, int lane, float& bc0, float& bc1, float& ic0, float& ic1) {
    const float* gp = gates + (size_t)(row0 + 2 * lane) * 8;
    ic0 = gp[h]; ic1 = gp[8 + h];
    const float lf0 = logsigmoid_acc(gp[4 + h]), lf1 = logsigmoid_acc(gp[12 + h]);
    const float s1 = lf0 + lf1; float v = s1;
#pragma unroll
    for (int off = 1; off < 64; off <<= 1) { const float t = __shfl_up(v, off); if (lane >= off) v += t; }
    const float ex = v - s1; bc0 = ex + lf0; bc1 = ex + s1;
}
__device__ __forceinline__ void gates_job(const bf16* xg, const unsigned long long* rs, const float* w_in_l, const float* swin_l, const float* b_ig, const float* b_fg, float* gates, int lane, int wave, int vcu, int G) {
    f32x4 wg[16][2];
#pragma unroll
    for (int j = 0; j < 2; ++j)
#pragma unroll
        for (int e = 0; e < 8; ++e) { const float* wp = w_in_l + (size_t)(512 * j + 8 * lane + e) * DIN + DZ; wg[8 * j + e][0] = *(const f32x4*)wp; wg[8 * j + e][1] = *(const f32x4*)(wp + 4); }
    for (int blk = vcu; blk < M / 128; blk += G) {
        const int b = (blk * 128) / SEQ;
        float cq = 0.f;
        if (lane < 8) cq = swin_l[(size_t)b * DIN + DZ + lane] + (lane < 4 ? b_ig[lane] : b_fg[lane - 4]);
        for (int r = 0; r < 16; ++r) {
            const int row = blk * 128 + wave * 16 + r;
            const v4u a0 = *(const v4u*)(xg + (size_t)row * D + 8 * lane), a1 = *(const v4u*)(xg + (size_t)row * D + 512 + 8 * lane);
            const float xv[16] = {bflo(a0.x), bfhi(a0.x), bflo(a0.y), bfhi(a0.y), bflo(a0.z), bfhi(a0.z), bflo(a0.w), bfhi(a0.w), bflo(a1.x), bfhi(a1.x), bflo(a1.y), bfhi(a1.y), bflo(a1.z), bfhi(a1.z), bflo(a1.w), bfhi(a1.w)};
            f32x4 d0 = {0.f, 0.f, 0.f, 0.f}, d1 = d0;
#pragma unroll
            for (int e = 0; e < 16; ++e) { d0 += wg[e][0] * xv[e]; d1 += wg[e][1] * xv[e]; }
            float mine = 0.f;
#pragma unroll
            for (int q = 0; q < 4; ++q) { const float s0 = wave_sum(d0[q]), s1 = wave_sum(d1[q]); if (lane == q) mine = s0; if (lane == 4 + q) mine = s1; }
            if (lane < 8) gates[(size_t)row * 8 + lane] = (1.0f / sqrtf((float)rs[row] * RS_INV + EPS)) * mine + cq;
        }
    }
}

constexpr int ZLD = 128;
#define ZS(z, slice, row) ((z) + ((size_t)(slice) * M + (size_t)(row)) * ZLD)
typedef short bf16x8 __attribute__((ext_vector_type(8)));
typedef short s16x4 __attribute__((ext_vector_type(4)));
__device__ __forceinline__ unsigned cvtpk(float lo, float hi) { unsigned r; asm volatile("v_cvt_pk_bf16_f32 %0, %1, %2" : "=v"(r) : "v"(lo), "v"(hi)); return r; }
template <int OFF> __device__ __forceinline__ s16x4 tr_read(unsigned addr) { s16x4 r; asm volatile("ds_read_b64_tr_b16 %0, %1 offset:%2" : "=&v"(r) : "v"(addr), "i"(OFF) : "memory"); return r; }
template <int OFF> __device__ __forceinline__ bf16x8 lds_rd16(unsigned addr) { bf16x8 r; asm volatile("ds_read_b128 %0, %1 offset:%2" : "=&v"(r) : "v"(addr), "i"(OFF) : "memory"); return r; }
#define TR_WAIT() do { asm volatile("s_waitcnt lgkmcnt(0)" ::: "memory"); __builtin_amdgcn_sched_barrier(0); } while (0)
#define PK8(L, H) (bf16x8){L[0], L[1], L[2], L[3], H[0], H[1], H[2], H[3]}
__device__ __forceinline__ float silu_fast(float x) { return x * __builtin_amdgcn_rcpf(1.0f + __expf(-x)); }
__device__ __forceinline__ float sigmoid_fast(float x) { return __builtin_amdgcn_rcpf(1.0f + __expf(-x)); }
constexpr float LOG2E = 1.4426950408889634f;
#ifndef TPROBE
#define TPROBE 0
#endif
#define TPX_NOW() __builtin_amdgcn_s_memrealtime()
#define TPX_SPIN(T0_, K_) do { const unsigned long long d_ = TPX_NOW() - (T0_); const unsigned long long e_ = TPX_NOW() + (unsigned long long)(K_) * d_; while (TPX_NOW() < e_) __builtin_amdgcn_s_sleep(2); } while (0)
#define TP_BEGIN() const unsigned long long tp0_ = __builtin_amdgcn_s_memtime()
#define TP_SPIN(K) do { const unsigned long long d_ = __builtin_amdgcn_s_memtime() - tp0_; const unsigned long long e_ = __builtin_amdgcn_s_memtime() + (unsigned long long)(K) * d_; while (__builtin_amdgcn_s_memtime() < e_) __builtin_amdgcn_s_sleep(2); } while (0)

template <int NPC, int NTHR>
__device__ __forceinline__ void stage_rot(LAS bf16* dst, int ldst, int half_off, const bf16* zp0, const float2* rp0, float scale, const LAS float* rowscale, int tid) {
    for (int it = tid; it < 128 * NPC; it += NTHR) {
        const int l = it / NPC, pc = it % NPC;
        const bf16* zp = zp0 + (size_t)l * DZ + 8 * pc;
        const v4u a = *(const v4u*)zp, b = *(const v4u*)(zp + 64);
        const f32x4* rp = (const f32x4*)(rp0 + (size_t)l * 64 + 8 * pc);
        const f32x4 r0 = rp[0], r1 = rp[1], r2 = rp[2], r3 = rp[3];
        const float sc = rowscale ? scale * rowscale[l] : scale;
        const float t1[8] = {bflo(a.x), bfhi(a.x), bflo(a.y), bfhi(a.y), bflo(a.z), bfhi(a.z), bflo(a.w), bfhi(a.w)};
        const float t2[8] = {bflo(b.x), bfhi(b.x), bflo(b.y), bfhi(b.y), bflo(b.z), bfhi(b.z), bflo(b.w), bfhi(b.w)};
        const float cs[8] = {r0.x, r0.z, r1.x, r1.z, r2.x, r2.z, r3.x, r3.z}, sn[8] = {r0.y, r0.w, r1.y, r1.w, r2.y, r2.w, r3.y, r3.w};
        float o1[8], o2[8];
#pragma unroll
        for (int j = 0; j < 8; ++j) { o1[j] = (t1[j] * cs[j] - t2[j] * sn[j]) * sc; o2[j] = (t1[j] * sn[j] + t2[j] * cs[j]) * sc; }
        v4u w1, w2; w1.x = cvtpk(o1[0], o1[1]); w1.y = cvtpk(o1[2], o1[3]); w1.z = cvtpk(o1[4], o1[5]); w1.w = cvtpk(o1[6], o1[7]);
        w2.x = cvtpk(o2[0], o2[1]); w2.y = cvtpk(o2[2], o2[3]); w2.z = cvtpk(o2[4], o2[5]); w2.w = cvtpk(o2[6], o2[7]);
        *(LAS v4u*)(dst + l * ldst + 8 * pc) = w1; *(LAS v4u*)(dst + l * ldst + half_off + 8 * pc) = w2;
    }
}
template <int NCHK>
__device__ __forceinline__ void stage_conv(LAS bf16* dst, int ldst, const bf16* zp0, int s0, const float* cw, const float* cb, float scale, const LAS float* rowscale, int tid) {
    const int ch = tid % NCHK;
    float w[4][8], bias[8];
#pragma unroll
    for (int j = 0; j < 4; ++j) { const f32x4 a = *(const f32x4*)(cw + j * 1024 + 8 * ch), b = *(const f32x4*)(cw + j * 1024 + 8 * ch + 4);
        w[j][0] = a.x; w[j][1] = a.y; w[j][2] = a.z; w[j][3] = a.w; w[j][4] = b.x; w[j][5] = b.y; w[j][6] = b.z; w[j][7] = b.w; }
    { const f32x4 a = *(const f32x4*)(cb + 8 * ch), b = *(const f32x4*)(cb + 8 * ch + 4); bias[0] = a.x; bias[1] = a.y; bias[2] = a.z; bias[3] = a.w; bias[4] = b.x; bias[5] = b.y; bias[6] = b.z; bias[7] = b.w; }
    for (int it = tid; it < 128 * NCHK; it += NWAVES * 64) {
        const int l = it / NCHK, s = s0 + l;
        const bf16* zp = zp0 + (size_t)l * ZLD + 8 * ch;
        const v4u zero = {0u, 0u, 0u, 0u};
        const v4u x3 = *(const v4u*)zp, x2 = s >= 1 ? *(const v4u*)(zp - (ptrdiff_t)ZLD) : zero, x1 = s >= 2 ? *(const v4u*)(zp - (ptrdiff_t)2 * ZLD) : zero, x0 = s >= 3 ? *(const v4u*)(zp - (ptrdiff_t)3 * ZLD) : zero;
        const unsigned u3[4] = {x3.x, x3.y, x3.z, x3.w}, u2[4] = {x2.x, x2.y, x2.z, x2.w}, u1[4] = {x1.x, x1.y, x1.z, x1.w}, u0[4] = {x0.x, x0.y, x0.z, x0.w};
        const float sc = rowscale ? scale * rowscale[l] : scale;
        float o[8];
#pragma unroll
        for (int p = 0; p < 4; ++p) {
            const float a0 = bias[2 * p] + w[0][2 * p] * bflo(u0[p]) + w[1][2 * p] * bflo(u1[p]) + w[2][2 * p] * bflo(u2[p]) + w[3][2 * p] * bflo(u3[p]);
            const float a1 = bias[2 * p + 1] + w[0][2 * p + 1] * bfhi(u0[p]) + w[1][2 * p + 1] * bfhi(u1[p]) + w[2][2 * p + 1] * bfhi(u2[p]) + w[3][2 * p + 1] * bfhi(u3[p]);
            o[2 * p] = silu_fast(a0) * sc; o[2 * p + 1] = silu_fast(a1) * sc; }
        v4u wv; wv.x = cvtpk(o[0], o[1]); wv.y = cvtpk(o[2], o[3]); wv.z = cvtpk(o[4], o[5]); wv.w = cvtpk(o[6], o[7]);
        *(LAS v4u*)(dst + l * ldst + 8 * ch) = wv;
    }
}
template <int NCHK>
__device__ __forceinline__ void stage_copy(LAS bf16* dst, int ldst, const bf16* src, size_t src_ld, int tid) {
    for (int it = tid; it < 128 * NCHK; it += NWAVES * 64) { const int l = it / NCHK, ch = it % NCHK; *(LAS v4u*)(dst + l * ldst + 8 * ch) = *(const v4u*)(src + (size_t)l * src_ld + 8 * ch); }
}

constexpr int CST = 176;
constexpr int MA_TAB = 2 * 128 * CST * 2;
struct MaRegs { v4u k[4]; v4u v[4]; };
__device__ __forceinline__ void ma_load(MaRegs& R, int g, const bf16* zk, const bf16* zv, int c, int tid) {
    const int l = tid >> 2, q = tid & 3;
    if (g == 0) R.k[0] = *(const v4u*)(zk + (size_t)(c * CHUNK + l) * ZLD + (q >> 1) * 64 + (q & 1) * 8);
    else { const int s = c * CHUNK + l; const bf16* zp = zk + (size_t)s * ZLD + 8 * q; const v4u zero = {0u, 0u, 0u, 0u};
        R.k[3] = *(const v4u*)zp; R.k[2] = s >= 1 ? *(const v4u*)(zp - (ptrdiff_t)ZLD) : zero; R.k[1] = s >= 2 ? *(const v4u*)(zp - (ptrdiff_t)2 * ZLD) : zero; R.k[0] = s >= 3 ? *(const v4u*)(zp - (ptrdiff_t)3 * ZLD) : zero; }
#pragma unroll
    for (int i = 0; i < 4; ++i) { const int it = tid + 512 * i; R.v[i] = *(const v4u*)(zv + (size_t)(c * CHUNK + (it >> 4)) * ZLD + 8 * (it & 15)); }
}
__device__ __forceinline__ void ma_write(const MaRegs& R, int g, LAS bf16* comb, float rowsc, const float (&w)[4][8], const float (&bias)[8], int tid) {
    const int l = tid >> 2, q = tid & 3;
    v4u wv;
    if (g == 0) { const v4u a = R.k[0];
        wv.x = cvtpk(bflo(a.x) * rowsc, bfhi(a.x) * rowsc); wv.y = cvtpk(bflo(a.y) * rowsc, bfhi(a.y) * rowsc); wv.z = cvtpk(bflo(a.z) * rowsc, bfhi(a.z) * rowsc); wv.w = cvtpk(bflo(a.w) * rowsc, bfhi(a.w) * rowsc);
    } else {
        const unsigned u3[4] = {R.k[3].x, R.k[3].y, R.k[3].z, R.k[3].w}, u2[4] = {R.k[2].x, R.k[2].y, R.k[2].z, R.k[2].w}, u1[4] = {R.k[1].x, R.k[1].y, R.k[1].z, R.k[1].w}, u0[4] = {R.k[0].x, R.k[0].y, R.k[0].z, R.k[0].w};
        float o[8];
#pragma unroll
        for (int p = 0; p < 4; ++p) {
            const float a0 = bias[2 * p] + w[0][2 * p] * bflo(u0[p]) + w[1][2 * p] * bflo(u1[p]) + w[2][2 * p] * bflo(u2[p]) + w[3][2 * p] * bflo(u3[p]);
            const float a1 = bias[2 * p + 1] + w[0][2 * p + 1] * bfhi(u0[p]) + w[1][2 * p + 1] * bfhi(u1[p]) + w[2][2 * p + 1] * bfhi(u2[p]) + w[3][2 * p + 1] * bfhi(u3[p]);
            o[2 * p] = silu_fast(a0) * rowsc; o[2 * p + 1] = silu_fast(a1) * rowsc; }
        wv.x = cvtpk(o[0], o[1]); wv.y = cvtpk(o[2], o[3]); wv.z = cvtpk(o[4], o[5]); wv.w = cvtpk(o[6], o[7]);
    }
    *(LAS v4u*)(comb + l * CST + 8 * q) = wv;
#pragma unroll
    for (int i = 0; i < 4; ++i) { const int it = tid + 512 * i; *(LAS v4u*)(comb + (it >> 4) * CST + 32 + 8 * (it & 15)) = R.v[i]; }
}
__device__ __forceinline__ void ma_fast(LAS unsigned char* lds, const bf16* z, const float2* rope, const float* gates, const float* conv_w, const float* conv_b,
                                        bf16* states, float* nprev, float* mprev, int tid, int lane, int wave, int vcu, int G) {
    LAS float* gtab = (LAS float*)(lds + MA_TAB);
    LAS float* blt = gtab + 4096;
    LAS float* gmt = blt + 32;
    LAS float* wct = gmt + 32;
    LAS float* mnt = wct + 32;
    const int fr = lane & 15, hq = lane >> 4;
    for (int u = vcu; u < 256; u += G) {
        const int g = u >> 7, b = (u >> 4) & 7, h = (u >> 2) & 3, dq = u & 3;
        const bf16* zk = ZS(z, (g == 0 ? 4 : 20) + h, b * SEQ) + (g == 0 ? 16 * dq : 32 * dq);
        const bf16* zv = ZS(z, (g == 0 ? 8 : 24) + h, b * SEQ);
        MaRegs R0, R1;
        ma_load(R0, g, zk, zv, 0, tid); ma_load(R1, g, zk, zv, 1, tid);
        const unsigned long long tq5_ = (TPROBE == 5) ? TPX_NOW() : 0ull;
        float w[4][8], bias[8];
        { const int ch = tid & 3; const float* cw = conv_w + 512 + 128 * h + 32 * dq + 8 * ch; const float* cb = conv_b + 512 + 128 * h + 32 * dq + 8 * ch;
#pragma unroll
          for (int j = 0; j < 4; ++j)
#pragma unroll
              for (int e = 0; e < 8; ++e) w[j][e] = (g == 1) ? cw[j * 1024 + e] : 0.f;
#pragma unroll
          for (int e = 0; e < 8; ++e) bias[e] = (g == 1) ? cb[e] : 0.f; }
        __syncthreads();
        if (g == 0) { if (tid < 128) gtab[tid] = exp2f((float)(127 - tid) * lg2gamma(h)); }
        else {
            float gi[4][2], gf[4][2];
#pragma unroll
            for (int k = 0; k < 4; ++k) { const float* gp = gates + (size_t)(b * SEQ + (wave * 4 + k) * CHUNK + 2 * lane) * 8; gi[k][0] = gp[h]; gi[k][1] = gp[8 + h]; gf[k][0] = gp[4 + h]; gf[k][1] = gp[12 + h]; }
#pragma unroll
            for (int k = 0; k < 4; ++k) { const int cc = wave * 4 + k;
                const float ic0 = gi[k][0], ic1 = gi[k][1], lf0 = logsigmoid_acc(gf[k][0]), lf1 = logsigmoid_acc(gf[k][1]);
                const float s1 = lf0 + lf1; float v = s1;
#pragma unroll
                for (int off = 1; off < 64; off <<= 1) { const float t = __shfl_up(v, off); if (lane >= off) v += t; }
                const float ex = v - s1, bc0 = ex + lf0, bc1 = ex + s1;
                const float blast = __shfl(bc1, 63);
                const float g0 = blast - bc0 + ic0, g1 = blast - bc1 + ic1;
                gtab[cc * 128 + 2 * lane] = g0; gtab[cc * 128 + 2 * lane + 1] = g1;
                const float gmax = wave_max(fmaxf(g0, g1));
                if (lane == 0) { blt[cc] = blast; gmt[cc] = gmax; }
            }
            __syncthreads();
            if (tid == 0) { float m = 0.f;
                for (int cc = 0; cc < NCH; ++cc) { const float mn = fmaxf(blt[cc] + m, gmt[cc]); wct[cc] = expf(blt[cc] + m - mn); mnt[cc] = mn;
                    if (dq == 0) mprev[((size_t)b * NH + h) * NCH + cc] = m;
                    m = mn; } }
        }
        __syncthreads();
        if (TPROBE == 5) TPX_SPIN(tq5_, 3);
        const float wc_ret = exp2f(128.0f * lg2gamma(h));
        const int td = wave & 1, tp = wave >> 1;
        f32x4 acc0 = {0.f, 0.f, 0.f, 0.f}, acc1 = acc0, nacc = acc0;
        const int dglob = (g == 0) ? (td ? 64 + 16 * dq : 16 * dq) + 4 * hq : 32 * dq + 16 * td + 4 * hq;
        const unsigned tr_base = (unsigned)(4 * hq + (fr >> 2)) * (CST * 2) + (unsigned)(4 * (fr & 3)) * 2;
        bf16x8 ones; { const short o = (fr == 0) ? (short)0x3F80 : (short)0; ones = (bf16x8){o, o, o, o, o, o, o, o}; }
        const int lrow = tid >> 2;
#define MA_STEP(S_) do { \
                const s16x4 a_lo = tr_read<((32 * (S_)) * CST + 16 * 0) * 2>(cb_ + td * 32), a_hi = tr_read<((32 * (S_) + 16) * CST) * 2>(cb_ + td * 32); \
                const s16x4 b0_lo = tr_read<((32 * (S_)) * CST + 32) * 2>(cb_ + tp * 64), b0_hi = tr_read<((32 * (S_) + 16) * CST + 32) * 2>(cb_ + tp * 64); \
                const s16x4 b1_lo = tr_read<((32 * (S_)) * CST + 48) * 2>(cb_ + tp * 64), b1_hi = tr_read<((32 * (S_) + 16) * CST + 48) * 2>(cb_ + tp * 64); \
                TR_WAIT(); \
                const bf16x8 A = PK8(a_lo, a_hi); \
                acc0 = __builtin_amdgcn_mfma_f32_16x16x32_bf16(A, PK8(b0_lo, b0_hi), acc0, 0, 0, 0); \
                acc1 = __builtin_amdgcn_mfma_f32_16x16x32_bf16(A, PK8(b1_lo, b1_hi), acc1, 0, 0, 0); \
                if (g == 1 && tp == 0) nacc = __builtin_amdgcn_mfma_f32_16x16x32_bf16(A, ones, nacc, 0, 0, 0); } while (0)
#define MA_CHUNK(C_, R_) do { const int c = (C_); \
            const unsigned long long tq0_ = (TPROBE == 6) ? TPX_NOW() : 0ull; \
            const unsigned long long tq8_ = (TPROBE == 8) ? TPX_NOW() : 0ull; \
            LAS bf16* comb = (LAS bf16*)(lds + (c & 1) * (128 * CST * 2)); \
            const float rowsc = (g == 0) ? gtab[lrow] : __expf(gtab[c * 128 + lrow] - mnt[c]); \
            ma_write(R_, g, comb, rowsc, w, bias, tid); \
            if (TPROBE == 8) { asm volatile("s_waitcnt lgkmcnt(0)" ::: "memory"); TPX_SPIN(tq8_, 3); } \
            const unsigned long long tq9_ = (TPROBE == 9) ? TPX_NOW() : 0ull; \
            if (c + 2 < NCH) ma_load(R_, g, zk, zv, c + 2, tid); \
            { bf16* st = states + ((((size_t)g * BATCH + b) * NH + h) * NCH + c) * 16384 + dglob; \
              uint2 o0, o1; o0.x = cvtpk(acc0[0], acc0[1]); o0.y = cvtpk(acc0[2], acc0[3]); o1.x = cvtpk(acc1[0], acc1[1]); o1.y = cvtpk(acc1[2], acc1[3]); \
              *(uint2*)(st + (size_t)(32 * tp + fr) * 128) = o0; *(uint2*)(st + (size_t)(32 * tp + 16 + fr) * 128) = o1; \
              if (g == 1 && tp == 0 && fr == 0) *(f32x4*)(nprev + (((size_t)b * NH + h) * NCH + c) * 128 + dglob) = nacc; } \
            if (TPROBE == 9) TPX_SPIN(tq9_, 3); \
            __syncthreads(); \
            if (TPROBE == 6) TPX_SPIN(tq0_, 3); \
            const unsigned long long tq1_ = (TPROBE == 7) ? TPX_NOW() : 0ull; \
            const float wc = (g == 0) ? wc_ret : wct[c]; \
            acc0 *= wc; acc1 *= wc; nacc *= wc; \
            const unsigned cb_ = (unsigned)(size_t)comb + tr_base; \
            MA_STEP(0); MA_STEP(1); MA_STEP(2); MA_STEP(3); \
            if (TPROBE == 7) TPX_SPIN(tq1_, 3); } while (0)
        for (int c2 = 0; c2 < NCH; c2 += 2) { MA_CHUNK(c2, R0); MA_CHUNK(c2 + 1, R1); }
#undef MA_CHUNK
#undef MA_STEP
    }
}

constexpr int LST = 144;
constexpr int MX_Q = 0, MX_K = 128 * LST * 2, MX_V = 2 * MX_K, MX_S = 3 * MX_K, MX_TAB = 4 * MX_K;
__device__ __forceinline__ void mb_fast(LAS unsigned char* lds, const bf16* z, const float2* rope, const float* gates, const float* conv_w, const float* conv_b,
                                        const bf16* states, const float* nprev, const float* mprev, const float* g_ret, const float* g_ml, bf16* y,
                                        int tid, int lane, int wave, int vcu, int G) {
    LAS bf16* qs = (LAS bf16*)(lds + MX_Q); LAS bf16* ks = (LAS bf16*)(lds + MX_K); LAS bf16* vs = (LAS bf16*)(lds + MX_V); LAS bf16* ss = (LAS bf16*)(lds + MX_S);
    LAS float* bcs = (LAS float*)(lds + MX_TAB);
    LAS float* ams = bcs + 128;
    LAS float* mts = ams + 128;
    LAS float* nps = mts + 128;
    const int fr = lane & 15, hq = lane >> 4, l0 = 16 * wave;
    for (int u = vcu; u < 2 * BATCH * NH * NCH; u += G) {
        const int g = u >> 10, b = (u >> 7) & 7, h = (u >> 5) & 3, c = u & 31;
        const int row0 = b * SEQ + c * CHUNK;
        __syncthreads();
#ifndef MB_STAGE_REP
#define MB_STAGE_REP 1
#endif
#ifndef MB_COMP_REP
#define MB_COMP_REP 1
#endif
        for (int srep_ = 0; srep_ < MB_STAGE_REP; ++srep_) { if (srep_) __syncthreads();
        if (g == 0) {
            stage_copy<16>(qs, LST, ZS(z, h, row0), ZLD, tid);
            stage_copy<16>(ks, LST, ZS(z, 4 + h, row0), ZLD, tid);
        } else {
            stage_conv<16>(qs, LST, ZS(z, 16 + h, row0), c * CHUNK, conv_w + 128 * h, conv_b + 128 * h, QK_SCALE, nullptr, tid);
            stage_conv<16>(ks, LST, ZS(z, 20 + h, row0), c * CHUNK, conv_w + 512 + 128 * h, conv_b + 512 + 128 * h, 1.0f, nullptr, tid);
            if (wave == 0) {
                float bc0, bc1, ic0, ic1; ml_gate_scan(gates, row0, h, lane, bc0, bc1, ic0, ic1);
                const float a0 = ic0 - bc0, a1 = ic1 - bc1; const float c1 = fmaxf(a0, a1); float v = c1;
#pragma unroll
                for (int off = 1; off < 64; off <<= 1) { const float t = __shfl_up(v, off); if (lane >= off) v = fmaxf(v, t); }
                float ex = __shfl_up(v, 1); if (lane == 0) ex = -INFINITY;
                const float mp = mprev[((size_t)b * NH + h) * NCH + c];
                const float mt0 = bc0 + fmaxf(fmaxf(ex, a0), mp), mt1 = bc1 + fmaxf(fmaxf(ex, c1), mp);
                bcs[2 * lane] = bc0; bcs[2 * lane + 1] = bc1; ams[2 * lane] = a0; ams[2 * lane + 1] = a1; mts[2 * lane] = mt0; mts[2 * lane + 1] = mt1;
            }
            if (tid >= 64 && tid < 192) nps[tid - 64] = nprev[(((size_t)b * NH + h) * NCH + c) * 128 + (tid - 64)];
        }
        stage_copy<16>(vs, LST, ZS(z, (g == 0 ? 8 : 24) + h, row0), ZLD, tid);
        stage_copy<16>(ss, LST, states + ((((size_t)g * BATCH + b) * NH + h) * NCH + c) * 16384, 128, tid);
        }
        __syncthreads();
        for (int crep_ = 0; crep_ < MB_COMP_REP; ++crep_) {
        const int l = l0 + fr;
        float rowf, mt = 0.f, bl_mt = 0.f;
        if (g == 0) rowf = exp2f((float)(l + 1) * lg2gamma(h));
        else { const float mp = mprev[((size_t)b * NH + h) * NCH + c]; const float bl = bcs[l]; mt = mts[l]; rowf = __expf(bl + mp - mt); bl_mt = bl - mt; }
        bf16x8 qf[4];
#pragma unroll
        for (int s = 0; s < 4; ++s) qf[s] = *(const LAS bf16x8*)(qs + l * LST + 32 * s + 8 * hq);
        f32x4 acc[8];
#pragma unroll
        for (int te = 0; te < 8; ++te) { acc[te] = (f32x4){0.f, 0.f, 0.f, 0.f};
#pragma unroll
            for (int s = 0; s < 4; ++s) { const bf16x8 a = *(const LAS bf16x8*)(ss + (16 * te + fr) * LST + 32 * s + 8 * hq); acc[te] = __builtin_amdgcn_mfma_f32_16x16x32_bf16(a, qf[s], acc[te], 0, 0, 0); }
            acc[te] *= rowf; }
        float qn = 0.f;
        if (g == 1) {
#pragma unroll
            for (int s = 0; s < 4; ++s) { const f32x4 n0 = *(const LAS f32x4*)(nps + 32 * s + 8 * hq), n1 = *(const LAS f32x4*)(nps + 32 * s + 8 * hq + 4);
                qn += bf2f((unsigned short)qf[s][0]) * n0.x + bf2f((unsigned short)qf[s][1]) * n0.y + bf2f((unsigned short)qf[s][2]) * n0.z + bf2f((unsigned short)qf[s][3]) * n0.w
                    + bf2f((unsigned short)qf[s][4]) * n1.x + bf2f((unsigned short)qf[s][5]) * n1.y + bf2f((unsigned short)qf[s][6]) * n1.z + bf2f((unsigned short)qf[s][7]) * n1.w; }
            qn += __shfl_xor(qn, 16); qn += __shfl_xor(qn, 32);
        }
        unsigned pk[8][2];
        float psum = 0.f;
        const float lg = lg2gamma(h);
#pragma unroll
        for (int t = 0; t < 8; ++t) {
            if (t <= wave) {
                f32x4 p = {0.f, 0.f, 0.f, 0.f};
#pragma unroll
                for (int s = 0; s < 4; ++s) { const bf16x8 a = *(const LAS bf16x8*)(ks + (16 * t + fr) * LST + 32 * s + 8 * hq); p = __builtin_amdgcn_mfma_f32_16x16x32_bf16(a, qf[s], p, 0, 0, 0); }
                const int m0 = 16 * t + 4 * hq;
                f32x4 w;
                if (g == 0) {
#pragma unroll
                    for (int r = 0; r < 4; ++r) w[r] = exp2f((float)(l - m0 - r) * lg);
                } else { const f32x4 am = *(const LAS f32x4*)(ams + m0);
#pragma unroll
                    for (int r = 0; r < 4; ++r) w[r] = exp2f((bl_mt + am[r]) * LOG2E); }
#pragma unroll
                for (int r = 0; r < 4; ++r) { const float pv = (m0 + r <= l) ? p[r] * w[r] : 0.f; p[r] = pv; psum += pv; }
                pk[t][0] = cvtpk(p[0], p[1]); pk[t][1] = cvtpk(p[2], p[3]);
            } else { pk[t][0] = 0u; pk[t][1] = 0u; }
        }
        const unsigned vb = (unsigned)(size_t)vs + (unsigned)(4 * hq + (fr >> 2)) * (LST * 2) + (unsigned)(4 * (fr & 3)) * 2;
#define MB_PV(SP_) do { if (2 * (SP_) <= wave) { \
            const bf16x8 pf = __builtin_bit_cast(bf16x8, (v4u){pk[2 * (SP_)][0], pk[2 * (SP_)][1], pk[2 * (SP_) + 1][0], pk[2 * (SP_) + 1][1]}); \
            s16x4 lo[8], hi[8]; \
            lo[0] = tr_read<((32 * (SP_)) * LST + 0) * 2>(vb);  hi[0] = tr_read<((32 * (SP_) + 16) * LST + 0) * 2>(vb); \
            lo[1] = tr_read<((32 * (SP_)) * LST + 16) * 2>(vb); hi[1] = tr_read<((32 * (SP_) + 16) * LST + 16) * 2>(vb); \
            lo[2] = tr_read<((32 * (SP_)) * LST + 32) * 2>(vb); hi[2] = tr_read<((32 * (SP_) + 16) * LST + 32) * 2>(vb); \
            lo[3] = tr_read<((32 * (SP_)) * LST + 48) * 2>(vb); hi[3] = tr_read<((32 * (SP_) + 16) * LST + 48) * 2>(vb); \
            lo[4] = tr_read<((32 * (SP_)) * LST + 64) * 2>(vb); hi[4] = tr_read<((32 * (SP_) + 16) * LST + 64) * 2>(vb); \
            lo[5] = tr_read<((32 * (SP_)) * LST + 80) * 2>(vb); hi[5] = tr_read<((32 * (SP_) + 16) * LST + 80) * 2>(vb); \
            lo[6] = tr_read<((32 * (SP_)) * LST + 96) * 2>(vb); hi[6] = tr_read<((32 * (SP_) + 16) * LST + 96) * 2>(vb); \
            lo[7] = tr_read<((32 * (SP_)) * LST + 112) * 2>(vb); hi[7] = tr_read<((32 * (SP_) + 16) * LST + 112) * 2>(vb); \
            TR_WAIT(); \
            _Pragma("unroll") for (int te = 0; te < 8; ++te) acc[te] = __builtin_amdgcn_mfma_f32_16x16x32_bf16(PK8(lo[te], hi[te]), pf, acc[te], 0, 0, 0); } } while (0)
        MB_PV(0); MB_PV(1); MB_PV(2); MB_PV(3);
#undef MB_PV
        const int row = row0 + l;
        if (g == 1) {
            psum += __shfl_xor(psum, 16); psum += __shfl_xor(psum, 32);
            const float den = psum + rowf * qn; const float inv = 1.0f / fmaxf(fabsf(den), __expf(-mt));
            const bf16* zo = ZS(z, 28 + h, row) + 4 * hq;
#pragma unroll
            for (int te = 0; te < 8; ++te) { const uint2 gz = *(const uint2*)(zo + 16 * te);
                acc[te][0] *= inv * sigmoid_fast(bflo(gz.x)); acc[te][1] *= inv * sigmoid_fast(bfhi(gz.x)); acc[te][2] *= inv * sigmoid_fast(bflo(gz.y)); acc[te][3] *= inv * sigmoid_fast(bfhi(gz.y)); }
        }
        float s1 = 0.f;
#pragma unroll
        for (int te = 0; te < 8; ++te) s1 += (acc[te][0] + acc[te][1]) + (acc[te][2] + acc[te][3]);
        s1 += __shfl_xor(s1, 16); s1 += __shfl_xor(s1, 32);
        const float mu = s1 * (1.0f / 128.0f); float s2 = 0.f;
#pragma unroll
        for (int te = 0; te < 8; ++te) { const f32x4 dl = acc[te] - mu; s2 += (dl[0] * dl[0] + dl[1] * dl[1]) + (dl[2] * dl[2] + dl[3] * dl[3]); }
        s2 += __shfl_xor(s2, 16); s2 += __shfl_xor(s2, 32);
        const float rs = 1.0f / sqrtf(s2 * (1.0f / 128.0f) + EPS);
        const float* gn = (g == 0 ? g_ret : g_ml) + 128 * h + 4 * hq;
        const bf16* zg = ZS(z, 12 + h, row) + 4 * hq;
        bf16* yo = y + (size_t)row * D + g * 512 + 128 * h + 4 * hq;
#pragma unroll
        for (int te = 0; te < 8; ++te) { const f32x4 gv = *(const f32x4*)(gn + 16 * te); f32x4 o = (acc[te] - mu) * rs * gv;
            if (g == 0) { const uint2 gz = *(const uint2*)(zg + 16 * te); o[0] *= silu_fast(bflo(gz.x)); o[1] *= silu_fast(bfhi(gz.x)); o[2] *= silu_fast(bflo(gz.y)); o[3] *= silu_fast(bfhi(gz.y)); }
            uint2 w; w.x = cvtpk(o[0], o[1]); w.y = cvtpk(o[2], o[3]); *(uint2*)(yo + 16 * te) = w; }
        }
    }
}


constexpr int MB_CW = MX_TAB + 2048 + 64;
constexpr int MB_GN = MB_CW + 5120;
struct MbRegs { v4u a[11]; v4u v[4]; v4u s[4]; float gsc[5]; float np; };
#define GLD16(base, voff, coff) (*(const v4u*)((const char*)(base) + (coff) + (size_t)(unsigned)(voff)))
template <int PART  , int g>
__device__ __forceinline__ void mb_load(MbRegs& R, int b, int h, int c, const bf16* z, const bf16* states, const float* gates, const float* nprev, const float* mprev, int tid) {
    const int row0 = b * SEQ + c * CHUNK;
    const unsigned off0 = (unsigned)((tid >> 4) * 256 + (tid & 15) * 16);
    if (PART == 0) {
        if (g == 0) { const bf16* zq = ZS(z, h, row0); const bf16* zk = ZS(z, 4 + h, row0);
#pragma unroll
            for (int i = 0; i < 4; ++i) { R.a[i] = GLD16(zq, off0, i * 8192); R.a[4 + i] = GLD16(zk, off0, i * 8192); }
        } else {
            const int mat = tid >> 8, tt = tid & 255, rg = tt >> 4, ch = tt & 15; const int s0 = c * CHUNK + 8 * rg - 3;
            const bf16* zb = ZS(z, 16 + h, row0 - 3);
            const unsigned off = (unsigned)mat * (4u * M * ZLD * 2u) + (unsigned)(rg * 2048 + ch * 16);
            const v4u zero = {0u, 0u, 0u, 0u};
#pragma unroll
            for (int j = 0; j < 11; ++j) R.a[j] = (s0 + j >= 0) ? GLD16(zb, off, j * 256) : zero;
        }
    } else {
        if (g == 1) {
            if (tid < 64) { const float* gp = gates + (size_t)(row0 + 2 * tid) * 8; R.gsc[0] = gp[h]; R.gsc[1] = gp[8 + h]; R.gsc[2] = gp[4 + h]; R.gsc[3] = gp[12 + h]; R.gsc[4] = mprev[((size_t)b * NH + h) * NCH + c]; }
            if (tid >= 64 && tid < 192) R.np = nprev[(((size_t)b * NH + h) * NCH + c) * 128 + (tid - 64)];
        }
        const bf16* zv = ZS(z, (g == 0 ? 8 : 24) + h, row0); const bf16* st = states + ((((size_t)g * BATCH + b) * NH + h) * NCH + c) * 16384;
#pragma unroll
        for (int i = 0; i < 4; ++i) { R.v[i] = GLD16(zv, off0, i * 8192); R.s[i] = GLD16(st, off0, i * 8192); }
    }
}
template <int g>
__device__ __forceinline__ void mb_write(const MbRegs& R, LAS unsigned char* lds, int tid, int lane) {
    LAS bf16* qs = (LAS bf16*)(lds + MX_Q); LAS bf16* ks = (LAS bf16*)(lds + MX_K); LAS bf16* vs = (LAS bf16*)(lds + MX_V); LAS bf16* ss = (LAS bf16*)(lds + MX_S);
    if (g == 0) {
#pragma unroll
        for (int i = 0; i < 4; ++i) { const int it = tid + 512 * i; *(LAS v4u*)(qs + (it >> 4) * LST + 8 * (it & 15)) = R.a[i]; *(LAS v4u*)(ks + (it >> 4) * LST + 8 * (it & 15)) = R.a[4 + i]; }
    } else {
        const int mat = tid >> 8, tt = tid & 255, rg = tt >> 4, ch = tt & 15;
        const LAS float* cw = (const LAS float*)(lds + MB_CW) + mat * 640 + 8 * ch;
        float w[5][8];
#pragma unroll
        for (int j = 0; j < 5; ++j) { const f32x4 x0 = *(const LAS f32x4*)(cw + 128 * j), x1 = *(const LAS f32x4*)(cw + 128 * j + 4);
            w[j][0] = x0.x; w[j][1] = x0.y; w[j][2] = x0.z; w[j][3] = x0.w; w[j][4] = x1.x; w[j][5] = x1.y; w[j][6] = x1.z; w[j][7] = x1.w; }
        const float sc = mat == 0 ? QK_SCALE : 1.0f;
        LAS bf16* dst = (mat == 0 ? qs : ks) + (8 * rg) * LST + 8 * ch;
#pragma unroll
        for (int r = 0; r < 8; ++r) {
            const unsigned u0[4] = {R.a[r].x, R.a[r].y, R.a[r].z, R.a[r].w}, u1[4] = {R.a[r + 1].x, R.a[r + 1].y, R.a[r + 1].z, R.a[r + 1].w}, u2[4] = {R.a[r + 2].x, R.a[r + 2].y, R.a[r + 2].z, R.a[r + 2].w}, u3[4] = {R.a[r + 3].x, R.a[r + 3].y, R.a[r + 3].z, R.a[r + 3].w};
            float o[8];
#pragma unroll
            for (int p = 0; p < 4; ++p) {
                const float a0 = w[4][2 * p] + w[0][2 * p] * bflo(u0[p]) + w[1][2 * p] * bflo(u1[p]) + w[2][2 * p] * bflo(u2[p]) + w[3][2 * p] * bflo(u3[p]);
                const float a1 = w[4][2 * p + 1] + w[0][2 * p + 1] * bfhi(u0[p]) + w[1][2 * p + 1] * bfhi(u1[p]) + w[2][2 * p + 1] * bfhi(u2[p]) + w[3][2 * p + 1] * bfhi(u3[p]);
                o[2 * p] = silu_fast(a0) * sc; o[2 * p + 1] = silu_fast(a1) * sc; }
            v4u wv; wv.x = cvtpk(o[0], o[1]); wv.y = cvtpk(o[2], o[3]); wv.z = cvtpk(o[4], o[5]); wv.w = cvtpk(o[6], o[7]);
            *(LAS v4u*)(dst + r * LST) = wv;
        }
        LAS float* bcs = (LAS float*)(lds + MX_TAB); LAS float* ams = bcs + 128; LAS float* mts = ams + 128; LAS float* nps = mts + 128;
        if (tid < 64) {
            const float ic0 = R.gsc[0], ic1 = R.gsc[1], lf0 = logsigmoid_acc(R.gsc[2]), lf1 = logsigmoid_acc(R.gsc[3]), mp = R.gsc[4];
            const float s1 = lf0 + lf1; float v = s1;
#pragma unroll
            for (int off = 1; off < 64; off <<= 1) { const float t = __shfl_up(v, off); if (lane >= off) v += t; }
            const float ex0 = v - s1, bc0 = ex0 + lf0, bc1 = ex0 + s1;
            const float a0 = ic0 - bc0, a1 = ic1 - bc1; const float c1 = fmaxf(a0, a1); float vm = c1;
#pragma unroll
            for (int off = 1; off < 64; off <<= 1) { const float t = __shfl_up(vm, off); if (lane >= off) vm = fmaxf(vm, t); }
            float ex = __shfl_up(vm, 1); if (lane == 0) ex = -INFINITY;
            const float mt0 = bc0 + fmaxf(fmaxf(ex, a0), mp), mt1 = bc1 + fmaxf(fmaxf(ex, c1), mp);
            bcs[2 * lane] = bc0; bcs[2 * lane + 1] = bc1; ams[2 * lane] = a0; ams[2 * lane + 1] = a1; mts[2 * lane] = mt0; mts[2 * lane + 1] = mt1;
            if (lane == 0) nps[128] = mp;
        }
        if (tid >= 64 && tid < 192) nps[tid - 64] = R.np;
    }
#pragma unroll
    for (int i = 0; i < 4; ++i) { const int it = tid + 512 * i; *(LAS v4u*)(vs + (it >> 4) * LST + 8 * (it & 15)) = R.v[i]; *(LAS v4u*)(ss + (it >> 4) * LST + 8 * (it & 15)) = R.s[i]; }
}
template <int g>
__device__ __forceinline__ void mb_group(LAS unsigned char* lds, const bf16* z, const float* gates, const bf16* states, const float* nprev, const float* mprev, bf16* y, int h, int c, int bb, int tid, int lane, int wave) {
    LAS bf16* qs = (LAS bf16*)(lds + MX_Q); LAS bf16* ks = (LAS bf16*)(lds + MX_K); LAS bf16* vs = (LAS bf16*)(lds + MX_V); LAS bf16* ss = (LAS bf16*)(lds + MX_S);
    LAS float* bcs = (LAS float*)(lds + MX_TAB); LAS float* ams = bcs + 128; LAS float* mts = ams + 128; LAS float* nps = mts + 128;
    const int l0 = 16 * wave;
    MbRegs R;
    mb_load<0, g>(R, bb, h, c, z, states, gates, nprev, mprev, tid); mb_load<1, g>(R, bb, h, c, z, states, gates, nprev, mprev, tid);
    for (int i = 0; i < 4; ++i) {
        const int b = bb + 2 * i;
        const int row0 = b * SEQ + c * CHUNK;
#if TPROBE == 1
        TP_BEGIN();
#endif
        __syncthreads();
        mb_write<g>(R, lds, tid, lane);
        if (i + 1 < 4) { mb_load<1, g>(R, bb + 2 * (i + 1), h, c, z, states, gates, nprev, mprev, tid); mb_load<0, g>(R, bb + 2 * (i + 1), h, c, z, states, gates, nprev, mprev, tid); }
        __syncthreads();
#if TPROBE == 1
        TP_SPIN(3);
#endif
#if TPROBE == 3
        { const unsigned long long e3_ = __builtin_amdgcn_s_memtime() + 10000ull + 3000ull * (unsigned long long)wave; while (__builtin_amdgcn_s_memtime() < e3_) __builtin_amdgcn_s_sleep(2); }
#endif
#if TPROBE == 2
        TP_BEGIN();
#endif
        int lane_l = lane; asm volatile("" : "+v"(lane_l)); const int fr = lane_l & 15, hq = lane_l >> 4;
        int l = l0 + fr; asm volatile("" : "+v"(l));
        const int row = row0 + l;
        float rowf, mt = 0.f, bl_mt = 0.f;
        if (g == 0) rowf = __builtin_amdgcn_exp2f((float)(l + 1) * lg2gamma(h));
        else { const float mp = nps[128]; const float bl = bcs[l]; mt = mts[l]; rowf = __expf(bl + mp - mt); bl_mt = bl - mt; }
        const unsigned lb = (unsigned)(fr * (LST * 2) + hq * 16);
        const unsigned qa = (unsigned)(size_t)qs + (unsigned)(l0 * (LST * 2)) + lb, sa = (unsigned)(size_t)ss + lb, ka = (unsigned)(size_t)ks + lb;
        bf16x8 qf[4];
        qf[0] = lds_rd16<0>(qa); qf[1] = lds_rd16<64>(qa); qf[2] = lds_rd16<128>(qa); qf[3] = lds_rd16<192>(qa);
        f32x4 acc[8];
#define MB_INTER(TP_) do { \
            const bf16x8 a0 = lds_rd16<(2 * (TP_)) * 16 * LST * 2 + 0>(sa), a1 = lds_rd16<(2 * (TP_)) * 16 * LST * 2 + 64>(sa), a2 = lds_rd16<(2 * (TP_)) * 16 * LST * 2 + 128>(sa), a3 = lds_rd16<(2 * (TP_)) * 16 * LST * 2 + 192>(sa); \
            const bf16x8 b0 = lds_rd16<(2 * (TP_) + 1) * 16 * LST * 2 + 0>(sa), b1 = lds_rd16<(2 * (TP_) + 1) * 16 * LST * 2 + 64>(sa), b2 = lds_rd16<(2 * (TP_) + 1) * 16 * LST * 2 + 128>(sa), b3 = lds_rd16<(2 * (TP_) + 1) * 16 * LST * 2 + 192>(sa); \
            TR_WAIT(); \
            f32x4 x = {0.f, 0.f, 0.f, 0.f}, y = x; \
            x = __builtin_amdgcn_mfma_f32_16x16x32_bf16(a0, qf[0], x, 0, 0, 0); y = __builtin_amdgcn_mfma_f32_16x16x32_bf16(b0, qf[0], y, 0, 0, 0); \
            x = __builtin_amdgcn_mfma_f32_16x16x32_bf16(a1, qf[1], x, 0, 0, 0); y = __builtin_amdgcn_mfma_f32_16x16x32_bf16(b1, qf[1], y, 0, 0, 0); \
            x = __builtin_amdgcn_mfma_f32_16x16x32_bf16(a2, qf[2], x, 0, 0, 0); y = __builtin_amdgcn_mfma_f32_16x16x32_bf16(b2, qf[2], y, 0, 0, 0); \
            x = __builtin_amdgcn_mfma_f32_16x16x32_bf16(a3, qf[3], x, 0, 0, 0); y = __builtin_amdgcn_mfma_f32_16x16x32_bf16(b3, qf[3], y, 0, 0, 0); \
            acc[2 * (TP_)] = x * rowf; acc[2 * (TP_) + 1] = y * rowf; } while (0)
        MB_INTER(0); MB_INTER(1); MB_INTER(2); MB_INTER(3);
#undef MB_INTER
        float qn = 0.f;
        if (g == 1) {
#pragma unroll
            for (int s = 0; s < 4; ++s) { const f32x4 n0 = *(const LAS f32x4*)(nps + 32 * s + 8 * hq), n1 = *(const LAS f32x4*)(nps + 32 * s + 8 * hq + 4);
                qn += bf2f((unsigned short)qf[s][0]) * n0.x + bf2f((unsigned short)qf[s][1]) * n0.y + bf2f((unsigned short)qf[s][2]) * n0.z + bf2f((unsigned short)qf[s][3]) * n0.w
                    + bf2f((unsigned short)qf[s][4]) * n1.x + bf2f((unsigned short)qf[s][5]) * n1.y + bf2f((unsigned short)qf[s][6]) * n1.z + bf2f((unsigned short)qf[s][7]) * n1.w; }
            qn += __shfl_xor(qn, 16); qn += __shfl_xor(qn, 32);
        }
        unsigned pk[8][2];
        float psum = 0.f;
        const float lg = lg2gamma(h);
#define MB_WGT(T_, P_) do { const int m0 = 16 * (T_) + 4 * hq; f32x4 w; \
            if (g == 0) { _Pragma("unroll") for (int r = 0; r < 4; ++r) w[r] = __builtin_amdgcn_exp2f((float)(l - m0 - r) * lg); } \
            else { const f32x4 am = *(const LAS f32x4*)(ams + m0); _Pragma("unroll") for (int r = 0; r < 4; ++r) w[r] = __builtin_amdgcn_exp2f((bl_mt + am[r]) * LOG2E); } \
            _Pragma("unroll") for (int r = 0; r < 4; ++r) { const float pv = (m0 + r <= l) ? P_[r] * w[r] : 0.f; P_[r] = pv; psum += pv; } \
            pk[T_][0] = cvtpk(P_[0], P_[1]); pk[T_][1] = cvtpk(P_[2], P_[3]); } while (0)
#define MB_ST(TP_) do { if (2 * (TP_) <= wave) { \
            const bf16x8 a0 = lds_rd16<(2 * (TP_)) * 16 * LST * 2 + 0>(ka), a1 = lds_rd16<(2 * (TP_)) * 16 * LST * 2 + 64>(ka), a2 = lds_rd16<(2 * (TP_)) * 16 * LST * 2 + 128>(ka), a3 = lds_rd16<(2 * (TP_)) * 16 * LST * 2 + 192>(ka); \
            const bf16x8 b0 = lds_rd16<(2 * (TP_) + 1) * 16 * LST * 2 + 0>(ka), b1 = lds_rd16<(2 * (TP_) + 1) * 16 * LST * 2 + 64>(ka), b2 = lds_rd16<(2 * (TP_) + 1) * 16 * LST * 2 + 128>(ka), b3 = lds_rd16<(2 * (TP_) + 1) * 16 * LST * 2 + 192>(ka); \
            TR_WAIT(); \
            f32x4 x = {0.f, 0.f, 0.f, 0.f}, y = x; \
            x = __builtin_amdgcn_mfma_f32_16x16x32_bf16(a0, qf[0], x, 0, 0, 0); y = __builtin_amdgcn_mfma_f32_16x16x32_bf16(b0, qf[0], y, 0, 0, 0); \
            x = __builtin_amdgcn_mfma_f32_16x16x32_bf16(a1, qf[1], x, 0, 0, 0); y = __builtin_amdgcn_mfma_f32_16x16x32_bf16(b1, qf[1], y, 0, 0, 0); \
            x = __builtin_amdgcn_mfma_f32_16x16x32_bf16(a2, qf[2], x, 0, 0, 0); y = __builtin_amdgcn_mfma_f32_16x16x32_bf16(b2, qf[2], y, 0, 0, 0); \
            x = __builtin_amdgcn_mfma_f32_16x16x32_bf16(a3, qf[3], x, 0, 0, 0); y = __builtin_amdgcn_mfma_f32_16x16x32_bf16(b3, qf[3], y, 0, 0, 0); \
            MB_WGT(2 * (TP_), x); \
            if (2 * (TP_) + 1 <= wave) MB_WGT(2 * (TP_) + 1, y); else { pk[2 * (TP_) + 1][0] = 0u; pk[2 * (TP_) + 1][1] = 0u; } \
        } else { pk[2 * (TP_)][0] = 0u; pk[2 * (TP_)][1] = 0u; pk[2 * (TP_) + 1][0] = 0u; pk[2 * (TP_) + 1][1] = 0u; } } while (0)
        MB_ST(0); MB_ST(1); MB_ST(2); MB_ST(3);
#undef MB_ST
#undef MB_WGT
        const unsigned vb = (unsigned)(size_t)vs + (unsigned)(4 * hq + (fr >> 2)) * (LST * 2) + (unsigned)(4 * (fr & 3)) * 2;
#define MB_PV(SP_) do { if (2 * (SP_) <= wave) { \
            const bf16x8 pf = __builtin_bit_cast(bf16x8, (v4u){pk[2 * (SP_)][0], pk[2 * (SP_)][1], pk[2 * (SP_) + 1][0], pk[2 * (SP_) + 1][1]}); \
            { s16x4 lo[4], hi[4]; \
            lo[0] = tr_read<((32 * (SP_)) * LST + 0) * 2>(vb);  hi[0] = tr_read<((32 * (SP_) + 16) * LST + 0) * 2>(vb); \
            lo[1] = tr_read<((32 * (SP_)) * LST + 16) * 2>(vb); hi[1] = tr_read<((32 * (SP_) + 16) * LST + 16) * 2>(vb); \
            lo[2] = tr_read<((32 * (SP_)) * LST + 32) * 2>(vb); hi[2] = tr_read<((32 * (SP_) + 16) * LST + 32) * 2>(vb); \
            lo[3] = tr_read<((32 * (SP_)) * LST + 48) * 2>(vb); hi[3] = tr_read<((32 * (SP_) + 16) * LST + 48) * 2>(vb); \
            TR_WAIT(); \
            _Pragma("unroll") for (int te = 0; te < 4; ++te) acc[te] = __builtin_amdgcn_mfma_f32_16x16x32_bf16(PK8(lo[te], hi[te]), pf, acc[te], 0, 0, 0); } \
            { s16x4 lo[4], hi[4]; \
            lo[0] = tr_read<((32 * (SP_)) * LST + 64) * 2>(vb); hi[0] = tr_read<((32 * (SP_) + 16) * LST + 64) * 2>(vb); \
            lo[1] = tr_read<((32 * (SP_)) * LST + 80) * 2>(vb); hi[1] = tr_read<((32 * (SP_) + 16) * LST + 80) * 2>(vb); \
            lo[2] = tr_read<((32 * (SP_)) * LST + 96) * 2>(vb); hi[2] = tr_read<((32 * (SP_) + 16) * LST + 96) * 2>(vb); \
            lo[3] = tr_read<((32 * (SP_)) * LST + 112) * 2>(vb); hi[3] = tr_read<((32 * (SP_) + 16) * LST + 112) * 2>(vb); \
            TR_WAIT(); \
            _Pragma("unroll") for (int te = 0; te < 4; ++te) acc[4 + te] = __builtin_amdgcn_mfma_f32_16x16x32_bf16(PK8(lo[te], hi[te]), pf, acc[4 + te], 0, 0, 0); } } } while (0)
        MB_PV(0); MB_PV(1); MB_PV(2); MB_PV(3);
#undef MB_PV
        uint2 gz[8];
        const unsigned wide_off = (hq & 1) ? 24u : 0u;
        { const bf16* zgp = ZS(z, (g == 0 ? 12 : 28) + h, row0); const unsigned go = (unsigned)(l * 256 + hq * 8) + wide_off;
#pragma unroll
          for (int tp = 0; tp < 4; ++tp) { const v4u L = *(const v4u*)((const char*)zgp + 64 * tp + (size_t)go);
              const auto r0 = __builtin_amdgcn_permlane16_swap(L.x, L.z, false, false); const auto r1 = __builtin_amdgcn_permlane16_swap(L.y, L.w, false, false);
              gz[2 * tp].x = r0[0]; gz[2 * tp + 1].x = r0[1]; gz[2 * tp].y = r1[0]; gz[2 * tp + 1].y = r1[1]; } }
        if (g == 1) {
            psum += __shfl_xor(psum, 16); psum += __shfl_xor(psum, 32);
            const float den = psum + rowf * qn; const float inv = __builtin_amdgcn_rcpf(fmaxf(fabsf(den), __expf(-mt)));
#pragma unroll
            for (int te = 0; te < 8; ++te) { acc[te][0] *= inv * sigmoid_fast(bflo(gz[te].x)); acc[te][1] *= inv * sigmoid_fast(bfhi(gz[te].x)); acc[te][2] *= inv * sigmoid_fast(bflo(gz[te].y)); acc[te][3] *= inv * sigmoid_fast(bfhi(gz[te].y)); }
        }
        float s1 = 0.f;
#pragma unroll
        for (int te = 0; te < 8; ++te) s1 += (acc[te][0] + acc[te][1]) + (acc[te][2] + acc[te][3]);
        s1 += __shfl_xor(s1, 16); s1 += __shfl_xor(s1, 32);
        const float mu = s1 * (1.0f / 128.0f); float s2 = 0.f;
#pragma unroll
        for (int te = 0; te < 8; ++te) { const f32x4 dl = acc[te] - mu; s2 += (dl[0] * dl[0] + dl[1] * dl[1]) + (dl[2] * dl[2] + dl[3] * dl[3]); }
        s2 += __shfl_xor(s2, 16); s2 += __shfl_xor(s2, 32);
        const float rs = __builtin_amdgcn_rsqf(s2 * (1.0f / 128.0f) + EPS);
        const LAS float* gn = (const LAS float*)(lds + MB_GN) + g * 128 + 4 * hq;
        bf16* yb = y + (size_t)row0 * D + g * 512 + 128 * h; const unsigned yoff = (unsigned)(l * 2048 + hq * 8) + wide_off;
#pragma unroll
        for (int tp = 0; tp < 4; ++tp) { uint2 wv[2];
#pragma unroll
            for (int k = 0; k < 2; ++k) { const int te = 2 * tp + k; const f32x4 gv = *(const LAS f32x4*)(gn + 16 * te); f32x4 o = (acc[te] - mu) * rs * gv;
                if (g == 0) { o[0] *= silu_fast(bflo(gz[te].x)); o[1] *= silu_fast(bfhi(gz[te].x)); o[2] *= silu_fast(bflo(gz[te].y)); o[3] *= silu_fast(bfhi(gz[te].y)); }
                wv[k].x = cvtpk(o[0], o[1]); wv[k].y = cvtpk(o[2], o[3]); }
            const auto r0 = __builtin_amdgcn_permlane16_swap(wv[0].x, wv[1].x, false, false); const auto r1 = __builtin_amdgcn_permlane16_swap(wv[0].y, wv[1].y, false, false);
            v4u W; W.x = r0[0]; W.y = r1[0]; W.z = r0[1]; W.w = r1[1];
            *(v4u*)((char*)yb + 64 * tp + (size_t)yoff) = W; }
#if TPROBE == 2
        TP_SPIN(3);
#endif
    }
}
__device__ __forceinline__ void mb_fast2(LAS unsigned char* lds, const bf16* z, const float2* rope, const float* gates, const float* conv_w, const float* conv_b,
                                         const bf16* states, const float* nprev, const float* mprev, const float* g_ret, const float* g_ml, bf16* y,
                                         int tid, int lane, int wave, int vcu, int G) {
    if (G != 256) return;
    const int h = (vcu >> 5) & 3, c = vcu & 31, bb = (vcu >> 7) & 1;
    __syncthreads();
    { LAS float* cwl = (LAS float*)(lds + MB_CW); LAS float* gnl = (LAS float*)(lds + MB_GN);
      for (int i = tid; i < 2 * 5 * 128; i += NWAVES * 64) { const int mat = i / 640, j = (i % 640) >> 7, ch = i & 127; cwl[i] = j < 4 ? conv_w[j * 1024 + mat * 512 + 128 * h + ch] : conv_b[mat * 512 + 128 * h + ch]; }
      if (tid < 256) gnl[tid] = (tid < 128 ? g_ret : g_ml)[128 * h + (tid & 127)]; }
    mb_group<0>(lds, z, gates, states, nprev, mprev, y, h, c, bb, tid, lane, wave);
    mb_group<1>(lds, z, gates, states, nprev, mprev, y, h, c, bb, tid, lane, wave);
}

#ifndef GEMM_SP2
#define GEMM_SP2 true
#endif
#ifndef GEMM_ALIGN
#define GEMM_ALIGN true
#endif
__global__ void __launch_bounds__(NWAVES * 64, 2) mk_fwd(Args args) {
    extern __shared__ __attribute__((aligned(16))) unsigned char lds_raw[];
    LAS unsigned char* lds = (LAS unsigned char*)lds_raw;
    volatile LAS unsigned* MISC = (volatile LAS unsigned*)(lds + MISC_OFF);
    const int G = gridDim.x; const int bx = blockIdx.x; const int vcu = (G % 8 == 0) ? (bx % 8) * (G / 8) + bx / 8 : bx;
    const int wave_s = __builtin_amdgcn_readfirstlane((int)(threadIdx.x >> 6));
    if (threadIdx.x < 32) MISC[threadIdx.x] = 0u;
    __syncthreads();
    XcdBarrier bar;
    { const auto* A = ARGS(); bar = xcd_barrier_post((unsigned*)(A->ws + WS_CTL) + CW_BAR + A->li * XCD_BAR_WORDS, MISC + 8); }
    const int lo = args.ph_lo, hi = args.ph_hi;
#define IN(k) (lo <= (k) && (k) < hi)
#ifndef SEAM_REP
#define SEAM_REP 1
#endif
#define SEAM(k) do { if (IN(k) && IN((k) + 1)) { for (int sr_ = 0; sr_ < SEAM_REP; ++sr_) xcd_barrier(bar); } } while (0)
#ifndef DUP_MASK
#define DUP_MASK 0
#endif
#define REP(k) for (int rep_ = 0; rep_ < (((DUP_MASK) >> (k)) & 1) + 1; ++rep_, __syncthreads())
#ifndef PHASE_PROBE
#define PHASE_PROBE 0
#endif
#ifndef PHASE_K
#define PHASE_K 1
#endif
#define PB(k) const unsigned long long pb0_ = (PHASE_PROBE == (k)) ? __builtin_amdgcn_s_memrealtime() : 0ull
#define PE(k) do { if (PHASE_PROBE == (k)) { const unsigned long long d_ = __builtin_amdgcn_s_memrealtime() - pb0_; const unsigned long long e_ = __builtin_amdgcn_s_memrealtime() + (unsigned long long)(PHASE_K) * d_; while (__builtin_amdgcn_s_memrealtime() < e_) __builtin_amdgcn_s_sleep(4); } } while (0)
#define TIDS() int tid = wave_s * 64 + lane_id(); asm volatile("" : "+v"(tid)); const int lane = tid & 63, wave = wave_s, gw = vcu * NWAVES + wave, NGW = G * NWAVES; (void)gw; (void)NGW; (void)lane; int vcu_p = vcu; asm volatile("" : "+s"(vcu_p))

    if (IN(0)) { TIDS(); const auto* A = ARGS(); const void* inp[18];
#pragma unroll
        for (int i = 0; i < 18; ++i) inp[i] = A->in[i];
        PB(1); REP(0) prologue_a(lds, inp, A->ws, tid, lane, wave, vcu, G); PE(1); SEAM(0); }
    if (IN(1)) { TIDS(); const auto* A = ARGS(); const void* inp[18];
#pragma unroll
        for (int i = 0; i < 18; ++i) inp[i] = A->in[i];
        PB(2); REP(1) prologue_b(lds, inp, A->ws, (unsigned char*)A->out, tid, lane, wave, vcu, G); PE(2); SEAM(1); }

    for (int j = 0; j < 2 * DEPTH; ++j) {
        const int l = j >> 1, f = j & 1;
        const int pb = 2 + 8 * l + (f ? 6 : 0);
        const int s = f ? 2 : 0;
        if (IN(pb)) { const auto* A = ARGS(); unsigned char* ws = A->ws;
            pg8::Gemm g{f ? (const bf16*)(ws + WS_H2) : (const bf16*)((unsigned char*)A->out + OUT_H), (const bf16*)(ws + WS_W + (size_t)l * LW_BYTES + LW_W13 + (size_t)f * W13_BYTES), M, 2 * DFF, D}; pg8::StaticOrder S; S.init(M, 2 * DFF, G, bx);
            pg8::EpiSwigluN E{l, f};
            PB(3); REP(4) pg8::gemm_phase<pg8::EpiSwigluN, pg8::StaticOrder, GEMM_ALIGN, GEMM_SP2>(lds, g, S, E, wave_s); PE(3);
            SEAM(pb);
        }
        if (IN(pb + 1)) { const auto* A = ARGS(); unsigned char* ws = A->ws;
            pg8::Gemm g{(const bf16*)(ws + WS_Z), (const bf16*)(ws + WS_W + (size_t)l * LW_BYTES + LW_W2 + (size_t)f * W2_BYTES), M, D, DFF}; pg8::StaticOrder S; S.init(M, D, G, bx);
            PB(4);
            if (j == 2 * DEPTH - 1) { pg8::EpiFinalN E{l}; pg8::gemm_phase<pg8::EpiFinalN, pg8::StaticOrder, GEMM_ALIGN, GEMM_SP2>(lds, g, S, E, wave_s); }
            else { pg8::EpiResidN E{l, f ? 2 : 0, j == 0 ? 1 : 0}; pg8::gemm_phase<pg8::EpiResidN, pg8::StaticOrder, GEMM_ALIGN, GEMM_SP2>(lds, g, S, E, wave_s); }
            PE(4);
            SEAM(pb + 1);
        }
        if (f == 0) {
            const int mb = 2 + 8 * l + 2;
            if (IN(mb)) { const auto* A = ARGS(); unsigned char* ws = A->ws;
                PB(5); pg8::Gemm g{(const bf16*)((unsigned char*)A->out + OUT_H), (const bf16*)(ws + WS_W + (size_t)l * LW_BYTES + LW_WIN), M, DZ, D}; pg8::StaticOrder S; S.init(M, DZ, G, bx);
                { TIDS(); gates_job((const bf16*)((unsigned char*)A->out + OUT_H), (const unsigned long long*)(ws + WS_RS) + (size_t)(l * 3 + 1) * M, (const float*)A->in[9] + (size_t)l * D * DIN, (const float*)(ws + WS_SWIN) + (size_t)l * BATCH * DIN,
                                     (const float*)A->in[12] + l * NH, (const float*)A->in[13] + l * NH, (float*)(ws + WS_GPART), lane, wave, vcu, G); }
                pg8::EpiZN E{l};
                REP(5) pg8::gemm_phase<pg8::EpiZN, pg8::StaticOrder, GEMM_ALIGN, GEMM_SP2>(lds, g, S, E, wave_s); PE(5);
                SEAM(mb);
            }
            if (IN(mb + 1)) { TIDS(); const auto* A = ARGS(); unsigned char* ws = A->ws;
                PB(6); REP(2) ma_fast(lds, (const bf16*)(ws + WS_Z), (const float2*)(ws + WS_ROPE), (const float*)(ws + WS_GPART),
                          (const float*)A->in[10] + (size_t)l * 4 * D, (const float*)A->in[11] + (size_t)l * D,
                          (bf16*)((unsigned char*)A->out + OUT_ST), (float*)(ws + WS_NPREV), (float*)(ws + WS_MPREV), tid, lane, wave, vcu_p, G); PE(6);
                SEAM(mb + 1); }
            if (IN(mb + 2)) { TIDS(); const auto* A = ARGS(); unsigned char* ws = A->ws;
                PB(7); REP(3) MB_FN(lds, (const bf16*)(ws + WS_Z), (const float2*)(ws + WS_ROPE), (const float*)(ws + WS_GPART),
                          (const float*)A->in[10] + (size_t)l * 4 * D, (const float*)A->in[11] + (size_t)l * D,
                          (const bf16*)((unsigned char*)A->out + OUT_ST), (const float*)(ws + WS_NPREV), (const float*)(ws + WS_MPREV), (const float*)A->in[14] + (size_t)l * 512, (const float*)A->in[15] + (size_t)l * 512, (bf16*)((unsigned char*)A->out + OUT_H),
                          tid, lane, wave, vcu_p, G); PE(7);
                SEAM(mb + 2); }
            if (IN(mb + 3)) { const auto* A = ARGS(); unsigned char* ws = A->ws;
                pg8::Gemm g{(const bf16*)((unsigned char*)A->out + OUT_H), (const bf16*)(ws + WS_W + (size_t)l * LW_BYTES + LW_WOUT), M, D, D}; pg8::StaticOrder S; S.init(M, D, G, bx);
                pg8::EpiResidN E{l, 1, 0};
                PB(8); pg8::gemm_phase<pg8::EpiResidN, pg8::StaticOrder, GEMM_ALIGN, GEMM_SP2>(lds, g, S, E, wave_s); PE(8);
                SEAM(mb + 3);
            }
        }
    }
#undef TIDS
#undef IN
#undef SEAM
}

extern "C" void kernel_launch(void* const* d_in, const int* in_sizes, int n_in, void* d_out, int out_size, void* d_ws, size_t ws_size, hipStream_t stream) {
    static int grid = 0;
    if (grid == 0) {
        if (n_in != 18 || in_sizes[0] != M * D || out_size != M * D || ws_size < WS_END) { fprintf(stderr, "kernel_launch: unexpected shapes (n_in %d, in0 %d, out %d, ws %zu)\n", n_in, n_in > 0 ? in_sizes[0] : -1, out_size, ws_size); grid = -1; return; }
        int dev = 0, cus = 0, per_cu = 0;
        if (hipGetDevice(&dev) != hipSuccess || hipDeviceGetAttribute(&cus, hipDeviceAttributeMultiprocessorCount, dev) != hipSuccess) { grid = -1; return; }
        if (hipFuncSetAttribute((const void*)mk_fwd, hipFuncAttributeMaxDynamicSharedMemorySize, LDS_BYTES) != hipSuccess) { fprintf(stderr, "kernel_launch: hipFuncSetAttribute failed\n"); grid = -1; return; }
        if (hipOccupancyMaxActiveBlocksPerMultiprocessor(&per_cu, (const void*)mk_fwd, NWAVES * 64, LDS_BYTES) != hipSuccess || per_cu < 1) { fprintf(stderr, "kernel_launch: occupancy query says %d\n", per_cu); }
        (void)hipGetLastError();
        grid = cus;
        { pg8::StaticOrder S; bool ok = true;
            for (int pm = 0; pm < M / 256 && ok; ++pm) { int seq = -1;
                for (int c = 0; c < grid && ok; ++c) { S.init(M, D, grid, c); pg8::Unit u; for (int i = 0; S.next(i, u); ++i) if (u.pm == pm) { if (seq < 0) seq = i; else if (seq != i) ok = false; } } }
            if (!ok) { fprintf(stderr, "kernel_launch: tile order unsuitable for the fused final norm (grid %d)\n", grid); grid = -1; return; } }
    }
    if (grid < 0) return;
    if (hipMemsetAsync((char*)d_ws + WS_CTL, 0, CTL_ZERO_BYTES, stream) != hipSuccess) return;
    Args a{};
    for (int i = 0; i < 18; ++i) a.in[i] = d_in[i];
    a.out = (float*)d_out; a.ws = (unsigned char*)d_ws; a.pad = 0;
#if MK_ONE_LAUNCH
    a.ph_lo = 0; a.ph_hi = NPHASE; a.li = 0;
    hipLaunchKernelGGL(mk_fwd, dim3(grid), dim3(NWAVES * 64), LDS_BYTES, stream, a);
#else
    for (int li = 0; li < NPHASE; ++li) { a.ph_lo = li; a.ph_hi = li + 1; a.li = li;
        hipLaunchKernelGGL(mk_fwd, dim3(grid), dim3(NWAVES * 64), LDS_BYTES, stream, a); }
#endif
}
```

```cpp
#define MK_ONE_LAUNCH 1
#define MA_FN ma_fast
#define MB_FN mb_fast2
#define DUP_MASK 0
#include <hip/hip_runtime.h>
#include <cstdio>
#include <cstdint>

constexpr int NWAVES = 8;
#ifndef MK_ONE_LAUNCH
#define MK_ONE_LAUNCH 1
#endif

constexpr int BATCH = 8, SEQ = 4096, D = 1024, DEPTH = 2, DFF = 2816, NH = 4, DH = 128, CHUNK = 128, NCH = SEQ / CHUNK, DIN = 4104, DZ = 4096;
constexpr int M = BATCH * SEQ;
constexpr float EPS = 1e-6f;
constexpr int NPHASE = 18;

constexpr size_t MiB = 1u << 20;
constexpr size_t WS_CTL = 0, CTL_ZERO_BYTES = 1 * MiB;
constexpr size_t WS_MOD = 1 * MiB;
constexpr size_t WS_GM = 1 * MiB + 640 * 1024;
constexpr size_t WS_RS = 2 * MiB;
constexpr size_t WS_NPREV = 3 * MiB + 512 * 1024;
constexpr size_t WS_MPREV = 5 * MiB;
constexpr size_t WS_GPART = 4 * MiB;
constexpr size_t WS_SW13 = 6 * MiB;
constexpr size_t WS_SWIN = 7 * MiB;
constexpr size_t WS_ROPE = 8 * MiB;
constexpr size_t WS_W = 24 * MiB;
constexpr size_t W13_BYTES = (size_t)2 * DFF * D * 2, W2_BYTES = (size_t)D * DFF * 2, WIN_BYTES = (size_t)DZ * D * 2, WOUT_BYTES = (size_t)D * D * 2;
constexpr size_t LW_W13 = 0, LW_W2 = 2 * W13_BYTES, LW_WIN = LW_W2 + 2 * W2_BYTES, LW_WOUT = LW_WIN + WIN_BYTES, LW_BYTES = LW_WOUT + WOUT_BYTES;
constexpr size_t WS_XB = 110 * MiB;
constexpr size_t OUT_H = 0, OUT_ST = 64 * MiB;
constexpr size_t WS_Z = 174 * MiB;
constexpr size_t WS_H2 = WS_Z + 192 * MiB;
constexpr size_t WS_END = 430 * MiB;
static_assert(WS_W + DEPTH * LW_BYTES <= WS_XB && WS_XB + (size_t)M * D * 2 <= WS_Z && OUT_ST + (size_t)2 * BATCH * NH * NCH * 16384 * 2 <= (size_t)M * D * 4 && WS_Z + (size_t)M * DZ * 2 <= WS_END, "d_ws map");
static_assert((size_t)M * DFF * 2 <= 192 * MiB && WS_H2 + (size_t)M * D * 2 <= WS_END, "u and H2 inside the z region, disjoint");
static_assert(WS_GM + (size_t)DEPTH * 3 * BATCH * D * 4 <= WS_RS && WS_RS + (size_t)DEPTH * 3 * M * 8 <= WS_NPREV && WS_NPREV + (size_t)BATCH * NH * NCH * 128 * 4 <= WS_GPART && WS_GPART + (size_t)M * 8 * 4 <= WS_MPREV && WS_MPREV + 4096 <= WS_SW13 && WS_GPART + (size_t)DEPTH * M * 8 * 4 <= WS_SW13 && WS_SW13 + (size_t)DEPTH * 2 * BATCH * 2 * DFF * 4 <= WS_SWIN && WS_SWIN + (size_t)DEPTH * BATCH * DIN * 4 <= WS_ROPE, "small tables");
constexpr int CW_BAR = 4096;

constexpr int RING_BYTES = 131072;
constexpr int SM_OFF = RING_BYTES;
constexpr int MISC_OFF = 163584;
constexpr int LDS_BYTES = 163840;
static_assert(MISC_OFF + 128 <= LDS_BYTES, "LDS map");

#define GAS __attribute__((address_space(1)))
#define LAS __attribute__((address_space(3)))
typedef unsigned short bf16;
typedef unsigned v4u __attribute__((ext_vector_type(4)));
typedef float f32x4 __attribute__((ext_vector_type(4)));
typedef GAS unsigned gu32;
constexpr float RS_SCALE = 1048576.0f, RS_INV = 1.0f / (1048576.0f * 1024.0f);
#define RLX_AGENT __ATOMIC_RELAXED, __HIP_MEMORY_SCOPE_AGENT
#define LDS_WAIT() asm volatile("s_waitcnt lgkmcnt(0)" ::: "memory")
#define VM_WAIT() asm volatile("s_waitcnt vmcnt(0)" ::: "memory")
__device__ __forceinline__ unsigned f2bf(float f) { unsigned u = __builtin_bit_cast(unsigned, f); return (u + 0x7fffu + ((u >> 16) & 1u)) >> 16; }
__device__ __forceinline__ unsigned pk2(float lo, float hi) { return f2bf(lo) | (f2bf(hi) << 16); }
__device__ __forceinline__ float bf2f(unsigned short v) { return __builtin_bit_cast(float, (unsigned)v << 16); }
__device__ __forceinline__ float bflo(unsigned w) { return __builtin_bit_cast(float, w << 16); }
__device__ __forceinline__ float bfhi(unsigned w) { return __builtin_bit_cast(float, w & 0xffff0000u); }
__device__ __forceinline__ int lane_id() { int l; asm volatile("v_mbcnt_lo_u32_b32 %0, -1, 0\n\tv_mbcnt_hi_u32_b32 %0, -1, %0" : "=v"(l)); return l; }
__device__ __forceinline__ float wave_sum(float v) {
#pragma unroll
    for (int o = 1; o < 64; o <<= 1) v += __shfl_xor(v, o);
    return v;
}
__device__ __forceinline__ float wave_max(float v) {
#pragma unroll
    for (int o = 1; o < 64; o <<= 1) v = fmaxf(v, __shfl_xor(v, o));
    return v;
}
__device__ __forceinline__ float silu_acc(float x) { return x / (1.0f + expf(-x)); }
__device__ __forceinline__ float sigmoid_acc(float x) { return 1.0f / (1.0f + expf(-x)); }
__device__ __forceinline__ float logsigmoid_acc(float x) { return fminf(x, 0.0f) - log1pf(expf(-fabsf(x))); }

struct Args { const void* in[18]; float* out; unsigned char* ws; int ph_lo, ph_hi, li, pad; };
#define ARGS() ({ unsigned long long _p = (unsigned long long)__builtin_amdgcn_kernarg_segment_ptr(); asm volatile("" : "+s"(_p)); (const __attribute__((address_space(4))) Args*)_p; })
#ifndef PG8_WGM
#define PG8_WGM 8
#endif
namespace pg8 {
#define PG8_LAS __attribute__((address_space(3)))
typedef unsigned short bf16_t;
typedef short bf16x8 __attribute__((ext_vector_type(8)));
typedef float f32x4 __attribute__((ext_vector_type(4)));
typedef unsigned u32x4 __attribute__((ext_vector_type(4)));
constexpr int BM = 256, BK = 64, HALF = 128, HTB = HALF * BK * 2  , STAGE_BYTES = 8 * HTB, NXCD = 8, WGM = PG8_WGM;

__host__ __device__ __forceinline__ int lds_byte(int r, int c) { const int st = (r >> 4) * 2 + (c >> 5), rr = r & 15, cc = c & 31, ob = rr * 64 + cc * 2; return st * 1024 + (ob ^ (((ob >> 9) & 1) << 5)); }
__host__ __device__ __forceinline__ void stage_rc(int b, int& R, int& C) { const int st = b / 1024, sb = b % 1024, swz = sb ^ (((sb >> 9) & 1) << 5); R = (st >> 1) * 16 + swz / 64; C = (st & 1) * 32 + (swz % 64) / 2; }
__host__ __device__ __forceinline__ int perm32(int rho) { const int n = rho >> 4, i = rho & 15; return 8 * (i >> 2) + 4 * n + (i & 3); }

struct Unit { int pm, pn; };
struct Gemm { const bf16_t* A; const bf16_t* Bt; int M, N, K; };

struct StaticOrder {
    int nM, nN, nwg, G, c;
    __host__ __device__ void init(int M, int N, int G_, int c_) { nM = M / BM; nN = N / BM; nwg = nM * nN; G = G_; c = c_; }
    __host__ __device__ bool next(int i, Unit& u) const {
        const long L = (long)i * G + c; if (L >= nwg) return false;
        int wgid = (int)L; { const int q = nwg / NXCD, r = nwg % NXCD, xcd = wgid % NXCD, off = wgid / NXCD; wgid = (xcd < r ? xcd * (q + 1) : r * (q + 1) + (xcd - r) * q) + off; }
        const int nig = WGM * nN, gid = wgid / nig, fm = gid * WGM, gsz = (nM - fm) < WGM ? (nM - fm) : WGM;
        u.pm = fm + ((wgid % nig) % gsz); u.pn = (wgid % nig) / gsz; return true;
    }
    __device__ __forceinline__ void a_ready(const Unit&) const {}
    __device__ __forceinline__ void done(const Unit&) const {}
};

constexpr float NEPS = 1e-6f;
#ifndef EPI_WT
#define EPI_WT 0
#endif
__device__ __forceinline__ void st16_wt(void* p, u32x4 v) {
#if EPI_WT
    asm volatile("global_store_dwordx4 %0, %1, off sc1" :: "v"(p), "v"(v) : "memory");
#else
    *(u32x4*)p = v;
#endif
}
__device__ __forceinline__ unsigned cvt_pk_bf16(float lo, float hi) { unsigned r; asm volatile("v_cvt_pk_bf16_f32 %0, %1, %2" : "=v"(r) : "v"(lo), "v"(hi)); return r; }
__device__ __forceinline__ float silu_f(float g) { return g * __builtin_amdgcn_rcpf(1.0f + __expf(-g)); }
__device__ __forceinline__ float rstd_of(unsigned long long ssfix) { return __builtin_amdgcn_rsqf((float)ssfix * RS_INV + NEPS); }

constexpr int EPI_SLOT = 131072, EPI_COL = 2048, EPI_POS = 3072;
__device__ __forceinline__ void dma_1k(const float* g, PG8_LAS unsigned char* dst, int lane) {
    __builtin_amdgcn_global_load_lds((const unsigned*)(g + 4 * lane), (PG8_LAS unsigned*)dst, 16, 0, 0); }
__device__ __forceinline__ void dma_rs(const unsigned long long* g, PG8_LAS unsigned char* dst, int lane) {
    __builtin_amdgcn_global_load_lds((const unsigned*)(g + 2 * lane), (PG8_LAS unsigned*)dst, 16, 0, 0);
    __builtin_amdgcn_global_load_lds((const unsigned*)(g + 128 + 2 * lane), (PG8_LAS unsigned*)(dst + 1024), 16, 0, 0); }

struct EpiSwigluN {
    static constexpr bool PERM = true, AFTER_DRAIN = false; static constexpr int PROBE_ID = 1;
    int l, f;
    __device__ __forceinline__ void prefetch(PG8_LAS unsigned char* lds, const Unit& u, int wid, int lane) const {
        if (wid < 2) { unsigned char* ws = ARGS()->ws;
            if (wid == 0) dma_rs((const unsigned long long*)(ws + WS_RS) + (size_t)(l * 3 + (f ? 2 : 0)) * M + u.pm * BM, lds + EPI_SLOT, lane);
            else dma_1k((const float*)(ws + WS_SW13) + (size_t)(l * 2 + f) * BATCH * 2 * DFF + (size_t)(u.pm >> 4) * 2 * DFF + u.pn * BM, lds + EPI_SLOT + EPI_COL, lane); }
    }
    __device__ __forceinline__ void operator()(const f32x4 (&acc)[2][2][4][2], const Unit& u, int wr, int wc, int fr, int fq, PG8_LAS unsigned char* lds) const {
        asm volatile("" : "+v"(fr), "+v"(fq));
        unsigned char* ws = ARGS()->ws;
        bf16_t* U = (bf16_t*)(ws + WS_Z); constexpr int ldc = DFF;
        const PG8_LAS unsigned long long* rs = (const PG8_LAS unsigned long long*)(lds + EPI_SLOT) + wr * 64 + fr; const PG8_LAS float* sp = (const PG8_LAS float*)(lds + EPI_SLOT + EPI_COL) + wc * 32 + 8 * fq;
        const int row0 = u.pm * BM + wr * 64 + fr, col0 = u.pn * HALF + wc * 32 + 8 * fq;
        const f32x4 sg0 = *(const PG8_LAS f32x4*)sp, sg1 = *(const PG8_LAS f32x4*)(sp + 4), su0 = *(const PG8_LAS f32x4*)(sp + HALF), su1 = *(const PG8_LAS f32x4*)(sp + HALF + 4);
#pragma unroll
        for (int ai = 0; ai < 2; ++ai)
#pragma unroll
            for (int m = 0; m < 4; ++m) { const int row = row0 + ai * HALF + m * 16; const float rstd = rstd_of(rs[ai * HALF + m * 16]);
                bf16_t* rowp = U + (size_t)row * ldc + col0;
                const f32x4 g0 = acc[ai][0][m][0] * rstd + sg0, g1 = acc[ai][0][m][1] * rstd + sg1, u0 = acc[ai][1][m][0] * rstd + su0, u1 = acc[ai][1][m][1] * rstd + su1;
                f32x4 v0, v1;
#pragma unroll
                for (int j = 0; j < 4; ++j) { v0[j] = silu_f(g0[j]) * u0[j]; v1[j] = silu_f(g1[j]) * u1[j]; }
                u32x4 w; w.x = cvt_pk_bf16(v0[0], v0[1]); w.y = cvt_pk_bf16(v0[2], v0[3]); w.z = cvt_pk_bf16(v1[0], v1[1]); w.w = cvt_pk_bf16(v1[2], v1[3]);
                st16_wt(rowp, w); }
    }
};
struct EpiZN {
    static constexpr bool PERM = true, AFTER_DRAIN = false; static constexpr int PROBE_ID = 2;
    int l;
    __device__ __forceinline__ void prefetch(PG8_LAS unsigned char* lds, const Unit& u, int wid, int lane) const {
        if (wid == 2 && u.pn < 4) dma_1k((const float*)ARGS()->in[2] + u.pm * BM, lds + EPI_SLOT + EPI_POS, lane);
        if (wid < 2) { unsigned char* ws = ARGS()->ws;
            if (wid == 0) dma_rs((const unsigned long long*)(ws + WS_RS) + (size_t)(l * 3 + 1) * M + u.pm * BM, lds + EPI_SLOT, lane);
            else { const float* sw = (const float*)(ws + WS_SWIN) + (size_t)l * BATCH * DIN + (size_t)(u.pm >> 4) * DIN;
                if (u.pn >= 4) dma_1k(sw + u.pn * BM, lds + EPI_SLOT + EPI_COL, lane);
                else { const int p = 4 * lane, bj = p >> 7, cc = p & 127; const int src = (u.pn >> 1) * 512 + 128 * (2 * (u.pn & 1) + (cc >> 6)) + 64 * bj + (cc & 63);
                    __builtin_amdgcn_global_load_lds((const unsigned*)(sw + src), (PG8_LAS unsigned*)(lds + EPI_SLOT + EPI_COL), 16, 0, 0); } } }
    }
    __device__ __forceinline__ void operator()(const f32x4 (&acc)[2][2][4][2], const Unit& u, int wr, int wc, int fr, int fq, PG8_LAS unsigned char* lds) const {
        asm volatile("" : "+v"(fr), "+v"(fq));
        unsigned char* ws = ARGS()->ws;
        bf16_t* O = (bf16_t*)(ws + WS_Z);
        const PG8_LAS unsigned long long* rs = (const PG8_LAS unsigned long long*)(lds + EPI_SLOT) + wr * 64 + fr; const PG8_LAS float* sp = (const PG8_LAS float*)(lds + EPI_SLOT + EPI_COL) + wc * 32 + 8 * fq;
        const int row0 = u.pm * BM + wr * 64 + fr;
        f32x4 sv[2][2];
#pragma unroll
        for (int bj = 0; bj < 2; ++bj)
#pragma unroll
            for (int n = 0; n < 2; ++n) sv[bj][n] = *(const PG8_LAS f32x4*)(sp + bj * HALF + 4 * n);
        if (u.pn >= 4) {
#pragma unroll
            for (int ai = 0; ai < 2; ++ai)
#pragma unroll
                for (int m = 0; m < 4; ++m) { const int row = row0 + ai * HALF + m * 16; const float rstd = rstd_of(rs[ai * HALF + m * 16]);
                    bf16_t* rowp = O + ((size_t)(2 * u.pn) * M + row) * 128 + wc * 32 + 8 * fq;
#pragma unroll
                    for (int bj = 0; bj < 2; ++bj) { const f32x4 v0 = acc[ai][bj][m][0] * rstd + sv[bj][0], v1 = acc[ai][bj][m][1] * rstd + sv[bj][1];
                        u32x4 w; w.x = cvt_pk_bf16(v0[0], v0[1]); w.y = cvt_pk_bf16(v0[2], v0[3]); w.z = cvt_pk_bf16(v1[0], v1[1]); w.w = cvt_pk_bf16(v1[2], v1[3]);
                        st16_wt(rowp + (size_t)bj * M * 128, w); } }
        } else {
            const int cc = wc * 32 + 8 * fq, i0 = cc & 63;
            const int slice = 4 * (u.pn >> 1) + 2 * (u.pn & 1) + (cc >> 6);
            const float sc = u.pn >= 2 ? 0.08838834764831845f : 1.0f;
            const float* invf = (const float*)(ws + WS_ROPE) + i0;
            const f32x4 f0 = *(const f32x4*)invf, f1 = *(const f32x4*)(invf + 4);
            const PG8_LAS int* posl = (const PG8_LAS int*)(lds + EPI_SLOT + EPI_POS) + wr * 64 + fr;
#pragma unroll
            for (int ai = 0; ai < 2; ++ai)
#pragma unroll
                for (int m = 0; m < 4; ++m) { const int row = row0 + ai * HALF + m * 16; const float rstd = rstd_of(rs[ai * HALF + m * 16]) * sc;
                    const float posf = (float)posl[ai * HALF + m * 16];
                    f32x4 c0, s0, c1, s1;
#pragma unroll
                    for (int j = 0; j < 4; ++j) {
                        const float a0_ = posf * f0[j], a1_ = posf * f1[j];
                        const float k0_ = __builtin_rintf(a0_ * 0.15915494f), k1_ = __builtin_rintf(a1_ * 0.15915494f);
                        const float r0_ = __builtin_fmaf(a0_, 6.4206383e-09f, __builtin_fmaf(a0_, 0.15915494f, -k0_)), r1_ = __builtin_fmaf(a1_, 6.4206383e-09f, __builtin_fmaf(a1_, 0.15915494f, -k1_));
                        c0[j] = __builtin_amdgcn_cosf(r0_); s0[j] = __builtin_amdgcn_sinf(r0_); c1[j] = __builtin_amdgcn_cosf(r1_); s1[j] = __builtin_amdgcn_sinf(r1_); }
                    const f32x4 a0 = acc[ai][0][m][0] * rstd + sv[0][0] * sc, a1 = acc[ai][0][m][1] * rstd + sv[0][1] * sc, b0 = acc[ai][1][m][0] * rstd + sv[1][0] * sc, b1 = acc[ai][1][m][1] * rstd + sv[1][1] * sc;
                    const f32x4 o10 = a0 * c0 - b0 * s0, o11 = a1 * c1 - b1 * s1, o20 = a0 * s0 + b0 * c0, o21 = a1 * s1 + b1 * c1;
                    bf16_t* rowp = O + ((size_t)slice * M + row) * 128 + i0;
                    u32x4 w; w.x = cvt_pk_bf16(o10[0], o10[1]); w.y = cvt_pk_bf16(o10[2], o10[3]); w.z = cvt_pk_bf16(o11[0], o11[1]); w.w = cvt_pk_bf16(o11[2], o11[3]);
                    st16_wt(rowp, w);
                    w.x = cvt_pk_bf16(o20[0], o20[1]); w.y = cvt_pk_bf16(o20[2], o20[3]); w.z = cvt_pk_bf16(o21[0], o21[1]); w.w = cvt_pk_bf16(o21[2], o21[3]);
                    st16_wt(rowp + 64, w); }
        }
    }
};
struct EpiResidN {
    static constexpr bool PERM = true, AFTER_DRAIN = false; static constexpr int PROBE_ID = 3;
    int l, kind, first;
    __device__ __forceinline__ void prefetch(PG8_LAS unsigned char* lds, const Unit& u, int wid, int lane) const {
        if (wid < 2) { unsigned char* ws = ARGS()->ws; const int nidx = kind == 2 ? (l + 1) * 3 : l * 3 + kind + 1;
            if (wid == 0) dma_1k((const float*)(ws + WS_MOD) + (size_t)(l * 3 + kind) * BATCH * 3 * D + 2 * D + (size_t)(u.pm >> 4) * 3 * D + u.pn * BM, lds + EPI_SLOT, lane);
            else if (!(kind == 2 && l + 1 >= DEPTH)) dma_1k((const float*)(ws + WS_GM) + (size_t)nidx * BATCH * D + (size_t)(u.pm >> 4) * D + u.pn * BM, lds + EPI_SLOT + EPI_COL, lane); }
    }
    static __device__ __forceinline__ void row_out(const f32x4& x0, const f32x4& x1, const f32x4& g0, const f32x4& g1, bf16_t* xp, bf16_t* hp, bool gmn, float& ss) {
        { u32x4 w; w.x = cvt_pk_bf16(x0[0], x0[1]); w.y = cvt_pk_bf16(x0[2], x0[3]); w.z = cvt_pk_bf16(x1[0], x1[1]); w.w = cvt_pk_bf16(x1[2], x1[3]); st16_wt(xp, w); }
        if (gmn) { const f32x4 y0 = x0 * g0, y1 = x1 * g1;
            u32x4 w; w.x = cvt_pk_bf16(y0[0], y0[1]); w.y = cvt_pk_bf16(y0[2], y0[3]); w.z = cvt_pk_bf16(y1[0], y1[1]); w.w = cvt_pk_bf16(y1[2], y1[3]); st16_wt(hp, w);
            ss += (x0[0] * x0[0] + x0[1] * x0[1]) + (x0[2] * x0[2] + x0[3] * x0[3]) + (x1[0] * x1[0] + x1[1] * x1[1]) + (x1[2] * x1[2] + x1[3] * x1[3]); }
    }
    static __device__ __forceinline__ void row_stat(float ss, unsigned long long* rp, bool gmn, int fq) {
        if (gmn) { ss += __shfl_xor(ss, 16); ss += __shfl_xor(ss, 32);
            if (fq == 0) __hip_atomic_fetch_add(rp, (unsigned long long)(ss * RS_SCALE), __ATOMIC_RELAXED, __HIP_MEMORY_SCOPE_AGENT); }
    }
    __device__ __forceinline__ void operator()(const f32x4 (&acc)[2][2][4][2], const Unit& u, int wr, int wc, int fr, int fq, PG8_LAS unsigned char* lds) const {
        asm volatile("" : "+v"(fr), "+v"(fq));
        const auto* A = ARGS(); unsigned char* ws = A->ws;
        bf16_t* xb = (bf16_t*)(ws + WS_XB); const float* xin = (const float*)A->in[0];
        const float coef = kind == 1 ? 1.0f : 0.5f;
        const int nidx = kind == 2 ? (l + 1) * 3 : l * 3 + kind + 1;
        const bool gmn = !(kind == 2 && l + 1 >= DEPTH);
        bf16_t* hn = kind == 1 ? (bf16_t*)(ws + WS_H2) : (bf16_t*)((unsigned char*)A->out + OUT_H); unsigned long long* rsn = (unsigned long long*)(ws + WS_RS) + (size_t)nidx * M;
        const int row0 = u.pm * BM + wr * 64 + fr, col0 = u.pn * BM + wc * 32 + 8 * fq;
        const PG8_LAS float* gp = (const PG8_LAS float*)(lds + EPI_SLOT) + wc * 32 + 8 * fq; const PG8_LAS float* gmp = gp + EPI_COL / 4;
        if (first) {
        f32x4 gv[2][2], gm[2][2];
#pragma unroll
        for (int bj = 0; bj < 2; ++bj)
#pragma unroll
            for (int n = 0; n < 2; ++n) { gv[bj][n] = *(const PG8_LAS f32x4*)(gp + bj * HALF + 4 * n) * coef;
                gm[bj][n] = gmn ? *(const PG8_LAS f32x4*)(gmp + bj * HALF + 4 * n) : (f32x4){0.f, 0.f, 0.f, 0.f}; }
#pragma unroll
            for (int ai = 0; ai < 2; ++ai)
#pragma unroll
                for (int m = 0; m < 4; ++m) { const int row = row0 + ai * HALF + m * 16; const size_t off = (size_t)row * 1024 + col0;
                    f32x4 xa[2][2];
#pragma unroll
                    for (int bj = 0; bj < 2; ++bj) { xa[bj][0] = *(const f32x4*)(xin + off + bj * HALF); xa[bj][1] = *(const f32x4*)(xin + off + bj * HALF + 4); }
                    float ss = 0.f;
#pragma unroll
                    for (int bj = 0; bj < 2; ++bj) { const f32x4 x0 = xa[bj][0] + gv[bj][0] * acc[ai][bj][m][0], x1 = xa[bj][1] + gv[bj][1] * acc[ai][bj][m][1];
                        row_out(x0, x1, gm[bj][0], gm[bj][1], xb + off + bj * HALF, hn + off + bj * HALF, gmn, ss); }
                    row_stat(ss, rsn + row, gmn, fq); }
        } else {
#pragma unroll
            for (int ai = 0; ai < 2; ++ai) {
                u32x4 xw[4][2];
#pragma unroll
                for (int m = 0; m < 4; ++m)
#pragma unroll
                    for (int bj = 0; bj < 2; ++bj) xw[m][bj] = *(const u32x4*)(xb + (size_t)(row0 + ai * HALF + m * 16) * 1024 + col0 + bj * HALF);
#pragma unroll
                for (int m = 0; m < 4; ++m) { const int row = row0 + ai * HALF + m * 16; const size_t off = (size_t)row * 1024 + col0;
                    float ss = 0.f;
#pragma unroll
                    for (int bj = 0; bj < 2; ++bj) { const u32x4 w = xw[m][bj];
                        const f32x4 gv0 = *(const PG8_LAS f32x4*)(gp + bj * HALF) * coef, gv1 = *(const PG8_LAS f32x4*)(gp + bj * HALF + 4) * coef;
                        const f32x4 x0 = (f32x4){__builtin_bit_cast(float, w.x << 16), __builtin_bit_cast(float, w.x & 0xffff0000u), __builtin_bit_cast(float, w.y << 16), __builtin_bit_cast(float, w.y & 0xffff0000u)} + gv0 * acc[ai][bj][m][0];
                        const f32x4 x1 = (f32x4){__builtin_bit_cast(float, w.z << 16), __builtin_bit_cast(float, w.z & 0xffff0000u), __builtin_bit_cast(float, w.w << 16), __builtin_bit_cast(float, w.w & 0xffff0000u)} + gv1 * acc[ai][bj][m][1];
                        const f32x4 g0 = gmn ? *(const PG8_LAS f32x4*)(gmp + bj * HALF) : (f32x4){0.f, 0.f, 0.f, 0.f}, g1 = gmn ? *(const PG8_LAS f32x4*)(gmp + bj * HALF + 4) : (f32x4){0.f, 0.f, 0.f, 0.f};
                        row_out(x0, x1, g0, g1, xb + off + bj * HALF, hn + off + bj * HALF, gmn, ss); }
                    row_stat(ss, rsn + row, gmn, fq);
                    asm volatile("" : "+v"(gp), "+v"(gmp)); }
            }
        }
    }
};

constexpr size_t CTL_RSF = 512 * 1024, CTL_FCNT = 800 * 1024;
struct EpiFinalN {
    static constexpr bool PERM = true, AFTER_DRAIN = false; static constexpr int PROBE_ID = 4;
    int l;
    __device__ __forceinline__ void prefetch(PG8_LAS unsigned char* lds, const Unit& u, int wid, int lane) const {
        if (wid == 0) dma_1k((const float*)(ARGS()->ws + WS_MOD) + (size_t)(l * 3 + 2) * BATCH * 3 * D + 2 * D + (size_t)(u.pm >> 4) * 3 * D + u.pn * BM, lds + EPI_SLOT, lane);
        else if (wid == 1) dma_1k((const float*)ARGS()->in[17] + u.pn * BM, lds + EPI_SLOT + EPI_COL, lane);
    }
    __device__ __forceinline__ void operator()(const f32x4 (&acc_)[2][2][4][2], const Unit& u, int wr, int wc, int fr, int fq, PG8_LAS unsigned char* lds) const {
        asm volatile("" : "+v"(fr), "+v"(fq));
        f32x4 (&X)[2][2][4][2] = const_cast<f32x4 (&)[2][2][4][2]>(acc_);
        const auto* A = ARGS(); unsigned char* ws = A->ws;
        const bf16_t* xb = (const bf16_t*)(ws + WS_XB);
        unsigned long long* rsf = (unsigned long long*)(ws + WS_CTL + CTL_RSF);
        const int row0 = u.pm * BM + wr * 64 + fr, col0 = u.pn * BM + wc * 32 + 8 * fq;
        const PG8_LAS float* gp = (const PG8_LAS float*)(lds + EPI_SLOT) + wc * 32 + 8 * fq; const PG8_LAS float* gfp = gp + EPI_COL / 4;
#pragma unroll
        for (int ai = 0; ai < 2; ++ai) {
            u32x4 xw[4][2];
#pragma unroll
            for (int m = 0; m < 4; ++m)
#pragma unroll
                for (int bj = 0; bj < 2; ++bj) xw[m][bj] = *(const u32x4*)(xb + (size_t)(row0 + ai * HALF + m * 16) * 1024 + col0 + bj * HALF);
#pragma unroll
            for (int m = 0; m < 4; ++m) { const int row = row0 + ai * HALF + m * 16;
                float ss = 0.f;
#pragma unroll
                for (int bj = 0; bj < 2; ++bj) { const u32x4 w = xw[m][bj];
                    const f32x4 gv0 = *(const PG8_LAS f32x4*)(gp + bj * HALF) * 0.5f, gv1 = *(const PG8_LAS f32x4*)(gp + bj * HALF + 4) * 0.5f;
                    const f32x4 x0 = (f32x4){__builtin_bit_cast(float, w.x << 16), __builtin_bit_cast(float, w.x & 0xffff0000u), __builtin_bit_cast(float, w.y << 16), __builtin_bit_cast(float, w.y & 0xffff0000u)} + gv0 * X[ai][bj][m][0];
                    const f32x4 x1 = (f32x4){__builtin_bit_cast(float, w.z << 16), __builtin_bit_cast(float, w.z & 0xffff0000u), __builtin_bit_cast(float, w.w << 16), __builtin_bit_cast(float, w.w & 0xffff0000u)} + gv1 * X[ai][bj][m][1];
                    X[ai][bj][m][0] = x0; X[ai][bj][m][1] = x1;
                    ss += (x0[0] * x0[0] + x0[1] * x0[1]) + (x0[2] * x0[2] + x0[3] * x0[3]) + (x1[0] * x1[0] + x1[1] * x1[1]) + (x1[2] * x1[2] + x1[3] * x1[3]); }
                EpiResidN::row_stat(ss, rsf + row, true, fq);
                asm volatile("" : "+v"(gp)); }
        }
        asm volatile("s_waitcnt vmcnt(0)" ::: "memory");
        __syncthreads();
        if (wr == 0 && wc == 0 && fr == 0 && fq == 0) { unsigned* cnt = (unsigned*)(ws + WS_CTL + CTL_FCNT) + u.pm;
            __hip_atomic_fetch_add(cnt, 1u, __ATOMIC_RELAXED, __HIP_MEMORY_SCOPE_AGENT);
            while (__hip_atomic_load(cnt, __ATOMIC_RELAXED, __HIP_MEMORY_SCOPE_AGENT) < 4u) __builtin_amdgcn_s_sleep(2); }
        __syncthreads();
        float* out = A->out;
        unsigned long long rv[8];
#pragma unroll
        for (int rg = 0; rg < 8; ++rg) rv[rg] = __hip_atomic_load(rsf + row0 + (rg >> 2) * HALF + (rg & 3) * 16, __ATOMIC_RELAXED, __HIP_MEMORY_SCOPE_AGENT);
#pragma unroll
        for (int ai = 0; ai < 2; ++ai)
#pragma unroll
            for (int m = 0; m < 4; ++m) { const int row = row0 + ai * HALF + m * 16; const size_t off = (size_t)row * 1024 + col0;
                const float rstd = rstd_of(rv[ai * 4 + m]);
#pragma unroll
                for (int bj = 0; bj < 2; ++bj) { const f32x4 g0 = *(const PG8_LAS f32x4*)(gfp + bj * HALF), g1 = *(const PG8_LAS f32x4*)(gfp + bj * HALF + 4);
                    *(f32x4*)(out + off + bj * HALF) = (X[ai][bj][m][0] * rstd) * g0; *(f32x4*)(out + off + bj * HALF + 4) = (X[ai][bj][m][1] * rstd) * g1; }
                asm volatile("" : "+v"(gfp)); }
    }
};
template <class Epi, class Sched, bool ALIGN_EPI = false, bool SP2 = false>
__device__ __forceinline__ void gemm_phase(PG8_LAS unsigned char* lds, const Gemm g, const Sched& S, const Epi& E, int wave_in) {
    int tid = wave_in * 64 + lane_id(); asm volatile("" : "+v"(tid));
    const int wid = __builtin_amdgcn_readfirstlane(tid >> 6), lane = tid & 63, wr = wid >> 2, wc = wid & 3, fr = lane & 15, fq = lane >> 4;
    const int K = g.K, nt = K / BK;
    unsigned voffA[2], voffB[2];
#pragma unroll
    for (int i = 0; i < 2; ++i) { int R, C; stage_rc(tid * 16 + i * 8192, R, C); const int Rb = Epi::PERM ? ((R & ~31) + perm32(R & 31)) : R;
        voffA[i] = (unsigned)(R * K + C) * 2u; voffB[i] = (unsigned)(Rb * K + C) * 2u; }
    const size_t kstep = (size_t)(BK * 2);
    const size_t hstep = (size_t)HALF * K * 2;
    const size_t tstep = 2 * hstep;
    const unsigned ldsw = (unsigned)wid * 1024u;
    const int aoff = lds_byte(wr * 64 + fr, fq * 8), boff = lds_byte(wc * 32 + fr, fq * 8);
#define PG8_SA(b, h) (((b) * 2 + (h)) * HTB)
#define PG8_SB(b, h) ((4 + (b) * 2 + (h)) * HTB)
#define PG8_STAGE(bufoff, gbase, voff) do { _Pragma("unroll") for (int _i = 0; _i < 2; ++_i) \
        __builtin_amdgcn_global_load_lds((const unsigned*)((const char*)(gbase) + (voff)[_i]), (PG8_LAS unsigned*)(lds + (bufoff) + ldsw + _i * 8192), 16, 0, 0); } while (0)
#define PG8_LDA(dst, b, h) do { _Pragma("unroll") for (int m = 0; m < 4; ++m) _Pragma("unroll") for (int k = 0; k < 2; ++k) dst[m][k] = *(const PG8_LAS bf16x8*)(lds + PG8_SA(b, h) + aoff + m * 2048 + k * 1024); } while (0)
#define PG8_LDB(dst, b, h) do { _Pragma("unroll") for (int n = 0; n < 2; ++n) _Pragma("unroll") for (int k = 0; k < 2; ++k) dst[n][k] = *(const PG8_LAS bf16x8*)(lds + PG8_SB(b, h) + boff + n * 2048 + k * 1024); } while (0)
#define PG8_MMA(ai, bj, At, Bt) do { __builtin_amdgcn_s_setprio(1); _Pragma("unroll") for (int m = 0; m < 4; ++m) _Pragma("unroll") for (int n = 0; n < 2; ++n) _Pragma("unroll") for (int k = 0; k < 2; ++k) \
        acc[ai][bj][m][n] = __builtin_amdgcn_mfma_f32_16x16x32_bf16(Bt[n][k], At[m][k], acc[ai][bj][m][n], 0, 0, 0); __builtin_amdgcn_s_setprio(0); } while (0)
#define PG8_WAIT_V(n) asm volatile("s_waitcnt vmcnt(" #n ")" ::: "memory")
#define PG8_WAIT_L(n) asm volatile("s_waitcnt lgkmcnt(" #n ")" ::: "memory")
#define PG8_BAR __builtin_amdgcn_s_barrier()
#define PG8_SCHED __builtin_amdgcn_sched_barrier(0)
    Unit cur, nxt; int ui = 0;
    if (!S.next(0, cur)) return;
    f32x4 acc[2][2][4][2];
#pragma unroll
    for (int a = 0; a < 2; ++a)
#pragma unroll
        for (int b = 0; b < 2; ++b)
#pragma unroll
            for (int m = 0; m < 4; ++m)
#pragma unroll
                for (int n = 0; n < 2; ++n) acc[a][b][m][n] = (f32x4){0.f, 0.f, 0.f, 0.f};
    bf16x8 At[4][2], B0[2][2], B1[2][2];
    const char* cA = (const char*)g.A + (size_t)cur.pm * tstep; const char* cB = (const char*)g.Bt + (size_t)cur.pn * tstep;
    S.a_ready(cur);
    if constexpr (SP2) {
        PG8_STAGE(PG8_SB(0, 0), cB, voffB); PG8_STAGE(PG8_SB(0, 1), cB + hstep, voffB); PG8_STAGE(PG8_SA(0, 0), cA, voffA); PG8_STAGE(PG8_SA(0, 1), cA + hstep, voffA);
        if (wr == 1) PG8_BAR;
        PG8_WAIT_V(2); PG8_BAR;
        PG8_STAGE(PG8_SB(1, 0), cB + kstep, voffB); PG8_STAGE(PG8_SA(1, 0), cA + kstep, voffA); PG8_STAGE(PG8_SB(1, 1), cB + hstep + kstep, voffB);
        PG8_WAIT_V(6); PG8_BAR;
    } else {
        PG8_STAGE(PG8_SB(0, 0), cB, voffB); PG8_STAGE(PG8_SA(0, 0), cA, voffA); PG8_STAGE(PG8_SB(0, 1), cB + hstep, voffB); PG8_STAGE(PG8_SA(0, 1), cA + hstep, voffA);
        if (wr == 1) PG8_BAR;
        PG8_WAIT_V(4); PG8_BAR;
        PG8_STAGE(PG8_SB(1, 0), cB + kstep, voffB); PG8_STAGE(PG8_SA(1, 0), cA + kstep, voffA); PG8_STAGE(PG8_SB(1, 1), cB + hstep + kstep, voffB);
        PG8_WAIT_V(6); PG8_BAR;
    }
    for (;;) {
        const bool has_next = S.next(ui + 1, nxt);
        const char* nA = has_next ? (const char*)g.A + (size_t)nxt.pm * tstep : cA; const char* nB = has_next ? (const char*)g.Bt + (size_t)nxt.pn * tstep : cB;
        for (int t = 0; t < nt; t += 2) {
            const bool last = (t == nt - 2);
            const char* a1 = cA + (size_t)(t + 1) * kstep;
            const char* a2 = last ? nA : cA + (size_t)(t + 2) * kstep; const char* b2 = last ? nB : cB + (size_t)(t + 2) * kstep;
            const char* a3 = a2 + kstep; const char* b3 = b2 + kstep;
            if (last && has_next) S.a_ready(nxt);
            if (last) E.prefetch(lds, cur, wid, lane);
            if constexpr (SP2) {
            PG8_LDB(B0, 0, 0); PG8_LDB(B1, 0, 1); PG8_SCHED; PG8_LDA(At, 0, 0); PG8_STAGE(PG8_SA(1, 1), a1 + hstep, voffA);
            PG8_WAIT_V(8); PG8_WAIT_L(0); PG8_BAR; PG8_MMA(0, 0, At, B0); PG8_MMA(0, 1, At, B1); PG8_BAR; PG8_SCHED;
            PG8_LDA(At, 0, 1); PG8_STAGE(PG8_SB(0, 0), b2, voffB); PG8_STAGE(PG8_SB(0, 1), b2 + hstep, voffB); PG8_STAGE(PG8_SA(0, 0), a2, voffA);
            PG8_WAIT_V(8); PG8_WAIT_L(0); PG8_BAR; PG8_MMA(1, 0, At, B0); PG8_MMA(1, 1, At, B1); PG8_BAR; PG8_SCHED;
            PG8_LDB(B0, 1, 0); PG8_LDB(B1, 1, 1); PG8_SCHED; PG8_LDA(At, 1, 0); PG8_STAGE(PG8_SA(0, 1), a2 + hstep, voffA);
            PG8_WAIT_V(8); PG8_WAIT_L(0); PG8_BAR; PG8_MMA(0, 0, At, B0); PG8_MMA(0, 1, At, B1); PG8_BAR; PG8_SCHED;
            PG8_LDA(At, 1, 1); PG8_STAGE(PG8_SB(1, 0), b3, voffB); PG8_STAGE(PG8_SB(1, 1), b3 + hstep, voffB); PG8_STAGE(PG8_SA(1, 0), a3, voffA);
            PG8_WAIT_V(8); PG8_WAIT_L(0); PG8_BAR; PG8_MMA(1, 0, At, B0); PG8_MMA(1, 1, At, B1); PG8_BAR; PG8_SCHED;
            } else {
            PG8_LDB(B0, 0, 0); PG8_SCHED; PG8_LDA(At, 0, 0); PG8_STAGE(PG8_SA(1, 1), a1 + hstep, voffA);
            PG8_WAIT_L(8); PG8_BAR; PG8_WAIT_L(0); PG8_MMA(0, 0, At, B0); PG8_BAR; PG8_SCHED;
            PG8_LDB(B1, 0, 1); PG8_STAGE(PG8_SB(0, 0), b2, voffB);
            PG8_BAR; PG8_WAIT_L(0); PG8_MMA(0, 1, At, B1); PG8_BAR;
            PG8_LDA(At, 0, 1); PG8_STAGE(PG8_SA(0, 0), a2, voffA);
            PG8_BAR; PG8_WAIT_L(0); PG8_MMA(1, 0, At, B0); PG8_BAR; PG8_SCHED;
            PG8_STAGE(PG8_SB(0, 1), b2 + hstep, voffB);
            PG8_WAIT_V(6); PG8_BAR; PG8_MMA(1, 1, At, B1); PG8_BAR;
            PG8_LDB(B0, 1, 0); PG8_SCHED; PG8_LDA(At, 1, 0); PG8_STAGE(PG8_SA(0, 1), a2 + hstep, voffA);
            PG8_WAIT_L(8); PG8_BAR; PG8_WAIT_L(0); PG8_MMA(0, 0, At, B0); PG8_BAR; PG8_SCHED;
            PG8_LDB(B1, 1, 1); PG8_STAGE(PG8_SB(1, 0), b3, voffB);
            PG8_BAR; PG8_WAIT_L(0); PG8_MMA(0, 1, At, B1); PG8_BAR;
            PG8_LDA(At, 1, 1); PG8_STAGE(PG8_SA(1, 0), a3, voffA);
            PG8_BAR; PG8_WAIT_L(0); PG8_MMA(1, 0, At, B0); PG8_BAR; PG8_SCHED;
            PG8_STAGE(PG8_SB(1, 1), b3 + hstep, voffB);
            PG8_WAIT_V(6); PG8_BAR; PG8_MMA(1, 1, At, B1); PG8_BAR;
            }
        }
        if constexpr (ALIGN_EPI) { if (wr == 0) PG8_BAR; }
        if constexpr (!Epi::AFTER_DRAIN) {
#if defined(EPI_PROBE)
            const unsigned long long ep0_ = (Epi::PROBE_ID == EPI_PROBE) ? __builtin_amdgcn_s_memrealtime() : 0ull;
#endif
            E(acc, cur, wr, wc, fr, fq, lds); S.done(cur);
#if defined(EPI_PROBE)
            if (Epi::PROBE_ID == EPI_PROBE) { asm volatile("s_waitcnt vmcnt(0)" ::: "memory"); const unsigned long long d_ = __builtin_amdgcn_s_memrealtime() - ep0_; const unsigned long long e_ = __builtin_amdgcn_s_memrealtime() + 3ull * d_; while (__builtin_amdgcn_s_memrealtime() < e_) __builtin_amdgcn_s_sleep(2); }
#endif
        }
        if (!has_next) break;
#pragma unroll
        for (int a = 0; a < 2; ++a)
#pragma unroll
            for (int b = 0; b < 2; ++b)
#pragma unroll
                for (int m = 0; m < 4; ++m)
#pragma unroll
                    for (int n = 0; n < 2; ++n) acc[a][b][m][n] = (f32x4){0.f, 0.f, 0.f, 0.f};
        cur = nxt; cA = nA; cB = nB; ++ui;
        if constexpr (ALIGN_EPI) { if (wr == 1) PG8_BAR; }
    }
    PG8_WAIT_V(0);
    if constexpr (!ALIGN_EPI) { if (wr == 0) PG8_BAR; }
    PG8_BAR;
    if constexpr (Epi::AFTER_DRAIN) { E.fused(acc, cur, wr, wc, fr, fq, lds, wid, lane); S.done(cur); }
#undef PG8_SA
#undef PG8_SB
#undef PG8_STAGE
#undef PG8_LDA
#undef PG8_LDB
#undef PG8_MMA
#undef PG8_WAIT_V
#undef PG8_WAIT_L
#undef PG8_BAR
#undef PG8_SCHED
}
}
#define XB_TMO      128
#define XB_XCNT(j)  (256  + 64 * (j))
#define XB_XSUB(j)  (1280 + 64 * (j))
#define XB_XGEN(j)  (2304 + 64 * (j))
#define XB_TOP      3328
#define XB_TOPGEN   3392
#define XCD_BAR_WORDS 3456
#define XB_SPIN_CAP (1u << 18)

__device__ __forceinline__ unsigned xb_ld(unsigned* p)              { return __hip_atomic_load(p, __ATOMIC_RELAXED, __HIP_MEMORY_SCOPE_AGENT); }
__device__ __forceinline__ unsigned xb_add(unsigned* p, unsigned v) { return __hip_atomic_fetch_add(p, v, __ATOMIC_RELAXED, __HIP_MEMORY_SCOPE_AGENT); }
__device__ __forceinline__ unsigned xb_xcc_id() { return (unsigned)__builtin_amdgcn_s_getreg((3 << 11) | 20) & 0xFu; }
#define XB_SPIN(cond, bar) do { unsigned _sp = 0; while (cond) { __builtin_amdgcn_s_sleep(1); \
    if ((++_sp & 255u) == 0u) { if (xb_ld(&(bar)[XB_TMO])) break; if (_sp > XB_SPIN_CAP) { atomicAdd(&(bar)[XB_TMO], 1u); break; } } } } while (0)

struct XcdBarrier {
    unsigned w;
    unsigned* bar; unsigned x;
    volatile LAS unsigned* st;
};

__device__ __forceinline__ XcdBarrier xcd_barrier_post(unsigned* bar, volatile LAS unsigned* st) {
    XcdBarrier b; b.bar = bar; b.x = xb_xcc_id(); b.st = st;
    b.w = (unsigned)__builtin_amdgcn_readfirstlane((int)(threadIdx.x >> 6));
    if (threadIdx.x == 0) (void)xb_add(&bar[XB_XCNT(b.x)], 1u);
    return b;
}
__device__ __forceinline__ void xcd_barrier_complete(unsigned* bar, unsigned x, unsigned& nloc, unsigned& nx) {
    const unsigned G = gridDim.x * gridDim.y * gridDim.z;
    unsigned sum, cnt, mine, sp = 0u;
    for (;;) {
        sum = 0u; cnt = 0u; mine = 0u;
#pragma unroll
        for (unsigned j = 0; j < 16; ++j) { const unsigned c = xb_ld(&bar[XB_XCNT(j)]); sum += c; cnt += (c > 0u) ? 1u : 0u; mine = (j == x) ? c : mine; }
        if (sum == G) break;
        __builtin_amdgcn_s_sleep(1);
        if ((++sp & 255u) == 0u) { if (xb_ld(&bar[XB_TMO])) break; if (sp > XB_SPIN_CAP) { atomicAdd(&bar[XB_TMO], 1u); break; } }
    }
    nloc = mine > 0u ? mine : 1u; nx = cnt > 0u ? cnt : 1u;
}

__device__ __forceinline__ void xcd_barrier(const XcdBarrier& b) {
    asm volatile("s_waitcnt vmcnt(0)" ::: "memory");
    __syncthreads();
    if (b.w == 0u && lane_id() == 0) {
        unsigned* bar = b.bar;
        __builtin_amdgcn_s_waitcnt(0);
        unsigned nloc = b.st[0], nx = b.st[1];
        if (nloc == 0u) { xcd_barrier_complete(bar, b.x, nloc, nx); b.st[0] = nloc; b.st[1] = nx; }
        const unsigned old = xb_add(&bar[XB_XSUB(b.x)], 1u);
        const unsigned gen = old / nloc;
        if (old + 1u == (gen + 1u) * nloc) {
            __builtin_amdgcn_fence(__ATOMIC_RELEASE, "agent");
            asm volatile("s_waitcnt vmcnt(0)" ::: "memory");
            const unsigned og = xb_add(&bar[XB_TOP], 1u);
            const unsigned tg = og / nx;
            if (og + 1u == (tg + 1u) * nx) xb_add(&bar[XB_TOPGEN], 1u);
            else XB_SPIN(xb_ld(&bar[XB_TOPGEN]) == tg, bar);
            __builtin_amdgcn_fence(__ATOMIC_ACQUIRE, "agent");
            xb_add(&bar[XB_XGEN(b.x)], 1u);
            asm volatile("s_waitcnt vmcnt(0)" ::: "memory");
        } else {
            XB_SPIN(xb_ld(&bar[XB_XGEN(b.x)]) == gen, bar);
            __builtin_amdgcn_fence(__ATOMIC_ACQUIRE, "agent");
            asm volatile("s_waitcnt vmcnt(0)" ::: "memory");
        }
    }
    __syncthreads();
}

__device__ __forceinline__ void p0_transpose_item(const float* W, int ldw, int K, bf16* WT, int dst_row0, LAS float* scr, int k0, int n0, int lane) {
#pragma unroll 8
    for (int i = 0; i < 32; ++i) { const int kk = 2 * i + (lane >> 5); scr[kk * 33 + (lane & 31)] = W[(size_t)(k0 + kk) * ldw + n0 + (lane & 31)]; }
    LDS_WAIT(); asm volatile("" ::: "memory");
    const int c = lane & 7;
#pragma unroll
    for (int j = 0; j < 4; ++j) { const int n = (lane >> 3) + 8 * j; const LAS float* s = scr + (8 * c) * 33 + n;
        v4u o; o.x = pk2(s[0 * 33], s[1 * 33]); o.y = pk2(s[2 * 33], s[3 * 33]); o.z = pk2(s[4 * 33], s[5 * 33]); o.w = pk2(s[6 * 33], s[7 * 33]);
        *(GAS v4u*)(WT + (size_t)(dst_row0 + n) * K + k0 + 8 * c) = o; }
    LDS_WAIT(); asm volatile("" ::: "memory");
}
__device__ __forceinline__ void sincos_d(double a, double& s, double& c) {
    const double k = __builtin_rint(a * 0.63661977236758134308);
    double t = __builtin_fma(-k, 1.57079632679489655800e+00, a); t = __builtin_fma(-k, 6.12323399573676603587e-17, t);
    const double t2 = t * t;
    double sp = 1.0 / 6227020800.0; sp = sp * t2 - 1.0 / 39916800.0; sp = sp * t2 + 1.0 / 362880.0; sp = sp * t2 - 1.0 / 5040.0; sp = sp * t2 + 1.0 / 120.0; sp = sp * t2 - 1.0 / 6.0; sp = sp * t2 + 1.0;
    const double st = sp * t;
    double cp = -1.0 / 87178291200.0; cp = cp * t2 + 1.0 / 479001600.0; cp = cp * t2 - 1.0 / 3628800.0; cp = cp * t2 + 1.0 / 40320.0; cp = cp * t2 - 1.0 / 720.0; cp = cp * t2 + 1.0 / 24.0; cp = cp * t2 - 0.5; cp = cp * t2 + 1.0;
    const int q = (int)((long long)k & 3ll);
    s = (q == 0) ? st : (q == 1) ? cp : (q == 2) ? -st : -cp;
    c = (q == 0) ? cp : (q == 1) ? -st : (q == 2) ? -cp : st;
}


__device__ __forceinline__ void vecmat_unit(const LAS float* vs, LAS float* part, const float* W, int ldw, int n0, int ncols, float* outp, int out_bstride, const float* bias, int tid, int lane, int wave) {
    float acc[8];
#pragma unroll
    for (int b = 0; b < 8; ++b) acc[b] = 0.f;
    const int k0 = wave * 128; const bool act = lane < ncols;
    const float* Wp = W + (size_t)k0 * ldw + n0 + (act ? lane : 0);
    for (int kb = 0; kb < 128; kb += 64) {
        float w[64];
#pragma unroll
        for (int j = 0; j < 64; ++j) w[j] = Wp[(size_t)(kb + j) * ldw];
#pragma unroll
        for (int j = 0; j < 64; ++j)
#pragma unroll
            for (int b = 0; b < 8; ++b) acc[b] += vs[b * D + k0 + kb + j] * w[j];
    }
#pragma unroll
    for (int b = 0; b < 8; ++b) part[(wave * 8 + b) * 64 + lane] = acc[b];
    __syncthreads();
    { const int b = tid >> 6, col = tid & 63;
      if (col < ncols) { float s = bias ? bias[col] : 0.f;
#pragma unroll
        for (int w = 0; w < 8; ++w) s += part[(w * 8 + b) * 64 + col];
        outp[(size_t)b * out_bstride + col] = s; } }
    __syncthreads();
}

__device__ __forceinline__ void prologue_a(LAS unsigned char* lds, const void* const* in, unsigned char* ws, int tid, int lane, int wave, int vcu, int G) {
    const float* cvec = (const float*)in[1]; const int* positions = (const int*)in[2];
    const float* w_ada = (const float*)in[4]; const float* b_ada = (const float*)in[5];
    const int gtid = vcu * (NWAVES * 64) + tid, nth = G * NWAVES * 64;
    { f32x4* z0 = (f32x4*)(ws + WS_RS); for (int i = gtid; i < (int)((size_t)DEPTH * 3 * M * 8 / 16); i += nth) z0[i] = (f32x4){0.f, 0.f, 0.f, 0.f};
    }
    {
        LAS float* sc = (LAS float*)lds;
        LAS float* part = (LAS float*)(lds + 32768);
        float* mod = (float*)(ws + WS_MOD);
        for (int i = tid; i < BATCH * D; i += NWAVES * 64) sc[i] = silu_acc(cvec[i]);
        __syncthreads();
        for (int u = vcu; u < DEPTH * 3 * 48; u += G) { const int ls = u / 48, n0 = (u % 48) * 64;
            vecmat_unit(sc, part, w_ada + (size_t)ls * D * 3 * D, 3 * D, n0, 64, mod + (size_t)ls * BATCH * 3 * D + n0, 3 * D, b_ada + (size_t)ls * 3 * D + n0, tid, lane, wave); }
    }
    if (gtid < 64) {
        double r = 1.0, p = 0.8659643233600653;
#pragma unroll
        for (int bit = 0; bit < 6; ++bit) { if ((gtid >> bit) & 1) r *= p; p *= p; }
        ((float*)(ws + WS_ROPE))[gtid] = (float)r;
    }
    {
        LAS float* scr = (LAS float*)(lds + wave * 16384);
        const int gw = vcu * NWAVES + wave, NGW = G * NWAVES;
        constexpr int I_13 = (D / 64) * (DFF / 32), I_2 = (DFF / 64) * (D / 32), I_IN = (D / 64) * (DZ / 32), I_OUT = (D / 64) * (D / 32);
        constexpr int PER_LAYER = 4 * I_13 + 2 * I_2 + I_IN + I_OUT, NITEMS = DEPTH * PER_LAYER;
#define TR_DECODE(IT_, SRC_, LDW_, WT_, KK_, DROW_, K0_) do { \
            const int l_ = (IT_) / PER_LAYER; int r_ = (IT_) % PER_LAYER; unsigned char* lw_ = ws + WS_W + (size_t)l_ * LW_BYTES; \
            if (r_ < 4 * I_13) { const int q_ = r_ / I_13, rr_ = r_ % I_13, f_ = q_ >> 1, t_ = q_ & 1, kb_ = rr_ / (DFF / 32), n0_ = (rr_ % (DFF / 32)) * 32; \
                SRC_ = (t_ ? (const float*)in[7] : (const float*)in[6]) + (size_t)(l_ * 2 + f_) * D * DFF + (size_t)(kb_ * 64) * DFF + n0_; LDW_ = DFF; WT_ = (bf16*)(lw_ + LW_W13 + (size_t)f_ * W13_BYTES); KK_ = D; \
                DROW_ = 256 * (n0_ >> 7) + 128 * t_ + (n0_ & 127); K0_ = kb_ * 64; } \
            else if ((r_ -= 4 * I_13) < 2 * I_2) { const int f_ = r_ / I_2, rr_ = r_ % I_2, kb_ = rr_ / (D / 32), n0_ = (rr_ % (D / 32)) * 32; \
                SRC_ = (const float*)in[8] + (size_t)(l_ * 2 + f_) * DFF * D + (size_t)(kb_ * 64) * D + n0_; LDW_ = D; WT_ = (bf16*)(lw_ + LW_W2 + (size_t)f_ * W2_BYTES); KK_ = DFF; DROW_ = n0_; K0_ = kb_ * 64; } \
            else if ((r_ -= 2 * I_2) < I_IN) { const int kb_ = r_ / (DZ / 32), n0_ = (r_ % (DZ / 32)) * 32; int dr_ = n0_; \
                if (n0_ < 1024) { const int grp_ = n0_ >> 9, head_ = (n0_ >> 7) & 3, half_ = (n0_ >> 6) & 1; dr_ = 256 * (2 * grp_ + (head_ >> 1)) + 128 * half_ + 64 * (head_ & 1) + (n0_ & 63); }     \
                SRC_ = (const float*)in[9] + (size_t)l_ * D * DIN + (size_t)(kb_ * 64) * DIN + n0_; LDW_ = DIN; WT_ = (bf16*)(lw_ + LW_WIN); KK_ = D; DROW_ = dr_; K0_ = kb_ * 64; } \
            else { r_ -= I_IN; const int kb_ = r_ / (D / 32), n0_ = (r_ % (D / 32)) * 32; \
                SRC_ = (const float*)in[16] + (size_t)l_ * D * D + (size_t)(kb_ * 64) * D + n0_; LDW_ = D; WT_ = (bf16*)(lw_ + LW_WOUT); KK_ = D; DROW_ = n0_; K0_ = kb_ * 64; } } while (0)
#define TR_LOAD(V_, SRC_, LDW_) do { _Pragma("unroll") for (int i_ = 0; i_ < 32; ++i_) V_[i_] = SRC_[(size_t)(2 * i_ + (lane >> 5)) * LDW_ + (lane & 31)]; } while (0)
#define TR_STORE(V_, WT_, KK_, DROW_, K0_) do { \
            _Pragma("unroll") for (int i_ = 0; i_ < 32; ++i_) scr[(2 * i_ + (lane >> 5)) * 33 + (lane & 31)] = V_[i_]; \
            LDS_WAIT(); asm volatile("" ::: "memory"); \
            { const int c_ = lane & 7; \
              _Pragma("unroll") for (int j_ = 0; j_ < 4; ++j_) { const int n_ = (lane >> 3) + 8 * j_; const LAS float* s_ = scr + (8 * c_) * 33 + n_; \
                v4u o_; o_.x = pk2(s_[0 * 33], s_[1 * 33]); o_.y = pk2(s_[2 * 33], s_[3 * 33]); o_.z = pk2(s_[4 * 33], s_[5 * 33]); o_.w = pk2(s_[6 * 33], s_[7 * 33]); \
                *(GAS v4u*)(WT_ + (size_t)(DROW_ + n_) * KK_ + K0_ + 8 * c_) = o_; } } \
            LDS_WAIT(); asm volatile("" ::: "memory"); } while (0)
        const float* sa = nullptr; const float* sb = nullptr; bf16* wa = nullptr; bf16* wb = nullptr; int la = 0, lb = 0, ka = 0, kb2 = 0, da = 0, db = 0, k0a = 0, k0b = 0;
        float va[32], vb[32];
        int it = gw;
        if (it < NITEMS) { TR_DECODE(it, sa, la, wa, ka, da, k0a); TR_LOAD(va, sa, la); }
        while (it < NITEMS) {
            const int it2 = it + NGW;
            if (it2 < NITEMS) { TR_DECODE(it2, sb, lb, wb, kb2, db, k0b); TR_LOAD(vb, sb, lb); }
            TR_STORE(va, wa, ka, da, k0a);
            if (it2 >= NITEMS) break;
            const int it3 = it2 + NGW;
            if (it3 < NITEMS) { TR_DECODE(it3, sa, la, wa, ka, da, k0a); TR_LOAD(va, sa, la); }
            TR_STORE(vb, wb, kb2, db, k0b);
            it = it3;
        }
#undef TR_DECODE
#undef TR_LOAD
#undef TR_STORE
    }
}
__device__ __forceinline__ void prologue_b(LAS unsigned char* lds, const void* const* in, unsigned char* ws, unsigned char* outb, int tid, int lane, int wave, int vcu, int G) {
    const float* x = (const float*)in[0]; const float* norm_g = (const float*)in[3];
    const float* mod = (const float*)(ws + WS_MOD);
    const int gtid = vcu * (NWAVES * 64) + tid, nth = G * NWAVES * 64;
    { float* gmt = (float*)(ws + WS_GM);
      for (int i = gtid; i < DEPTH * 3 * BATCH * D; i += nth) { const int c = i & (D - 1), b = (i >> 10) & 7, ls = i >> 13; gmt[i] = norm_g[ls * D + c] * (1.0f + mod[((size_t)ls * BATCH + b) * 3 * D + D + c]); } }
    {
        LAS float* vs = (LAS float*)lds;
        LAS float* part = (LAS float*)(lds + 32768);
        const float* w_ff1 = (const float*)in[6]; const float* w_ff3 = (const float*)in[7]; const float* w_in = (const float*)in[9];
        constexpr int U13 = DEPTH * 2 * 2 * (DFF / 64), UIN = DEPTH * 65;
        for (int u = vcu; u < U13 + UIN; u += G) {
            int l, s;
            if (u < U13) { l = u / (4 * (DFF / 64)); s = ((u / (2 * (DFF / 64))) & 1) ? 2 : 0; } else { l = (u - U13) / 65; s = 1; }
            __syncthreads();
            for (int i = tid; i < BATCH * D; i += NWAVES * 64) vs[i] = mod[((size_t)(l * 3 + s) * BATCH + (i >> 10)) * 3 * D + (i & (D - 1))];
            __syncthreads();
            if (u < U13) { const int f = (u / (2 * (DFF / 64))) & 1, t = (u / (DFF / 64)) & 1, nb = u % (DFF / 64), n0 = nb * 64;
                const float* W = (t ? w_ff3 : w_ff1) + (size_t)(l * 2 + f) * D * DFF;
                vecmat_unit(vs, part, W, DFF, n0, 64, (float*)(ws + WS_SW13) + (size_t)(l * 2 + f) * BATCH * 2 * DFF + 256 * (n0 >> 7) + 128 * t + (n0 & 127), 2 * DFF, nullptr, tid, lane, wave);
            } else { const int nb = (u - U13) % 65, n0 = nb * 64;
                vecmat_unit(vs, part, w_in + (size_t)l * D * DIN, DIN, n0, nb == 64 ? 8 : 64, (float*)(ws + WS_SWIN) + (size_t)l * BATCH * DIN + n0, DIN, nullptr, tid, lane, wave); }
        }
    }
    {
        const int gw = vcu * NWAVES + wave, NGW = G * NWAVES;
        bf16* hout = (bf16*)(outb + OUT_H); unsigned long long* rs = (unsigned long long*)(ws + WS_RS);
        for (int grp = gw; grp < M / 16; grp += NGW) {
            const int row0 = grp * 16, b = row0 / SEQ;
            f32x4 gm[4];
#pragma unroll
            for (int j = 0; j < 4; ++j) { const int col = 4 * lane + 256 * j; gm[j] = *(const f32x4*)(norm_g + col) * (1.0f + *(const f32x4*)(mod + (size_t)b * 3 * D + D + col)); }
            for (int r = 0; r < 16; r += 2) {
                const int row = row0 + r;
                const GAS f32x4* xr = (const GAS f32x4*)(x + (size_t)row * D) + lane;
                f32x4 v[4], v2[4]; float ss = 0.f, ss2 = 0.f;
#pragma unroll
                for (int j = 0; j < 4; ++j) { v[j] = xr[64 * j]; v2[j] = xr[64 * j + D / 4]; }
#pragma unroll
                for (int j = 0; j < 4; ++j) { ss += (v[j].x * v[j].x + v[j].y * v[j].y) + (v[j].z * v[j].z + v[j].w * v[j].w); ss2 += (v2[j].x * v2[j].x + v2[j].y * v2[j].y) + (v2[j].z * v2[j].z + v2[j].w * v2[j].w); }
                ss = wave_sum(ss); ss2 = wave_sum(ss2);
                if (lane == 0) { rs[row] = (unsigned long long)(ss * RS_SCALE); rs[row + 1] = (unsigned long long)(ss2 * RS_SCALE); }
                GAS unsigned long long* o8 = (GAS unsigned long long*)(hout + (size_t)row * D) + lane;
#pragma unroll
                for (int j = 0; j < 4; ++j) { const f32x4 t = v[j] * gm[j], t2 = v2[j] * gm[j];
                    o8[64 * j] = (unsigned long long)pk2(t.x, t.y) | ((unsigned long long)pk2(t.z, t.w) << 32);
                    o8[64 * j + D / 4] = (unsigned long long)pk2(t2.x, t2.y) | ((unsigned long long)pk2(t2.z, t2.w) << 32); }
            }
        }
    }
}

__device__ __forceinline__ void final_norm_phase(const bf16* xb, float* out, const float* g, int gw, int NGW, int lane) {
    for (int grp = gw; grp < M / 16; grp += NGW) {
        f32x4 gm[4];
#pragma unroll
        for (int j = 0; j < 4; ++j) gm[j] = *(const f32x4*)(g + 4 * lane + 256 * j);
        for (int r = 0; r < 16; r += 2) {
            const size_t row = (size_t)(grp * 16 + r);
            typedef unsigned v2u __attribute__((ext_vector_type(2)));
            const GAS v2u* xr = (const GAS v2u*)(xb + row * D) + lane;
            v2u w[4], w2[4];
#pragma unroll
            for (int j = 0; j < 4; ++j) { w[j] = xr[64 * j]; w2[j] = xr[64 * j + D / 4]; }
            f32x4 v[4], v2[4]; float ss = 0.f, ss2 = 0.f;
#pragma unroll
            for (int j = 0; j < 4; ++j) { v[j] = (f32x4){bflo(w[j].x), bfhi(w[j].x), bflo(w[j].y), bfhi(w[j].y)}; v2[j] = (f32x4){bflo(w2[j].x), bfhi(w2[j].x), bflo(w2[j].y), bfhi(w2[j].y)};
                ss += (v[j].x * v[j].x + v[j].y * v[j].y) + (v[j].z * v[j].z + v[j].w * v[j].w); ss2 += (v2[j].x * v2[j].x + v2[j].y * v2[j].y) + (v2[j].z * v2[j].z + v2[j].w * v2[j].w); }
            const float rstd = 1.0f / sqrtf(wave_sum(ss) * (1.0f / D) + EPS), rstd2 = 1.0f / sqrtf(wave_sum(ss2) * (1.0f / D) + EPS);
            GAS f32x4* orow = (GAS f32x4*)(out + row * D) + lane;
#pragma unroll
            for (int j = 0; j < 4; ++j) { orow[64 * j] = (v[j] * rstd) * gm[j]; orow[64 * j + D / 4] = (v2[j] * rstd2) * gm[j]; }
        }
    }
}
__device__ __forceinline__ float lg2gamma(int h) { return h == 0 ? -0.04580368961312479f : h == 1 ? -0.02272007650008353f : h == 2 ? -0.011315313227834146f : -0.005646563141142063f; }
constexpr float QK_SCALE = 0.08838834764831845f;
__device__ __forceinline__ void ml_gate_scan(const float* gates, int row0, int h, int lane, float& bc0, float& bc1, float& ic0, float& ic1) {
    const float* gp = gates + (size_t)(row0 + 2 * lane) * 8;
    ic0 = gp[h]; ic1 = gp[8 + h];
    const float lf0 = logsigmoid_acc(gp[4 + h]), lf1 = logsigmoid_acc(gp[12 + h]);
    const float s1 = lf0 + lf1; float v = s1;
#pragma unroll
    for (int off = 1; off < 64; off <<= 1) { const float t = __shfl_up(v, off); if (lane >= off) v += t; }
    const float ex = v - s1; bc0 = ex + lf0; bc1 = ex + s1;
}
__device__ __forceinline__ void gates_job(const bf16* xg, const unsigned long long* rs, const float* w_in_l, const float* swin_l, const float* b_ig, const float* b_fg, float* gates, int lane, int wave, int vcu, int G) {
    f32x4 wg[16][2];
#pragma unroll
    for (int j = 0; j < 2; ++j)
#pragma unroll
        for (int e = 0; e < 8; ++e) { const float* wp = w_in_l + (size_t)(512 * j + 8 * lane + e) * DIN + DZ; wg[8 * j + e][0] = *(const f32x4*)wp; wg[8 * j + e][1] = *(const f32x4*)(wp + 4); }
    for (int blk = vcu; blk < M / 128; blk += G) {
        const int b = (blk * 128) / SEQ;
        float cq = 0.f;
        if (lane < 8) cq = swin_l[(size_t)b * DIN + DZ + lane] + (lane < 4 ? b_ig[lane] : b_fg[lane - 4]);
        for (int r = 0; r < 16; ++r) {
            const int row = blk * 128 + wave * 16 + r;
            const v4u a0 = *(const v4u*)(xg + (size_t)row * D + 8 * lane), a1 = *(const v4u*)(xg + (size_t)row * D + 512 + 8 * lane);
            const float xv[16] = {bflo(a0.x), bfhi(a0.x), bflo(a0.y), bfhi(a0.y), bflo(a0.z), bfhi(a0.z), bflo(a0.w), bfhi(a0.w), bflo(a1.x), bfhi(a1.x), bflo(a1.y), bfhi(a1.y), bflo(a1.z), bfhi(a1.z), bflo(a1.w), bfhi(a1.w)};
            f32x4 d0 = {0.f, 0.f, 0.f, 0.f}, d1 = d0;
#pragma unroll
            for (int e = 0; e < 16; ++e) { d0 += wg[e][0] * xv[e]; d1 += wg[e][1] * xv[e]; }
            float mine = 0.f;
#pragma unroll
            for (int q = 0; q < 4; ++q) { const float s0 = wave_sum(d0[q]), s1 = wave_sum(d1[q]); if (lane == q) mine = s0; if (lane == 4 + q) mine = s1; }
            if (lane < 8) gates[(size_t)row * 8 + lane] = (1.0f / sqrtf((float)rs[row] * RS_INV + EPS)) * mine + cq;
        }
    }
}

constexpr int ZLD = 128;
#define ZS(z, slice, row) ((z) + ((size_t)(slice) * M + (size_t)(row)) * ZLD)
typedef short bf16x8 __attribute__((ext_vector_type(8)));
typedef short s16x4 __attribute__((ext_vector_type(4)));
__device__ __forceinline__ unsigned cvtpk(float lo, float hi) { unsigned r; asm volatile("v_cvt_pk_bf16_f32 %0, %1, %2" : "=v"(r) : "v"(lo), "v"(hi)); return r; }
template <int OFF> __device__ __forceinline__ s16x4 tr_read(unsigned addr) { s16x4 r; asm volatile("ds_read_b64_tr_b16 %0, %1 offset:%2" : "=&v"(r) : "v"(addr), "i"(OFF) : "memory"); return r; }
template <int OFF> __device__ __forceinline__ bf16x8 lds_rd16(unsigned addr) { bf16x8 r; asm volatile("ds_read_b128 %0, %1 offset:%2" : "=&v"(r) : "v"(addr), "i"(OFF) : "memory"); return r; }
#define TR_WAIT() do { asm volatile("s_waitcnt lgkmcnt(0)" ::: "memory"); __builtin_amdgcn_sched_barrier(0); } while (0)
#define PK8(L, H) (bf16x8){L[0], L[1], L[2], L[3], H[0], H[1], H[2], H[3]}
__device__ __forceinline__ float silu_fast(float x) { return x * __builtin_amdgcn_rcpf(1.0f + __expf(-x)); }
__device__ __forceinline__ float sigmoid_fast(float x) { return __builtin_amdgcn_rcpf(1.0f + __expf(-x)); }
constexpr float LOG2E = 1.4426950408889634f;
#ifndef TPROBE
#define TPROBE 0
#endif
#define TPX_NOW() __builtin_amdgcn_s_memrealtime()
#define TPX_SPIN(T0_, K_) do { const unsigned long long d_ = TPX_NOW() - (T0_); const unsigned long long e_ = TPX_NOW() + (unsigned long long)(K_) * d_; while (TPX_NOW() < e_) __builtin_amdgcn_s_sleep(2); } while (0)
#define TP_BEGIN() const unsigned long long tp0_ = __builtin_amdgcn_s_memtime()
#define TP_SPIN(K) do { const unsigned long long d_ = __builtin_amdgcn_s_memtime() - tp0_; const unsigned long long e_ = __builtin_amdgcn_s_memtime() + (unsigned long long)(K) * d_; while (__builtin_amdgcn_s_memtime() < e_) __builtin_amdgcn_s_sleep(2); } while (0)

template <int NPC, int NTHR>
__device__ __forceinline__ void stage_rot(LAS bf16* dst, int ldst, int half_off, const bf16* zp0, const float2* rp0, float scale, const LAS float* rowscale, int tid) {
    for (int it = tid; it < 128 * NPC; it += NTHR) {
        const int l = it / NPC, pc = it % NPC;
        const bf16* zp = zp0 + (size_t)l * DZ + 8 * pc;
        const v4u a = *(const v4u*)zp, b = *(const v4u*)(zp + 64);
        const f32x4* rp = (const f32x4*)(rp0 + (size_t)l * 64 + 8 * pc);
        const f32x4 r0 = rp[0], r1 = rp[1], r2 = rp[2], r3 = rp[3];
        const float sc = rowscale ? scale * rowscale[l] : scale;
        const float t1[8] = {bflo(a.x), bfhi(a.x), bflo(a.y), bfhi(a.y), bflo(a.z), bfhi(a.z), bflo(a.w), bfhi(a.w)};
        const float t2[8] = {bflo(b.x), bfhi(b.x), bflo(b.y), bfhi(b.y), bflo(b.z), bfhi(b.z), bflo(b.w), bfhi(b.w)};
        const float cs[8] = {r0.x, r0.z, r1.x, r1.z, r2.x, r2.z, r3.x, r3.z}, sn[8] = {r0.y, r0.w, r1.y, r1.w, r2.y, r2.w, r3.y, r3.w};
        float o1[8], o2[8];
#pragma unroll
        for (int j = 0; j < 8; ++j) { o1[j] = (t1[j] * cs[j] - t2[j] * sn[j]) * sc; o2[j] = (t1[j] * sn[j] + t2[j] * cs[j]) * sc; }
        v4u w1, w2; w1.x = cvtpk(o1[0], o1[1]); w1.y = cvtpk(o1[2], o1[3]); w1.z = cvtpk(o1[4], o1[5]); w1.w = cvtpk(o1[6], o1[7]);
        w2.x = cvtpk(o2[0], o2[1]); w2.y = cvtpk(o2[2], o2[3]); w2.z = cvtpk(o2[4], o2[5]); w2.w = cvtpk(o2[6], o2[7]);
        *(LAS v4u*)(dst + l * ldst + 8 * pc) = w1; *(LAS v4u*)(dst + l * ldst + half_off + 8 * pc) = w2;
    }
}
template <int NCHK>
__device__ __forceinline__ void stage_conv(LAS bf16* dst, int ldst, const bf16* zp0, int s0, const float* cw, const float* cb, float scale, const LAS float* rowscale, int tid) {
    const int ch = tid % NCHK;
    float w[4][8], bias[8];
#pragma unroll
    for (int j = 0; j < 4; ++j) { const f32x4 a = *(const f32x4*)(cw + j * 1024 + 8 * ch), b = *(const f32x4*)(cw + j * 1024 + 8 * ch + 4);
        w[j][0] = a.x; w[j][1] = a.y; w[j][2] = a.z; w[j][3] = a.w; w[j][4] = b.x; w[j][5] = b.y; w[j][6] = b.z; w[j][7] = b.w; }
    { const f32x4 a = *(const f32x4*)(cb + 8 * ch), b = *(const f32x4*)(cb + 8 * ch + 4); bias[0] = a.x; bias[1] = a.y; bias[2] = a.z; bias[3] = a.w; bias[4] = b.x; bias[5] = b.y; bias[6] = b.z; bias[7] = b.w; }
    for (int it = tid; it < 128 * NCHK; it += NWAVES * 64) {
        const int l = it / NCHK, s = s0 + l;
        const bf16* zp = zp0 + (size_t)l * ZLD + 8 * ch;
        const v4u zero = {0u, 0u, 0u, 0u};
        const v4u x3 = *(const v4u*)zp, x2 = s >= 1 ? *(const v4u*)(zp - (ptrdiff_t)ZLD) : zero, x1 = s >= 2 ? *(const v4u*)(zp - (ptrdiff_t)2 * ZLD) : zero, x0 = s >= 3 ? *(const v4u*)(zp - (ptrdiff_t)3 * ZLD) : zero;
        const unsigned u3[4] = {x3.x, x3.y, x3.z, x3.w}, u2[4] = {x2.x, x2.y, x2.z, x2.w}, u1[4] = {x1.x, x1.y, x1.z, x1.w}, u0[4] = {x0.x, x0.y, x0.z, x0.w};
        const float sc = rowscale ? scale * rowscale[l] : scale;
        float o[8];
#pragma unroll
        for (int p = 0; p < 4; ++p) {
            const float a0 = bias[2 * p] + w[0][2 * p] * bflo(u0[p]) + w[1][2 * p] * bflo(u1[p]) + w[2][2 * p] * bflo(u2[p]) + w[3][2 * p] * bflo(u3[p]);
            const float a1 = bias[2 * p + 1] + w[0][2 * p + 1] * bfhi(u0[p]) + w[1][2 * p + 1] * bfhi(u1[p]) + w[2][2 * p + 1] * bfhi(u2[p]) + w[3][2 * p + 1] * bfhi(u3[p]);
            o[2 * p] = silu_fast(a0) * sc; o[2 * p + 1] = silu_fast(a1) * sc; }
        v4u wv; wv.x = cvtpk(o[0], o[1]); wv.y = cvtpk(o[2], o[3]); wv.z = cvtpk(o[4], o[5]); wv.w = cvtpk(o[6], o[7]);
        *(LAS v4u*)(dst + l * ldst + 8 * ch) = wv;
    }
}
template <int NCHK>
__device__ __forceinline__ void stage_copy(LAS bf16* dst, int ldst, const bf16* src, size_t src_ld, int tid) {
    for (int it = tid; it < 128 * NCHK; it += NWAVES * 64) { const int l = it / NCHK, ch = it % NCHK; *(LAS v4u*)(dst + l * ldst + 8 * ch) = *(const v4u*)(src + (size_t)l * src_ld + 8 * ch); }
}

constexpr int CST = 176;
constexpr int MA_TAB = 2 * 128 * CST * 2;
struct MaRegs { v4u k[4]; v4u v[4]; };
__device__ __forceinline__ void ma_load(MaRegs& R, int g, const bf16* zk, const bf16* zv, int c, int tid) {
    const int l = tid >> 2, q = tid & 3;
    if (g == 0) R.k[0] = *(const v4u*)(zk + (size_t)(c * CHUNK + l) * ZLD + (q >> 1) * 64 + (q & 1) * 8);
    else { const int s = c * CHUNK + l; const bf16* zp = zk + (size_t)s * ZLD + 8 * q; const v4u zero = {0u, 0u, 0u, 0u};
        R.k[3] = *(const v4u*)zp; R.k[2] = s >= 1 ? *(const v4u*)(zp - (ptrdiff_t)ZLD) : zero; R.k[1] = s >= 2 ? *(const v4u*)(zp - (ptrdiff_t)2 * ZLD) : zero; R.k[0] = s >= 3 ? *(const v4u*)(zp - (ptrdiff_t)3 * ZLD) : zero; }
#pragma unroll
    for (int i = 0; i < 4; ++i) { const int it = tid + 512 * i; R.v[i] = *(const v4u*)(zv + (size_t)(c * CHUNK + (it >> 4)) * ZLD + 8 * (it & 15)); }
}
__device__ __forceinline__ void ma_write(const MaRegs& R, int g, LAS bf16* comb, float rowsc, const float (&w)[4][8], const float (&bias)[8], int tid) {
    const int l = tid >> 2, q = tid & 3;
    v4u wv;
    if (g == 0) { const v4u a = R.k[0];
        wv.x = cvtpk(bflo(a.x) * rowsc, bfhi(a.x) * rowsc); wv.y = cvtpk(bflo(a.y) * rowsc, bfhi(a.y) * rowsc); wv.z = cvtpk(bflo(a.z) * rowsc, bfhi(a.z) * rowsc); wv.w = cvtpk(bflo(a.w) * rowsc, bfhi(a.w) * rowsc);
    } else {
        const unsigned u3[4] = {R.k[3].x, R.k[3].y, R.k[3].z, R.k[3].w}, u2[4] = {R.k[2].x, R.k[2].y, R.k[2].z, R.k[2].w}, u1[4] = {R.k[1].x, R.k[1].y, R.k[1].z, R.k[1].w}, u0[4] = {R.k[0].x, R.k[0].y, R.k[0].z, R.k[0].w};
        float o[8];
#pragma unroll
        for (int p = 0; p < 4; ++p) {
            const float a0 = bias[2 * p] + w[0][2 * p] * bflo(u0[p]) + w[1][2 * p] * bflo(u1[p]) + w[2][2 * p] * bflo(u2[p]) + w[3][2 * p] * bflo(u3[p]);
            const float a1 = bias[2 * p + 1] + w[0][2 * p + 1] * bfhi(u0[p]) + w[1][2 * p + 1] * bfhi(u1[p]) + w[2][2 * p + 1] * bfhi(u2[p]) + w[3][2 * p + 1] * bfhi(u3[p]);
            o[2 * p] = silu_fast(a0) * rowsc; o[2 * p + 1] = silu_fast(a1) * rowsc; }
        wv.x = cvtpk(o[0], o[1]); wv.y = cvtpk(o[2], o[3]); wv.z = cvtpk(o[4], o[5]); wv.w = cvtpk(o[6], o[7]);
    }
    *(LAS v4u*)(comb + l * CST + 8 * q) = wv;
#pragma unroll
    for (int i = 0; i < 4; ++i) { const int it = tid + 512 * i; *(LAS v4u*)(comb + (it >> 4) * CST + 32 + 8 * (it & 15)) = R.v[i]; }
}
__device__ __forceinline__ void ma_fast(LAS unsigned char* lds, const bf16* z, const float2* rope, const float* gates, const float* conv_w, const float* conv_b,
                                        bf16* states, float* nprev, float* mprev, int tid, int lane, int wave, int vcu, int G) {
    LAS float* gtab = (LAS float*)(lds + MA_TAB);
    LAS float* blt = gtab + 4096;
    LAS float* gmt = blt + 32;
    LAS float* wct = gmt + 32;
    LAS float* mnt = wct + 32;
    const int fr = lane & 15, hq = lane >> 4;
    for (int u = vcu; u < 256; u += G) {
        const int g = u >> 7, b = (u >> 4) & 7, h = (u >> 2) & 3, dq = u & 3;
        const bf16* zk = ZS(z, (g == 0 ? 4 : 20) + h, b * SEQ) + (g == 0 ? 16 * dq : 32 * dq);
        const bf16* zv = ZS(z, (g == 0 ? 8 : 24) + h, b * SEQ);
        MaRegs R0, R1;
        ma_load(R0, g, zk, zv, 0, tid); ma_load(R1, g, zk, zv, 1, tid);
        const unsigned long long tq5_ = (TPROBE == 5) ? TPX_NOW() : 0ull;
        float w[4][8], bias[8];
        { const int ch = tid & 3; const float* cw = conv_w + 512 + 128 * h + 32 * dq + 8 * ch; const float* cb = conv_b + 512 + 128 * h + 32 * dq + 8 * ch;
#pragma unroll
          for (int j = 0; j < 4; ++j)
#pragma unroll
              for (int e = 0; e < 8; ++e) w[j][e] = (g == 1) ? cw[j * 1024 + e] : 0.f;
#pragma unroll
          for (int e = 0; e < 8; ++e) bias[e] = (g == 1) ? cb[e] : 0.f; }
        __syncthreads();
        if (g == 0) { if (tid < 128) gtab[tid] = exp2f((float)(127 - tid) * lg2gamma(h)); }
        else {
            float gi[4][2], gf[4][2];
#pragma unroll
            for (int k = 0; k < 4; ++k) { const float* gp = gates + (size_t)(b * SEQ + (wave * 4 + k) * CHUNK + 2 * lane) * 8; gi[k][0] = gp[h]; gi[k][1] = gp[8 + h]; gf[k][0] = gp[4 + h]; gf[k][1] = gp[12 + h]; }
#pragma unroll
            for (int k = 0; k < 4; ++k) { const int cc = wave * 4 + k;
                const float ic0 = gi[k][0], ic1 = gi[k][1], lf0 = logsigmoid_acc(gf[k][0]), lf1 = logsigmoid_acc(gf[k][1]);
                const float s1 = lf0 + lf1; float v = s1;
#pragma unroll
                for (int off = 1; off < 64; off <<= 1) { const float t = __shfl_up(v, off); if (lane >= off) v += t; }
                const float ex = v - s1, bc0 = ex + lf0, bc1 = ex + s1;
                const float blast = __shfl(bc1, 63);
                const float g0 = blast - bc0 + ic0, g1 = blast - bc1 + ic1;
                gtab[cc * 128 + 2 * lane] = g0; gtab[cc * 128 + 2 * lane + 1] = g1;
                const float gmax = wave_max(fmaxf(g0, g1));
                if (lane == 0) { blt[cc] = blast; gmt[cc] = gmax; }
            }
            __syncthreads();
            if (tid == 0) { float m = 0.f;
                for (int cc = 0; cc < NCH; ++cc) { const float mn = fmaxf(blt[cc] + m, gmt[cc]); wct[cc] = expf(blt[cc] + m - mn); mnt[cc] = mn;
                    if (dq == 0) mprev[((size_t)b * NH + h) * NCH + cc] = m;
                    m = mn; } }
        }
        __syncthreads();
        if (TPROBE == 5) TPX_SPIN(tq5_, 3);
        const float wc_ret = exp2f(128.0f * lg2gamma(h));
        const int td = wave & 1, tp = wave >> 1;
        f32x4 acc0 = {0.f, 0.f, 0.f, 0.f}, acc1 = acc0, nacc = acc0;
        const int dglob = (g == 0) ? (td ? 64 + 16 * dq : 16 * dq) + 4 * hq : 32 * dq + 16 * td + 4 * hq;
        const unsigned tr_base = (unsigned)(4 * hq + (fr >> 2)) * (CST * 2) + (unsigned)(4 * (fr & 3)) * 2;
        bf16x8 ones; { const short o = (fr == 0) ? (short)0x3F80 : (short)0; ones = (bf16x8){o, o, o, o, o, o, o, o}; }
        const int lrow = tid >> 2;
#define MA_STEP(S_) do { \
                const s16x4 a_lo = tr_read<((32 * (S_)) * CST + 16 * 0) * 2>(cb_ + td * 32), a_hi = tr_read<((32 * (S_) + 16) * CST) * 2>(cb_ + td * 32); \
                const s16x4 b0_lo = tr_read<((32 * (S_)) * CST + 32) * 2>(cb_ + tp * 64), b0_hi = tr_read<((32 * (S_) + 16) * CST + 32) * 2>(cb_ + tp * 64); \
                const s16x4 b1_lo = tr_read<((32 * (S_)) * CST + 48) * 2>(cb_ + tp * 64), b1_hi = tr_read<((32 * (S_) + 16) * CST + 48) * 2>(cb_ + tp * 64); \
                TR_WAIT(); \
                const bf16x8 A = PK8(a_lo, a_hi); \
                acc0 = __builtin_amdgcn_mfma_f32_16x16x32_bf16(A, PK8(b0_lo, b0_hi), acc0, 0, 0, 0); \
                acc1 = __builtin_amdgcn_mfma_f32_16x16x32_bf16(A, PK8(b1_lo, b1_hi), acc1, 0, 0, 0); \
                if (g == 1 && tp == 0) nacc = __builtin_amdgcn_mfma_f32_16x16x32_bf16(A, ones, nacc, 0, 0, 0); } while (0)
#define MA_CHUNK(C_, R_) do { const int c = (C_); \
            const unsigned long long tq0_ = (TPROBE == 6) ? TPX_NOW() : 0ull; \
            const unsigned long long tq8_ = (TPROBE == 8) ? TPX_NOW() : 0ull; \
            LAS bf16* comb = (LAS bf16*)(lds + (c & 1) * (128 * CST * 2)); \
            const float rowsc = (g == 0) ? gtab[lrow] : __expf(gtab[c * 128 + lrow] - mnt[c]); \
            ma_write(R_, g, comb, rowsc, w, bias, tid); \
            if (TPROBE == 8) { asm volatile("s_waitcnt lgkmcnt(0)" ::: "memory"); TPX_SPIN(tq8_, 3); } \
            const unsigned long long tq9_ = (TPROBE == 9) ? TPX_NOW() : 0ull; \
            if (c + 2 < NCH) ma_load(R_, g, zk, zv, c + 2, tid); \
            { bf16* st = states + ((((size_t)g * BATCH + b) * NH + h) * NCH + c) * 16384 + dglob; \
              uint2 o0, o1; o0.x = cvtpk(acc0[0], acc0[1]); o0.y = cvtpk(acc0[2], acc0[3]); o1.x = cvtpk(acc1[0], acc1[1]); o1.y = cvtpk(acc1[2], acc1[3]); \
              *(uint2*)(st + (size_t)(32 * tp + fr) * 128) = o0; *(uint2*)(st + (size_t)(32 * tp + 16 + fr) * 128) = o1; \
              if (g == 1 && tp == 0 && fr == 0) *(f32x4*)(nprev + (((size_t)b * NH + h) * NCH + c) * 128 + dglob) = nacc; } \
            if (TPROBE == 9) TPX_SPIN(tq9_, 3); \
            __syncthreads(); \
            if (TPROBE == 6) TPX_SPIN(tq0_, 3); \
            const unsigned long long tq1_ = (TPROBE == 7) ? TPX_NOW() : 0ull; \
            const float wc = (g == 0) ? wc_ret : wct[c]; \
            acc0 *= wc; acc1 *= wc; nacc *= wc; \
            const unsigned cb_ = (unsigned)(size_t)comb + tr_base; \
            MA_STEP(0); MA_STEP(1); MA_STEP(2); MA_STEP(3); \
            if (TPROBE == 7) TPX_SPIN(tq1_, 3); } while (0)
        for (int c2 = 0; c2 < NCH; c2 += 2) { MA_CHUNK(c2, R0); MA_CHUNK(c2 + 1, R1); }
#undef MA_CHUNK
#undef MA_STEP
    }
}

constexpr int LST = 144;
constexpr int MX_Q = 0, MX_K = 128 * LST * 2, MX_V = 2 * MX_K, MX_S = 3 * MX_K, MX_TAB = 4 * MX_K;
__device__ __forceinline__ void mb_fast(LAS unsigned char* lds, const bf16* z, const float2* rope, const float* gates, const float* conv_w, const float* conv_b,
                                        const bf16* states, const float* nprev, const float* mprev, const float* g_ret, const float* g_ml, bf16* y,
                                        int tid, int lane, int wave, int vcu, int G) {
    LAS bf16* qs = (LAS bf16*)(lds + MX_Q); LAS bf16* ks = (LAS bf16*)(lds + MX_K); LAS bf16* vs = (LAS bf16*)(lds + MX_V); LAS bf16* ss = (LAS bf16*)(lds + MX_S);
    LAS float* bcs = (LAS float*)(lds + MX_TAB);
    LAS float* ams = bcs + 128;
    LAS float* mts = ams + 128;
    LAS float* nps = mts + 128;
    const int fr = lane & 15, hq = lane >> 4, l0 = 16 * wave;
    for (int u = vcu; u < 2 * BATCH * NH * NCH; u += G) {
        const int g = u >> 10, b = (u >> 7) & 7, h = (u >> 5) & 3, c = u & 31;
        const int row0 = b * SEQ + c * CHUNK;
        __syncthreads();
#ifndef MB_STAGE_REP
#define MB_STAGE_REP 1
#endif
#ifndef MB_COMP_REP
#define MB_COMP_REP 1
#endif
        for (int srep_ = 0; srep_ < MB_STAGE_REP; ++srep_) { if (srep_) __syncthreads();
        if (g == 0) {
            stage_copy<16>(qs, LST, ZS(z, h, row0), ZLD, tid);
            stage_copy<16>(ks, LST, ZS(z, 4 + h, row0), ZLD, tid);
        } else {
            stage_conv<16>(qs, LST, ZS(z, 16 + h, row0), c * CHUNK, conv_w + 128 * h, conv_b + 128 * h, QK_SCALE, nullptr, tid);
            stage_conv<16>(ks, LST, ZS(z, 20 + h, row0), c * CHUNK, conv_w + 512 + 128 * h, conv_b + 512 + 128 * h, 1.0f, nullptr, tid);
            if (wave == 0) {
                float bc0, bc1, ic0, ic1; ml_gate_scan(gates, row0, h, lane, bc0, bc1, ic0, ic1);
                const float a0 = ic0 - bc0, a1 = ic1 - bc1; const float c1 = fmaxf(a0, a1); float v = c1;
#pragma unroll
                for (int off = 1; off < 64; off <<= 1) { const float t = __shfl_up(v, off); if (lane >= off) v = fmaxf(v, t); }
                float ex = __shfl_up(v, 1); if (lane == 0) ex = -INFINITY;
                const float mp = mprev[((size_t)b * NH + h) * NCH + c];
                const float mt0 = bc0 + fmaxf(fmaxf(ex, a0), mp), mt1 = bc1 + fmaxf(fmaxf(ex, c1), mp);
                bcs[2 * lane] = bc0; bcs[2 * lane + 1] = bc1; ams[2 * lane] = a0; ams[2 * lane + 1] = a1; mts[2 * lane] = mt0; mts[2 * lane + 1] = mt1;
            }
            if (tid >= 64 && tid < 192) nps[tid - 64] = nprev[(((size_t)b * NH + h) * NCH + c) * 128 + (tid - 64)];
        }
        stage_copy<16>(vs, LST, ZS(z, (g == 0 ? 8 : 24) + h, row0), ZLD, tid);
        stage_copy<16>(ss, LST, states + ((((size_t)g * BATCH + b) * NH + h) * NCH + c) * 16384, 128, tid);
        }
        __syncthreads();
        for (int crep_ = 0; crep_ < MB_COMP_REP; ++crep_) {
        const int l = l0 + fr;
        float rowf, mt = 0.f, bl_mt = 0.f;
        if (g == 0) rowf = exp2f((float)(l + 1) * lg2gamma(h));
        else { const float mp = mprev[((size_t)b * NH + h) * NCH + c]; const float bl = bcs[l]; mt = mts[l]; rowf = __expf(bl + mp - mt); bl_mt = bl - mt; }
        bf16x8 qf[4];
#pragma unroll
        for (int s = 0; s < 4; ++s) qf[s] = *(const LAS bf16x8*)(qs + l * LST + 32 * s + 8 * hq);
        f32x4 acc[8];
#pragma unroll
        for (int te = 0; te < 8; ++te) { acc[te] = (f32x4){0.f, 0.f, 0.f, 0.f};
#pragma unroll
            for (int s = 0; s < 4; ++s) { const bf16x8 a = *(const LAS bf16x8*)(ss + (16 * te + fr) * LST + 32 * s + 8 * hq); acc[te] = __builtin_amdgcn_mfma_f32_16x16x32_bf16(a, qf[s], acc[te], 0, 0, 0); }
            acc[te] *= rowf; }
        float qn = 0.f;
        if (g == 1) {
#pragma unroll
            for (int s = 0; s < 4; ++s) { const f32x4 n0 = *(const LAS f32x4*)(nps + 32 * s + 8 * hq), n1 = *(const LAS f32x4*)(nps + 32 * s + 8 * hq + 4);
                qn += bf2f((unsigned short)qf[s][0]) * n0.x + bf2f((unsigned short)qf[s][1]) * n0.y + bf2f((unsigned short)qf[s][2]) * n0.z + bf2f((unsigned short)qf[s][3]) * n0.w
                    + bf2f((unsigned short)qf[s][4]) * n1.x + bf2f((unsigned short)qf[s][5]) * n1.y + bf2f((unsigned short)qf[s][6]) * n1.z + bf2f((unsigned short)qf[s][7]) * n1.w; }
            qn += __shfl_xor(qn, 16); qn += __shfl_xor(qn, 32);
        }
        unsigned pk[8][2];
        float psum = 0.f;
        const float lg = lg2gamma(h);
#pragma unroll
        for (int t = 0; t < 8; ++t) {
            if (t <= wave) {
                f32x4 p = {0.f, 0.f, 0.f, 0.f};
#pragma unroll
                for (int s = 0; s < 4; ++s) { const bf16x8 a = *(const LAS bf16x8*)(ks + (16 * t + fr) * LST + 32 * s + 8 * hq); p = __builtin_amdgcn_mfma_f32_16x16x32_bf16(a, qf[s], p, 0, 0, 0); }
                const int m0 = 16 * t + 4 * hq;
                f32x4 w;
                if (g == 0) {
#pragma unroll
                    for (int r = 0; r < 4; ++r) w[r] = exp2f((float)(l - m0 - r) * lg);
                } else { const f32x4 am = *(const LAS f32x4*)(ams + m0);
#pragma unroll
                    for (int r = 0; r < 4; ++r) w[r] = exp2f((bl_mt + am[r]) * LOG2E); }
#pragma unroll
                for (int r = 0; r < 4; ++r) { const float pv = (m0 + r <= l) ? p[r] * w[r] : 0.f; p[r] = pv; psum += pv; }
                pk[t][0] = cvtpk(p[0], p[1]); pk[t][1] = cvtpk(p[2], p[3]);
            } else { pk[t][0] = 0u; pk[t][1] = 0u; }
        }
        const unsigned vb = (unsigned)(size_t)vs + (unsigned)(4 * hq + (fr >> 2)) * (LST * 2) + (unsigned)(4 * (fr & 3)) * 2;
#define MB_PV(SP_) do { if (2 * (SP_) <= wave) { \
            const bf16x8 pf = __builtin_bit_cast(bf16x8, (v4u){pk[2 * (SP_)][0], pk[2 * (SP_)][1], pk[2 * (SP_) + 1][0], pk[2 * (SP_) + 1][1]}); \
            s16x4 lo[8], hi[8]; \
            lo[0] = tr_read<((32 * (SP_)) * LST + 0) * 2>(vb);  hi[0] = tr_read<((32 * (SP_) + 16) * LST + 0) * 2>(vb); \
            lo[1] = tr_read<((32 * (SP_)) * LST + 16) * 2>(vb); hi[1] = tr_read<((32 * (SP_) + 16) * LST + 16) * 2>(vb); \
            lo[2] = tr_read<((32 * (SP_)) * LST + 32) * 2>(vb); hi[2] = tr_read<((32 * (SP_) + 16) * LST + 32) * 2>(vb); \
            lo[3] = tr_read<((32 * (SP_)) * LST + 48) * 2>(vb); hi[3] = tr_read<((32 * (SP_) + 16) * LST + 48) * 2>(vb); \
            lo[4] = tr_read<((32 * (SP_)) * LST + 64) * 2>(vb); hi[4] = tr_read<((32 * (SP_) + 16) * LST + 64) * 2>(vb); \
            lo[5] = tr_read<((32 * (SP_)) * LST + 80) * 2>(vb); hi[5] = tr_read<((32 * (SP_) + 16) * LST + 80) * 2>(vb); \
            lo[6] = tr_read<((32 * (SP_)) * LST + 96) * 2>(vb); hi[6] = tr_read<((32 * (SP_) + 16) * LST + 96) * 2>(vb); \
            lo[7] = tr_read<((32 * (SP_)) * LST + 112) * 2>(vb); hi[7] = tr_read<((32 * (SP_) + 16) * LST + 112) * 2>(vb); \
            TR_WAIT(); \
            _Pragma("unroll") for (int te = 0; te < 8; ++te) acc[te] = __builtin_amdgcn_mfma_f32_16x16x32_bf16(PK8(lo[te], hi[te]), pf, acc[te], 0, 0, 0); } } while (0)
        MB_PV(0); MB_PV(1); MB_PV(2); MB_PV(3);
#undef MB_PV
        const int row = row0 + l;
        if (g == 1) {
            psum += __shfl_xor(psum, 16); psum += __shfl_xor(psum, 32);
            const float den = psum + rowf * qn; const float inv = 1.0f / fmaxf(fabsf(den), __expf(-mt));
            const bf16* zo = ZS(z, 28 + h, row) + 4 * hq;
#pragma unroll
            for (int te = 0; te < 8; ++te) { const uint2 gz = *(const uint2*)(zo + 16 * te);
                acc[te][0] *= inv * sigmoid_fast(bflo(gz.x)); acc[te][1] *= inv * sigmoid_fast(bfhi(gz.x)); acc[te][2] *= inv * sigmoid_fast(bflo(gz.y)); acc[te][3] *= inv * sigmoid_fast(bfhi(gz.y)); }
        }
        float s1 = 0.f;
#pragma unroll
        for (int te = 0; te < 8; ++te) s1 += (acc[te][0] + acc[te][1]) + (acc[te][2] + acc[te][3]);
        s1 += __shfl_xor(s1, 16); s1 += __shfl_xor(s1, 32);
        const float mu = s1 * (1.0f / 128.0f); float s2 = 0.f;
#pragma unroll
        for (int te = 0; te < 8; ++te) { const f32x4 dl = acc[te] - mu; s2 += (dl[0] * dl[0] + dl[1] * dl[1]) + (dl[2] * dl[2] + dl[3] * dl[3]); }
        s2 += __shfl_xor(s2, 16); s2 += __shfl_xor(s2, 32);
        const float rs = 1.0f / sqrtf(s2 * (1.0f / 128.0f) + EPS);
        const float* gn = (g == 0 ? g_ret : g_ml) + 128 * h + 4 * hq;
        const bf16* zg = ZS(z, 12 + h, row) + 4 * hq;
        bf16* yo = y + (size_t)row * D + g * 512 + 128 * h + 4 * hq;
#pragma unroll
        for (int te = 0; te < 8; ++te) { const f32x4 gv = *(const f32x4*)(gn + 16 * te); f32x4 o = (acc[te] - mu) * rs * gv;
            if (g == 0) { const uint2 gz = *(const uint2*)(zg + 16 * te); o[0] *= silu_fast(bflo(gz.x)); o[1] *= silu_fast(bfhi(gz.x)); o[2] *= silu_fast(bflo(gz.y)); o[3] *= silu_fast(bfhi(gz.y)); }
            uint2 w; w.x = cvtpk(o[0], o[1]); w.y = cvtpk(o[2], o[3]); *(uint2*)(yo + 16 * te) = w; }
        }
    }
}


constexpr int MB_CW = MX_TAB + 2048 + 64;
constexpr int MB_GN = MB_CW + 5120;
struct MbRegs { v4u a[11]; v4u v[4]; v4u s[4]; float gsc[5]; float np; };
#define GLD16(base, voff, coff) (*(const v4u*)((const char*)(base) + (coff) + (size_t)(unsigned)(voff)))
template <int PART  , int g>
__device__ __forceinline__ void mb_load(MbRegs& R, int b, int h, int c, const bf16* z, const bf16* states, const float* gates, const float* nprev, const float* mprev, int tid) {
    const int row0 = b * SEQ + c * CHUNK;
    const unsigned off0 = (unsigned)((tid >> 4) * 256 + (tid & 15) * 16);
    if (PART == 0) {
        if (g == 0) { const bf16* zq = ZS(z, h, row0); const bf16* zk = ZS(z, 4 + h, row0);
#pragma unroll
            for (int i = 0; i < 4; ++i) { R.a[i] = GLD16(zq, off0, i * 8192); R.a[4 + i] = GLD16(zk, off0, i * 8192); }
        } else {
            const int mat = tid >> 8, tt = tid & 255, rg = tt >> 4, ch = tt & 15; const int s0 = c * CHUNK + 8 * rg - 3;
            const bf16* zb = ZS(z, 16 + h, row0 - 3);
            const unsigned off = (unsigned)mat * (4u * M * ZLD * 2u) + (unsigned)(rg * 2048 + ch * 16);
            const v4u zero = {0u, 0u, 0u, 0u};
#pragma unroll
            for (int j = 0; j < 11; ++j) R.a[j] = (s0 + j >= 0) ? GLD16(zb, off, j * 256) : zero;
        }
    } else {
        if (g == 1) {
            if (tid < 64) { const float* gp = gates + (size_t)(row0 + 2 * tid) * 8; R.gsc[0] = gp[h]; R.gsc[1] = gp[8 + h]; R.gsc[2] = gp[4 + h]; R.gsc[3] = gp[12 + h]; R.gsc[4] = mprev[((size_t)b * NH + h) * NCH + c]; }
            if (tid >= 64 && tid < 192) R.np = nprev[(((size_t)b * NH + h) * NCH + c) * 128 + (tid - 64)];
        }
        const bf16* zv = ZS(z, (g == 0 ? 8 : 24) + h, row0); const bf16* st = states + ((((size_t)g * BATCH + b) * NH + h) * NCH + c) * 16384;
#pragma unroll
        for (int i = 0; i < 4; ++i) { R.v[i] = GLD16(zv, off0, i * 8192); R.s[i] = GLD16(st, off0, i * 8192); }
    }
}
template <int g>
__device__ __forceinline__ void mb_write(const MbRegs& R, LAS unsigned char* lds, int tid, int lane) {
    LAS bf16* qs = (LAS bf16*)(lds + MX_Q); LAS bf16* ks = (LAS bf16*)(lds + MX_K); LAS bf16* vs = (LAS bf16*)(lds + MX_V); LAS bf16* ss = (LAS bf16*)(lds + MX_S);
    if (g == 0) {
#pragma unroll
        for (int i = 0; i < 4; ++i) { const int it = tid + 512 * i; *(LAS v4u*)(qs + (it >> 4) * LST + 8 * (it & 15)) = R.a[i]; *(LAS v4u*)(ks + (it >> 4) * LST + 8 * (it & 15)) = R.a[4 + i]; }
    } else {
        const int mat = tid >> 8, tt = tid & 255, rg = tt >> 4, ch = tt & 15;
        const LAS float* cw = (const LAS float*)(lds + MB_CW) + mat * 640 + 8 * ch;
        float w[5][8];
#pragma unroll
        for (int j = 0; j < 5; ++j) { const f32x4 x0 = *(const LAS f32x4*)(cw + 128 * j), x1 = *(const LAS f32x4*)(cw + 128 * j + 4);
            w[j][0] = x0.x; w[j][1] = x0.y; w[j][2] = x0.z; w[j][3] = x0.w; w[j][4] = x1.x; w[j][5] = x1.y; w[j][6] = x1.z; w[j][7] = x1.w; }
        const float sc = mat == 0 ? QK_SCALE : 1.0f;
        LAS bf16* dst = (mat == 0 ? qs : ks) + (8 * rg) * LST + 8 * ch;
#pragma unroll
        for (int r = 0; r < 8; ++r) {
            const unsigned u0[4] = {R.a[r].x, R.a[r].y, R.a[r].z, R.a[r].w}, u1[4] = {R.a[r + 1].x, R.a[r + 1].y, R.a[r + 1].z, R.a[r + 1].w}, u2[4] = {R.a[r + 2].x, R.a[r + 2].y, R.a[r + 2].z, R.a[r + 2].w}, u3[4] = {R.a[r + 3].x, R.a[r + 3].y, R.a[r + 3].z, R.a[r + 3].w};
            float o[8];
#pragma unroll
            for (int p = 0; p < 4; ++p) {
                const float a0 = w[4][2 * p] + w[0][2 * p] * bflo(u0[p]) + w[1][2 * p] * bflo(u1[p]) + w[2][2 * p] * bflo(u2[p]) + w[3][2 * p] * bflo(u3[p]);
                const float a1 = w[4][2 * p + 1] + w[0][2 * p + 1] * bfhi(u0[p]) + w[1][2 * p + 1] * bfhi(u1[p]) + w[2][2 * p + 1] * bfhi(u2[p]) + w[3][2 * p + 1] * bfhi(u3[p]);
                o[2 * p] = silu_fast(a0) * sc; o[2 * p + 1] = silu_fast(a1) * sc; }
            v4u wv; wv.x = cvtpk(o[0], o[1]); wv.y = cvtpk(o[2], o[3]); wv.z = cvtpk(o[4], o[5]); wv.w = cvtpk(o[6], o[7]);
            *(LAS v4u*)(dst + r * LST) = wv;
        }
        LAS float* bcs = (LAS float*)(lds + MX_TAB); LAS float* ams = bcs + 128; LAS float* mts = ams + 128; LAS float* nps = mts + 128;
        if (tid < 64) {
            const float ic0 = R.gsc[0], ic1 = R.gsc[1], lf0 = logsigmoid_acc(R.gsc[2]), lf1 = logsigmoid_acc(R.gsc[3]), mp = R.gsc[4];
            const float s1 = lf0 + lf1; float v = s1;
#pragma unroll
            for (int off = 1; off < 64; off <<= 1) { const float t = __shfl_up(v, off); if (lane >= off) v += t; }
            const float ex0 = v - s1, bc0 = ex0 + lf0, bc1 = ex0 + s1;
            const float a0 = ic0 - bc0, a1 = ic1 - bc1; const float c1 = fmaxf(a0, a1); float vm = c1;
#pragma unroll
            for (int off = 1; off < 64; off <<= 1) { const float t = __shfl_up(vm, off); if (lane >= off) vm = fmaxf(vm, t); }
            float ex = __shfl_up(vm, 1); if (lane == 0) ex = -INFINITY;
            const float mt0 = bc0 + fmaxf(fmaxf(ex, a0), mp), mt1 = bc1 + fmaxf(fmaxf(ex, c1), mp);
            bcs[2 * lane] = bc0; bcs[2 * lane + 1] = bc1; ams[2 * lane] = a0; ams[2 * lane + 1] = a1; mts[2 * lane] = mt0; mts[2 * lane + 1] = mt1;
            if (lane == 0) nps[128] = mp;
        }
        if (tid >= 64 && tid < 192) nps[tid - 64] = R.np;
    }
#pragma unroll
    for (int i = 0; i < 4; ++i) { const int it = tid + 512 * i; *(LAS v4u*)(vs + (it >> 4) * LST + 8 * (it & 15)) = R.v[i]; *(LAS v4u*)(ss + (it >> 4) * LST + 8 * (it & 15)) = R.s[i]; }
}
template <int g>
__device__ __forceinline__ void mb_group(LAS unsigned char* lds, const bf16* z, const float* gates, const bf16* states, const float* nprev, const float* mprev, bf16* y, int h, int c, int bb, int tid, int lane, int wave) {
    LAS bf16* qs = (LAS bf16*)(lds + MX_Q); LAS bf16* ks = (LAS bf16*)(lds + MX_K); LAS bf16* vs = (LAS bf16*)(lds + MX_V); LAS bf16* ss = (LAS bf16*)(lds + MX_S);
    LAS float* bcs = (LAS float*)(lds + MX_TAB); LAS float* ams = bcs + 128; LAS float* mts = ams + 128; LAS float* nps = mts + 128;
    const int l0 = 16 * wave;
    MbRegs R;
    mb_load<0, g>(R, bb, h, c, z, states, gates, nprev, mprev, tid); mb_load<1, g>(R, bb, h, c, z, states, gates, nprev, mprev, tid);
    for (int i = 0; i < 4; ++i) {
        const int b = bb + 2 * i;
        const int row0 = b * SEQ + c * CHUNK;
#if TPROBE == 1
        TP_BEGIN();
#endif
        __syncthreads();
        mb_write<g>(R, lds, tid, lane);
        if (i + 1 < 4) { mb_load<1, g>(R, bb + 2 * (i + 1), h, c, z, states, gates, nprev, mprev, tid); mb_load<0, g>(R, bb + 2 * (i + 1), h, c, z, states, gates, nprev, mprev, tid); }
        __syncthreads();
#if TPROBE == 1
        TP_SPIN(3);
#endif
#if TPROBE == 3
        { const unsigned long long e3_ = __builtin_amdgcn_s_memtime() + 10000ull + 3000ull * (unsigned long long)wave; while (__builtin_amdgcn_s_memtime() < e3_) __builtin_amdgcn_s_sleep(2); }
#endif
#if TPROBE == 2
        TP_BEGIN();
#endif
        int lane_l = lane; asm volatile("" : "+v"(lane_l)); const int fr = lane_l & 15, hq = lane_l >> 4;
        int l = l0 + fr; asm volatile("" : "+v"(l));
        const int row = row0 + l;
        float rowf, mt = 0.f, bl_mt = 0.f;
        if (g == 0) rowf = __builtin_amdgcn_exp2f((float)(l + 1) * lg2gamma(h));
        else { const float mp = nps[128]; const float bl = bcs[l]; mt = mts[l]; rowf = __expf(bl + mp - mt); bl_mt = bl - mt; }
        const unsigned lb = (unsigned)(fr * (LST * 2) + hq * 16);
        const unsigned qa = (unsigned)(size_t)qs + (unsigned)(l0 * (LST * 2)) + lb, sa = (unsigned)(size_t)ss + lb, ka = (unsigned)(size_t)ks + lb;
        bf16x8 qf[4];
        qf[0] = lds_rd16<0>(qa); qf[1] = lds_rd16<64>(qa); qf[2] = lds_rd16<128>(qa); qf[3] = lds_rd16<192>(qa);
        f32x4 acc[8];
#define MB_INTER(TP_) do { \
            const bf16x8 a0 = lds_rd16<(2 * (TP_)) * 16 * LST * 2 + 0>(sa), a1 = lds_rd16<(2 * (TP_)) * 16 * LST * 2 + 64>(sa), a2 = lds_rd16<(2 * (TP_)) * 16 * LST * 2 + 128>(sa), a3 = lds_rd16<(2 * (TP_)) * 16 * LST * 2 + 192>(sa); \
            const bf16x8 b0 = lds_rd16<(2 * (TP_) + 1) * 16 * LST * 2 + 0>(sa), b1 = lds_rd16<(2 * (TP_) + 1) * 16 * LST * 2 + 64>(sa), b2 = lds_rd16<(2 * (TP_) + 1) * 16 * LST * 2 + 128>(sa), b3 = lds_rd16<(2 * (TP_) + 1) * 16 * LST * 2 + 192>(sa); \
            TR_WAIT(); \
            f32x4 x = {0.f, 0.f, 0.f, 0.f}, y = x; \
            x = __builtin_amdgcn_mfma_f32_16x16x32_bf16(a0, qf[0], x, 0, 0, 0); y = __builtin_amdgcn_mfma_f32_16x16x32_bf16(b0, qf[0], y, 0, 0, 0); \
            x = __builtin_amdgcn_mfma_f32_16x16x32_bf16(a1, qf[1], x, 0, 0, 0); y = __builtin_amdgcn_mfma_f32_16x16x32_bf16(b1, qf[1], y, 0, 0, 0); \
            x = __builtin_amdgcn_mfma_f32_16x16x32_bf16(a2, qf[2], x, 0, 0, 0); y = __builtin_amdgcn_mfma_f32_16x16x32_bf16(b2, qf[2], y, 0, 0, 0); \
            x = __builtin_amdgcn_mfma_f32_16x16x32_bf16(a3, qf[3], x, 0, 0, 0); y = __builtin_amdgcn_mfma_f32_16x16x32_bf16(b3, qf[3], y, 0, 0, 0); \
            acc[2 * (TP_)] = x * rowf; acc[2 * (TP_) + 1] = y * rowf; } while (0)
        MB_INTER(0); MB_INTER(1); MB_INTER(2); MB_INTER(3);
#undef MB_INTER
        float qn = 0.f;
        if (g == 1) {
#pragma unroll
            for (int s = 0; s < 4; ++s) { const f32x4 n0 = *(const LAS f32x4*)(nps + 32 * s + 8 * hq), n1 = *(const LAS f32x4*)(nps + 32 * s + 8 * hq + 4);
                qn += bf2f((unsigned short)qf[s][0]) * n0.x + bf2f((unsigned short)qf[s][1]) * n0.y + bf2f((unsigned short)qf[s][2]) * n0.z + bf2f((unsigned short)qf[s][3]) * n0.w
                    + bf2f((unsigned short)qf[s][4]) * n1.x + bf2f((unsigned short)qf[s][5]) * n1.y + bf2f((unsigned short)qf[s][6]) * n1.z + bf2f((unsigned short)qf[s][7]) * n1.w; }
            qn += __shfl_xor(qn, 16); qn += __shfl_xor(qn, 32);
        }
        unsigned pk[8][2];
        float psum = 0.f;
        const float lg = lg2gamma(h);
#define MB_WGT(T_, P_) do { const int m0 = 16 * (T_) + 4 * hq; f32x4 w; \
            if (g == 0) { _Pragma("unroll") for (int r = 0; r < 4; ++r) w[r] = __builtin_amdgcn_exp2f((float)(l - m0 - r) * lg); } \
            else { const f32x4 am = *(const LAS f32x4*)(ams + m0); _Pragma("unroll") for (int r = 0; r < 4; ++r) w[r] = __builtin_amdgcn_exp2f((bl_mt + am[r]) * LOG2E); } \
            _Pragma("unroll") for (int r = 0; r < 4; ++r) { const float pv = (m0 + r <= l) ? P_[r] * w[r] : 0.f; P_[r] = pv; psum += pv; } \
            pk[T_][0] = cvtpk(P_[0], P_[1]); pk[T_][1] = cvtpk(P_[2], P_[3]); } while (0)
#define MB_ST(TP_) do { if (2 * (TP_) <= wave) { \
            const bf16x8 a0 = lds_rd16<(2 * (TP_)) * 16 * LST * 2 + 0>(ka), a1 = lds_rd16<(2 * (TP_)) * 16 * LST * 2 + 64>(ka), a2 = lds_rd16<(2 * (TP_)) * 16 * LST * 2 + 128>(ka), a3 = lds_rd16<(2 * (TP_)) * 16 * LST * 2 + 192>(ka); \
            const bf16x8 b0 = lds_rd16<(2 * (TP_) + 1) * 16 * LST * 2 + 0>(ka), b1 = lds_rd16<(2 * (TP_) + 1) * 16 * LST * 2 + 64>(ka), b2 = lds_rd16<(2 * (TP_) + 1) * 16 * LST * 2 + 128>(ka), b3 = lds_rd16<(2 * (TP_) + 1) * 16 * LST * 2 + 192>(ka); \
            TR_WAIT(); \
            f32x4 x = {0.f, 0.f, 0.f, 0.f}, y = x; \
            x = __builtin_amdgcn_mfma_f32_16x16x32_bf16(a0, qf[0], x, 0, 0, 0); y = __builtin_amdgcn_mfma_f32_16x16x32_bf16(b0, qf[0], y, 0, 0, 0); \
            x = __builtin_amdgcn_mfma_f32_16x16x32_bf16(a1, qf[1], x, 0, 0, 0); y = __builtin_amdgcn_mfma_f32_16x16x32_bf16(b1, qf[1], y, 0, 0, 0); \
            x = __builtin_amdgcn_mfma_f32_16x16x32_bf16(a2, qf[2], x, 0, 0, 0); y = __builtin_amdgcn_mfma_f32_16x16x32_bf16(b2, qf[2], y, 0, 0, 0); \
            x = __builtin_amdgcn_mfma_f32_16x16x32_bf16(a3, qf[3], x, 0, 0, 0); y = __builtin_amdgcn_mfma_f32_16x16x32_bf16(b3, qf[3], y, 0, 0, 0); \
            MB_WGT(2 * (TP_), x); \
            if (2 * (TP_) + 1 <= wave) MB_WGT(2 * (TP_) + 1, y); else { pk[2 * (TP_) + 1][0] = 0u; pk[2 * (TP_) + 1][1] = 0u; } \
        } else { pk[2 * (TP_)][0] = 0u; pk[2 * (TP_)][1] = 0u; pk[2 * (TP_) + 1][0] = 0u; pk[2 * (TP_) + 1][1] = 0u; } } while (0)
        MB_ST(0); MB_ST(1); MB_ST(2); MB_ST(3);
#undef MB_ST
#undef MB_WGT
        const unsigned vb = (unsigned)(size_t)vs + (unsigned)(4 * hq + (fr >> 2)) * (LST * 2) + (unsigned)(4 * (fr & 3)) * 2;
#define MB_PV(SP_) do { if (2 * (SP_) <= wave) { \
            const bf16x8 pf = __builtin_bit_cast(bf16x8, (v4u){pk[2 * (SP_)][0], pk[2 * (SP_)][1], pk[2 * (SP_) + 1][0], pk[2 * (SP_) + 1][1]}); \
            { s16x4 lo[4], hi[4]; \
            lo[0] = tr_read<((32 * (SP_)) * LST + 0) * 2>(vb);  hi[0] = tr_read<((32 * (SP_) + 16) * LST + 0) * 2>(vb); \
            lo[1] = tr_read<((32 * (SP_)) * LST + 16) * 2>(vb); hi[1] = tr_read<((32 * (SP_) + 16) * LST + 16) * 2>(vb); \
            lo[2] = tr_read<((32 * (SP_)) * LST + 32) * 2>(vb); hi[2] = tr_read<((32 * (SP_) + 16) * LST + 32) * 2>(vb); \
            lo[3] = tr_read<((32 * (SP_)) * LST + 48) * 2>(vb); hi[3] = tr_read<((32 * (SP_) + 16) * LST + 48) * 2>(vb); \
            TR_WAIT(); \
            _Pragma("unroll") for (int te = 0; te < 4; ++te) acc[te] = __builtin_amdgcn_mfma_f32_16x16x32_bf16(PK8(lo[te], hi[te]), pf, acc[te], 0, 0, 0); } \
            { s16x4 lo[4], hi[4]; \
            lo[0] = tr_read<((32 * (SP_)) * LST + 64) * 2>(vb); hi[0] = tr_read<((32 * (SP_) + 16) * LST + 64) * 2>(vb); \
            lo[1] = tr_read<((32 * (SP_)) * LST + 80) * 2>(vb); hi[1] = tr_read<((32 * (SP_) + 16) * LST + 80) * 2>(vb); \
            lo[2] = tr_read<((32 * (SP_)) * LST + 96) * 2>(vb); hi[2] = tr_read<((32 * (SP_) + 16) * LST + 96) * 2>(vb); \
            lo[3] = tr_read<((32 * (SP_)) * LST + 112) * 2>(vb); hi[3] = tr_read<((32 * (SP_) + 16) * LST + 112) * 2>(vb); \
            TR_WAIT(); \
            _Pragma("unroll") for (int te = 0; te < 4; ++te) acc[4 + te] = __builtin_amdgcn_mfma_f32_16x16x32_bf16(PK8(lo[te], hi[te]), pf, acc[4 + te], 0, 0, 0); } } } while (0)
        MB_PV(0); MB_PV(1); MB_PV(2); MB_PV(3);
#undef MB_PV
        uint2 gz[8];
        const unsigned wide_off = (hq & 1) ? 24u : 0u;
        { const bf16* zgp = ZS(z, (g == 0 ? 12 : 28) + h, row0); const unsigned go = (unsigned)(l * 256 + hq * 8) + wide_off;
#pragma unroll
          for (int tp = 0; tp < 4; ++tp) { const v4u L = *(const v4u*)((const char*)zgp + 64 * tp + (size_t)go);
              const auto r0 = __builtin_amdgcn_permlane16_swap(L.x, L.z, false, false); const auto r1 = __builtin_amdgcn_permlane16_swap(L.y, L.w, false, false);
              gz[2 * tp].x = r0[0]; gz[2 * tp + 1].x = r0[1]; gz[2 * tp].y = r1[0]; gz[2 * tp + 1].y = r1[1]; } }
        if (g == 1) {
            psum += __shfl_xor(psum, 16); psum += __shfl_xor(psum, 32);
            const float den = psum + rowf * qn; const float inv = __builtin_amdgcn_rcpf(fmaxf(fabsf(den), __expf(-mt)));
#pragma unroll
            for (int te = 0; te < 8; ++te) { acc[te][0] *= inv * sigmoid_fast(bflo(gz[te].x)); acc[te][1] *= inv * sigmoid_fast(bfhi(gz[te].x)); acc[te][2] *= inv * sigmoid_fast(bflo(gz[te].y)); acc[te][3] *= inv * sigmoid_fast(bfhi(gz[te].y)); }
        }
        float s1 = 0.f;
#pragma unroll
        for (int te = 0; te < 8; ++te) s1 += (acc[te][0] + acc[te][1]) + (acc[te][2] + acc[te][3]);
        s1 += __shfl_xor(s1, 16); s1 += __shfl_xor(s1, 32);
        const float mu = s1 * (1.0f / 128.0f); float s2 = 0.f;
#pragma unroll
        for (int te = 0; te < 8; ++te) { const f32x4 dl = acc[te] - mu; s2 += (dl[0] * dl[0] + dl[1] * dl[1]) + (dl[2] * dl[2] + dl[3] * dl[3]); }
        s2 += __shfl_xor(s2, 16); s2 += __shfl_xor(s2, 32);
        const float rs = __builtin_amdgcn_rsqf(s2 * (1.0f / 128.0f) + EPS);
        const LAS float* gn = (const LAS float*)(lds + MB_GN) + g * 128 + 4 * hq;
        bf16* yb = y + (size_t)row0 * D + g * 512 + 128 * h; const unsigned yoff = (unsigned)(l * 2048 + hq * 8) + wide_off;
#pragma unroll
        for (int tp = 0; tp < 4; ++tp) { uint2 wv[2];
#pragma unroll
            for (int k = 0; k < 2; ++k) { const int te = 2 * tp + k; const f32x4 gv = *(const LAS f32x4*)(gn + 16 * te); f32x4 o = (acc[te] - mu) * rs * gv;
                if (g == 0) { o[0] *= silu_fast(bflo(gz[te].x)); o[1] *= silu_fast(bfhi(gz[te].x)); o[2] *= silu_fast(bflo(gz[te].y)); o[3] *= silu_fast(bfhi(gz[te].y)); }
                wv[k].x = cvtpk(o[0], o[1]); wv[k].y = cvtpk(o[2], o[3]); }
            const auto r0 = __builtin_amdgcn_permlane16_swap(wv[0].x, wv[1].x, false, false); const auto r1 = __builtin_amdgcn_permlane16_swap(wv[0].y, wv[1].y, false, false);
            v4u W; W.x = r0[0]; W.y = r1[0]; W.z = r0[1]; W.w = r1[1];
            *(v4u*)((char*)yb + 64 * tp + (size_t)yoff) = W; }
#if TPROBE == 2
        TP_SPIN(3);
#endif
    }
}
__device__ __forceinline__ void mb_fast2(LAS unsigned char* lds, const bf16* z, const float2* rope, const float* gates, const float* conv_w, const float* conv_b,
                                         const bf16* states, const float* nprev, const float* mprev, const float* g_ret, const float* g_ml, bf16* y,
                                         int tid, int lane, int wave, int vcu, int G) {
    if (G != 256) return;
    const int h = (vcu >> 5) & 3, c = vcu & 31, bb = (vcu >> 7) & 1;
    __syncthreads();
    { LAS float* cwl = (LAS float*)(lds + MB_CW); LAS float* gnl = (LAS float*)(lds + MB_GN);
      for (int i = tid; i < 2 * 5 * 128; i += NWAVES * 64) { const int mat = i / 640, j = (i % 640) >> 7, ch = i & 127; cwl[i] = j < 4 ? conv_w[j * 1024 + mat * 512 + 128 * h + ch] : conv_b[mat * 512 + 128 * h + ch]; }
      if (tid < 256) gnl[tid] = (tid < 128 ? g_ret : g_ml)[128 * h + (tid & 127)]; }
    mb_group<0>(lds, z, gates, states, nprev, mprev, y, h, c, bb, tid, lane, wave);
    mb_group<1>(lds, z, gates, states, nprev, mprev, y, h, c, bb, tid, lane, wave);
}

#ifndef GEMM_SP2
#define GEMM_SP2 true
#endif
#ifndef GEMM_ALIGN
#define GEMM_ALIGN true
#endif
__global__ void __launch_bounds__(NWAVES * 64, 2) mk_fwd(Args args) {
    extern __shared__ __attribute__((aligned(16))) unsigned char lds_raw[];
    LAS unsigned char* lds = (LAS unsigned char*)lds_raw;
    volatile LAS unsigned* MISC = (volatile LAS unsigned*)(lds + MISC_OFF);
    const int G = gridDim.x; const int bx = blockIdx.x; const int vcu = (G % 8 == 0) ? (bx % 8) * (G / 8) + bx / 8 : bx;
    const int wave_s = __builtin_amdgcn_readfirstlane((int)(threadIdx.x >> 6));
    if (threadIdx.x < 32) MISC[threadIdx.x] = 0u;
    __syncthreads();
    XcdBarrier bar;
    { const auto* A = ARGS(); bar = xcd_barrier_post((unsigned*)(A->ws + WS_CTL) + CW_BAR + A->li * XCD_BAR_WORDS, MISC + 8); }
    const int lo = args.ph_lo, hi = args.ph_hi;
#define IN(k) (lo <= (k) && (k) < hi)
#ifndef SEAM_REP
#define SEAM_REP 1
#endif
#define SEAM(k) do { if (IN(k) && IN((k) + 1)) { for (int sr_ = 0; sr_ < SEAM_REP; ++sr_) xcd_barrier(bar); } } while (0)
#ifndef DUP_MASK
#define DUP_MASK 0
#endif
#define REP(k) for (int rep_ = 0; rep_ < (((DUP_MASK) >> (k)) & 1) + 1; ++rep_, __syncthreads())
#ifndef PHASE_PROBE
#define PHASE_PROBE 0
#endif
#ifndef PHASE_K
#define PHASE_K 1
#endif
#define PB(k) const unsigned long long pb0_ = (PHASE_PROBE == (k)) ? __builtin_amdgcn_s_memrealtime() : 0ull
#define PE(k) do { if (PHASE_PROBE == (k)) { const unsigned long long d_ = __builtin_amdgcn_s_memrealtime() - pb0_; const unsigned long long e_ = __builtin_amdgcn_s_memrealtime() + (unsigned long long)(PHASE_K) * d_; while (__builtin_amdgcn_s_memrealtime() < e_) __builtin_amdgcn_s_sleep(4); } } while (0)
#define TIDS() int tid = wave_s * 64 + lane_id(); asm volatile("" : "+v"(tid)); const int lane = tid & 63, wave = wave_s, gw = vcu * NWAVES + wave, NGW = G * NWAVES; (void)gw; (void)NGW; (void)lane; int vcu_p = vcu; asm volatile("" : "+s"(vcu_p))

    if (IN(0)) { TIDS(); const auto* A = ARGS(); const void* inp[18];
#pragma unroll
        for (int i = 0; i < 18; ++i) inp[i] = A->in[i];
        PB(1); REP(0) prologue_a(lds, inp, A->ws, tid, lane, wave, vcu, G); PE(1); SEAM(0); }
    if (IN(1)) { TIDS(); const auto* A = ARGS(); const void* inp[18];
#pragma unroll
        for (int i = 0; i < 18; ++i) inp[i] = A->in[i];
        PB(2); REP(1) prologue_b(lds, inp, A->ws, (unsigned char*)A->out, tid, lane, wave, vcu, G); PE(2); SEAM(1); }

    for (int j = 0; j < 2 * DEPTH; ++j) {
        const int l = j >> 1, f = j & 1;
        const int pb = 2 + 8 * l + (f ? 6 : 0);
        const int s = f ? 2 : 0;
        if (IN(pb)) { const auto* A = ARGS(); unsigned char* ws = A->ws;
            pg8::Gemm g{f ? (const bf16*)(ws + WS_H2) : (const bf16*)((unsigned char*)A->out + OUT_H), (const bf16*)(ws + WS_W + (size_t)l * LW_BYTES + LW_W13 + (size_t)f * W13_BYTES), M, 2 * DFF, D}; pg8::StaticOrder S; S.init(M, 2 * DFF, G, bx);
            pg8::EpiSwigluN E{l, f};
            PB(3); REP(4) pg8::gemm_phase<pg8::EpiSwigluN, pg8::StaticOrder, GEMM_ALIGN, GEMM_SP2>(lds, g, S, E, wave_s); PE(3);
            SEAM(pb);
        }
        if (IN(pb + 1)) { const auto* A = ARGS(); unsigned char* ws = A->ws;
            pg8::Gemm g{(const bf16*)(ws + WS_Z), (const bf16*)(ws + WS_W + (size_t)l * LW_BYTES + LW_W2 + (size_t)f * W2_BYTES), M, D, DFF}; pg8::StaticOrder S; S.init(M, D, G, bx);
            PB(4);
            if (j == 2 * DEPTH - 1) { pg8::EpiFinalN E{l}; pg8::gemm_phase<pg8::EpiFinalN, pg8::StaticOrder, GEMM_ALIGN, GEMM_SP2>(lds, g, S, E, wave_s); }
            else { pg8::EpiResidN E{l, f ? 2 : 0, j == 0 ? 1 : 0}; pg8::gemm_phase<pg8::EpiResidN, pg8::StaticOrder, GEMM_ALIGN, GEMM_SP2>(lds, g, S, E, wave_s); }
            PE(4);
            SEAM(pb + 1);
        }
        if (f == 0) {
            const int mb = 2 + 8 * l + 2;
            if (IN(mb)) { const auto* A = ARGS(); unsigned char* ws = A->ws;
                PB(5); pg8::Gemm g{(const bf16*)((unsigned char*)A->out + OUT_H), (const bf16*)(ws + WS_W + (size_t)l * LW_BYTES + LW_WIN), M, DZ, D}; pg8::StaticOrder S; S.init(M, DZ, G, bx);
                { TIDS(); gates_job((const bf16*)((unsigned char*)A->out + OUT_H), (const unsigned long long*)(ws + WS_RS) + (size_t)(l * 3 + 1) * M, (const float*)A->in[9] + (size_t)l * D * DIN, (const float*)(ws + WS_SWIN) + (size_t)l * BATCH * DIN,
                                     (const float*)A->in[12] + l * NH, (const float*)A->in[13] + l * NH, (float*)(ws + WS_GPART), lane, wave, vcu, G); }
                pg8::EpiZN E{l};
                REP(5) pg8::gemm_phase<pg8::EpiZN, pg8::StaticOrder, GEMM_ALIGN, GEMM_SP2>(lds, g, S, E, wave_s); PE(5);
                SEAM(mb);
            }
            if (IN(mb + 1)) { TIDS(); const auto* A = ARGS(); unsigned char* ws = A->ws;
                PB(6); REP(2) ma_fast(lds, (const bf16*)(ws + WS_Z), (const float2*)(ws + WS_ROPE), (const float*)(ws + WS_GPART),
                          (const float*)A->in[10] + (size_t)l * 4 * D, (const float*)A->in[11] + (size_t)l * D,
                          (bf16*)((unsigned char*)A->out + OUT_ST), (float*)(ws + WS_NPREV), (float*)(ws + WS_MPREV), tid, lane, wave, vcu_p, G); PE(6);
                SEAM(mb + 1); }
            if (IN(mb + 2)) { TIDS(); const auto* A = ARGS(); unsigned char* ws = A->ws;
                PB(7); REP(3) MB_FN(lds, (const bf16*)(ws + WS_Z), (const float2*)(ws + WS_ROPE), (const float*)(ws + WS_GPART),
                          (const float*)A->in[10] + (size_t)l * 4 * D, (const float*)A->in[11] + (size_t)l * D,
                          (const bf16*)((unsigned char*)A->out + OUT_ST), (const float*)(ws + WS_NPREV), (const float*)(ws + WS_MPREV), (const float*)A->in[14] + (size_t)l * 512, (const float*)A->in[15] + (size_t)l * 512, (bf16*)((unsigned char*)A->out + OUT_H),
                          tid, lane, wave, vcu_p, G); PE(7);
                SEAM(mb + 2); }
            if (IN(mb + 3)) { const auto* A = ARGS(); unsigned char* ws = A->ws;
                pg8::Gemm g{(const bf16*)((unsigned char*)A->out + OUT_H), (const bf16*)(ws + WS_W + (size_t)l * LW_BYTES + LW_WOUT), M, D, D}; pg8::StaticOrder S; S.init(M, D, G, bx);
                pg8::EpiResidN E{l, 1, 0};
                PB(8); pg8::gemm_phase<pg8::EpiResidN, pg8::StaticOrder, GEMM_ALIGN, GEMM_SP2>(lds, g, S, E, wave_s); PE(8);
                SEAM(mb + 3);
            }
        }
    }
#undef TIDS
#undef IN
#undef SEAM
}

extern "C" void kernel_launch(void* const* d_in, const int* in_sizes, int n_in, void* d_out, int out_size, void* d_ws, size_t ws_size, hipStream_t stream) {
    static int grid = 0;
    if (grid == 0) {
        if (n_in != 18 || in_sizes[0] != M * D || out_size != M * D || ws_size < WS_END) { fprintf(stderr, "kernel_launch: unexpected shapes (n_in %d, in0 %d, out %d, ws %zu)\n", n_in, n_in > 0 ? in_sizes[0] : -1, out_size, ws_size); grid = -1; return; }
        int dev = 0, cus = 0, per_cu = 0;
        if (hipGetDevice(&dev) != hipSuccess || hipDeviceGetAttribute(&cus, hipDeviceAttributeMultiprocessorCount, dev) != hipSuccess) { grid = -1; return; }
        if (hipFuncSetAttribute((const void*)mk_fwd, hipFuncAttributeMaxDynamicSharedMemorySize, LDS_BYTES) != hipSuccess) { fprintf(stderr, "kernel_launch: hipFuncSetAttribute failed\n"); grid = -1; return; }
        if (hipOccupancyMaxActiveBlocksPerMultiprocessor(&per_cu, (const void*)mk_fwd, NWAVES * 64, LDS_BYTES) != hipSuccess || per_cu < 1) { fprintf(stderr, "kernel_launch: occupancy query says %d\n", per_cu); }
        (void)hipGetLastError();
        grid = cus;
        { pg8::StaticOrder S; bool ok = true;
            for (int pm = 0; pm < M / 256 && ok; ++pm) { int seq = -1;
                for (int c = 0; c < grid && ok; ++c) { S.init(M, D, grid, c); pg8::Unit u; for (int i = 0; S.next(i, u); ++i) if (u.pm == pm) { if (seq < 0) seq = i; else if (seq != i) ok = false; } } }
            if (!ok) { fprintf(stderr, "kernel_launch: tile order unsuitable for the fused final norm (grid %d)\n", grid); grid = -1; return; } }
    }
    if (grid < 0) return;
    if (hipMemsetAsync((char*)d_ws + WS_CTL, 0, CTL_ZERO_BYTES, stream) != hipSuccess) return;
    Args a{};
    for (int i = 0; i < 18; ++i) a.in[i] = d_in[i];
    a.out = (float*)d_out; a.ws = (unsigned char*)d_ws; a.pad = 0;
#if MK_ONE_LAUNCH
    a.ph_lo = 0; a.ph_hi = NPHASE; a.li = 0;
    hipLaunchKernelGGL(mk_fwd, dim3(grid), dim3(NWAVES * 64), LDS_BYTES, stream, a);
#else
    for (int li = 0; li < NPHASE; ++li) { a.ph_lo = li; a.ph_hi = li + 1; a.li = li;
        hipLaunchKernelGGL(mk_fwd, dim3(grid), dim3(NWAVES * 64), LDS_BYTES, stream, a); }
#endif
}
```
